# Optimizing an MI355X kernel written in HIP

```python
import math
import jax, jax.numpy as jnp
from jax import lax
import numpy as np


D_MODEL = 1024
BATCH = 4
SEQ = 4096
DEPTH = 4

BLOCK_Q = 128
EPS = 1e-6
SB_HEADS = 8
SB_HEAD_DIM = 64
MLA_HEADS = 8
MLA_Q_LORA = 256
MLA_KV_LORA = 128
MLA_NOPE = 64
MLA_ROPE = 32
MLA_V = 64
ROPE_THETA = 10000.0
DSA_HEADS = 8
DSA_HEAD_DIM = 64
IDX_HEADS = 8
IDX_DIM = 32
TOPK_MAX = 256
REL_BUCKETS = 32
REL_MAX_DIST = 128
N_BRANCH = 3
BRANCH_WIDTH = 512
IN_SIZES = (SB_HEADS * SB_HEAD_DIM, SB_HEADS * SB_HEAD_DIM, SB_HEADS * SB_HEAD_DIM,
            MLA_Q_LORA, MLA_KV_LORA, MLA_ROPE,
            DSA_HEADS * DSA_HEAD_DIM, DSA_HEAD_DIM, DSA_HEAD_DIM,
            IDX_HEADS * IDX_DIM, IDX_DIM, IDX_HEADS,
            BRANCH_WIDTH, BRANCH_WIDTH, BRANCH_WIDTH,
            N_BRANCH * D_MODEL)
D_IN = sum(IN_SIZES)

kernel_name = 'hybrid_sb_mla_dsa_gated_block'


def _split_points(sizes):
    pts, acc = [], 0
    for s in sizes[:-1]:
        acc += s
        pts.append(acc)
    return pts


def rms_norm(x, g):
    xf = x.astype(jnp.float32)
    y = xf * lax.rsqrt(jnp.mean(xf * xf, axis=-1, keepdims=True) + EPS)
    return (y * g.astype(jnp.float32)).astype(x.dtype)


def apply_rope(x, cos, sin):
    xf = x.astype(jnp.float32)
    x1, x2 = xf[..., : MLA_ROPE // 2], xf[..., MLA_ROPE // 2:]
    return jnp.concatenate([x1 * cos - x2 * sin, x2 * cos + x1 * sin], axis=-1).astype(x.dtype)


def t5_bucket(dist):
    n = jnp.maximum(dist, 0)
    exact = REL_BUCKETS // 2
    nf = jnp.maximum(n, 1).astype(jnp.float32)
    large = exact + (jnp.log(nf / exact) / math.log(REL_MAX_DIST / exact)
                     * (REL_BUCKETS - exact)).astype(jnp.int32)
    large = jnp.minimum(large, REL_BUCKETS - 1)
    return jnp.where(n < exact, n, large)


def stick_breaking_attention(q, k, v):
    B, S, H, dh = q.shape
    kf, vf = k.astype(jnp.float32), v.astype(jnp.float32)
    key_idx = jnp.arange(S)

    def block(n):
        start = n * BLOCK_Q
        qb = lax.dynamic_slice_in_dim(q, start, BLOCK_Q, axis=1).astype(jnp.float32)
        z = jnp.einsum('bqhd,bkhd->bhqk', qb, kf) * (dh ** -0.5)
        q_idx = start + jnp.arange(BLOCK_Q)
        mask = key_idx[None, :] < q_idx[:, None]
        log_1m = jnp.where(mask, jax.nn.log_sigmoid(-z), 0.0)
        csum = jnp.cumsum(log_1m, axis=-1)
        log_a = jax.nn.log_sigmoid(z) + csum[..., -1:] - csum
        a = jnp.where(mask, jnp.exp(log_a), 0.0)
        return jnp.einsum('bhqk,bkhd->bqhd', a, vf)

    out = lax.map(block, jnp.arange(S // BLOCK_Q))
    return out.transpose(1, 0, 2, 3, 4).reshape(B, S, H * dh).astype(q.dtype)


def causal_softmax_attention(q, k, v, scale):
    B, S, H, _ = q.shape
    dv = v.shape[-1]
    kf, vf = k.astype(jnp.float32), v.astype(jnp.float32)
    key_idx = jnp.arange(S)

    def block(n):
        start = n * BLOCK_Q
        qb = lax.dynamic_slice_in_dim(q, start, BLOCK_Q, axis=1).astype(jnp.float32)
        logits = jnp.einsum('bqhd,bkhd->bhqk', qb, kf) * scale
        q_idx = start + jnp.arange(BLOCK_Q)
        mask = key_idx[None, :] <= q_idx[:, None]
        p = jax.nn.softmax(jnp.where(mask, logits, -jnp.inf), axis=-1)
        return jnp.einsum('bhqk,bkhd->bqhd', p, vf)

    out = lax.map(block, jnp.arange(S // BLOCK_Q))
    return out.transpose(1, 0, 2, 3, 4).reshape(B, S, H * dv).astype(q.dtype)


_gather_rows = jax.vmap(lambda a, i: a[i])


def dsa_attention(q, k, v, ix_q, ix_k, ix_w, positions, rel_bias):
    B, S, H, dh = q.shape
    topk = min(TOPK_MAX, S // 4)
    ixk = ix_k.astype(jnp.float32)
    key_idx = jnp.arange(S)

    def block(n):
        start = n * BLOCK_Q
        q_idx = start + jnp.arange(BLOCK_Q)
        iq = lax.dynamic_slice_in_dim(ix_q, start, BLOCK_Q, axis=1).astype(jnp.float32)
        iw = lax.dynamic_slice_in_dim(ix_w, start, BLOCK_Q, axis=1).astype(jnp.float32)
        s_idx = jax.nn.relu(jnp.einsum('bqhd,bkd->bqhk', iq, ixk) * (IDX_DIM ** -0.5))
        score = jnp.einsum('bqh,bqhk->bqk', iw * (IDX_HEADS ** -0.5), s_idx)
        score = jnp.where(key_idx[None, None, :] <= q_idx[None, :, None], score, -jnp.inf)
        _, sel = lax.top_k(score, topk)
        valid = sel <= q_idx[None, :, None]
        kg = _gather_rows(k, sel).astype(jnp.float32)
        vg = _gather_rows(v, sel).astype(jnp.float32)
        qb = lax.dynamic_slice_in_dim(q, start, BLOCK_Q, axis=1).astype(jnp.float32)
        logits = jnp.einsum('bqhd,bqkd->bqhk', qb, kg) * (dh ** -0.5)
        pq = lax.dynamic_slice_in_dim(positions, start, BLOCK_Q, axis=1)
        pk = _gather_rows(positions, sel)
        bias = rel_bias.astype(jnp.float32)[t5_bucket(pq[:, :, None] - pk)]
        logits = logits + jnp.moveaxis(bias, -1, 2)
        p = jax.nn.softmax(jnp.where(valid[:, :, None, :], logits, -jnp.inf), axis=-1)
        return jnp.einsum('bqhk,bqkd->bqhd', p, vg)

    out = lax.map(block, jnp.arange(S // BLOCK_Q))
    return out.transpose(1, 0, 2, 3, 4).reshape(B, S, H * dh).astype(q.dtype)


def hybrid_layer(x, positions, cos, sin, norm_g, w_in, q_norm_g, kv_norm_g, w_uq, w_ukv,
                 mla_q_g, mla_k_g, dsa_q_g, dsa_k_g, rel_bias, gate_b, w_branch, w_out):
    B, S, D = x.shape
    h = rms_norm(x, norm_g)
    proj = h @ w_in
    (sa_q, sa_k, sa_v, c_q, c_kv, k_pe, ds_q, ds_k, ds_v, ix_q, ix_k, ix_w,
     z_a, z_b, z_c, g) = jnp.split(proj, _split_points(IN_SIZES), axis=-1)

    y_a = stick_breaking_attention(sa_q.reshape(B, S, SB_HEADS, SB_HEAD_DIM),
                                   sa_k.reshape(B, S, SB_HEADS, SB_HEAD_DIM),
                                   sa_v.reshape(B, S, SB_HEADS, SB_HEAD_DIM))

    q_b = (rms_norm(c_q, q_norm_g) @ w_uq).reshape(B, S, MLA_HEADS, MLA_NOPE + MLA_ROPE)
    kv_b = (rms_norm(c_kv, kv_norm_g) @ w_ukv).reshape(B, S, MLA_HEADS, MLA_NOPE + MLA_V)
    k_nope, v_b = kv_b[..., :MLA_NOPE], kv_b[..., MLA_NOPE:]
    k_b = jnp.concatenate([k_nope, jnp.broadcast_to(k_pe[:, :, None, :], (B, S, MLA_HEADS, MLA_ROPE))], axis=-1)
    q_b = rms_norm(q_b, mla_q_g)
    k_b = rms_norm(k_b, mla_k_g)
    c4, s4 = cos[:, :, None, :], sin[:, :, None, :]
    q_b = jnp.concatenate([q_b[..., :MLA_NOPE], apply_rope(q_b[..., MLA_NOPE:], c4, s4)], axis=-1)
    k_b = jnp.concatenate([k_b[..., :MLA_NOPE], apply_rope(k_b[..., MLA_NOPE:], c4, s4)], axis=-1)
    y_b = causal_softmax_attention(q_b, k_b, v_b, (MLA_NOPE + MLA_ROPE) ** -0.5)

    y_c = dsa_attention(rms_norm(ds_q.reshape(B, S, DSA_HEADS, DSA_HEAD_DIM), dsa_q_g),
                        rms_norm(ds_k, dsa_k_g), ds_v,
                        ix_q.reshape(B, S, IDX_HEADS, IDX_DIM), ix_k, ix_w,
                        positions, rel_bias)

    branches = jnp.stack([y_a * jax.nn.silu(z_a), y_b * jax.nn.silu(z_b), y_c * jax.nn.silu(z_c)], axis=2)
    up = jnp.einsum('bsnc,ncd->bsnd', branches, w_branch)
    gates = jax.nn.sigmoid(g.reshape(B, S, N_BRANCH, D) + gate_b)
    merged = jnp.sum(gates * up, axis=2)
    return x + merged @ w_out


def setup_inputs(seed: int = 0) -> dict:
    key = jax.random.key(seed)
    ks = jax.random.split(key, 17)
    f32 = jnp.float32

    def nrm(k, shape, scale):
        return jax.random.normal(k, shape, f32) * scale

    def gain(k, shape):
        return 1.0 + 0.02 * jax.random.normal(k, shape, f32)

    x = jax.random.normal(ks[0], (BATCH, SEQ, D_MODEL), f32)
    offset = jax.random.randint(ks[1], (BATCH, 1), 0, 1024, dtype=jnp.int32)
    positions = offset + jnp.arange(SEQ, dtype=jnp.int32)[None, :]
    return {
        'x': x,
        'positions': positions,
        'norm_g': gain(ks[2], (DEPTH, D_MODEL)),
        'w_in': nrm(ks[3], (DEPTH, D_MODEL, D_IN), D_MODEL ** -0.5),
        'mla_q_norm_g': gain(ks[4], (DEPTH, MLA_Q_LORA)),
        'mla_kv_norm_g': gain(ks[5], (DEPTH, MLA_KV_LORA)),
        'mla_w_uq': nrm(ks[6], (DEPTH, MLA_Q_LORA, MLA_HEADS * (MLA_NOPE + MLA_ROPE)), MLA_Q_LORA ** -0.5),
        'mla_w_ukv': nrm(ks[7], (DEPTH, MLA_KV_LORA, MLA_HEADS * (MLA_NOPE + MLA_V)), MLA_KV_LORA ** -0.5),
        'mla_q_g': gain(ks[8], (DEPTH, MLA_NOPE + MLA_ROPE)),
        'mla_k_g': gain(ks[9], (DEPTH, MLA_NOPE + MLA_ROPE)),
        'dsa_q_g': gain(ks[10], (DEPTH, DSA_HEAD_DIM)),
        'dsa_k_g': gain(ks[11], (DEPTH, DSA_HEAD_DIM)),
        'rel_bias': nrm(ks[12], (REL_BUCKETS, DSA_HEADS), 0.5),
        'gate_b': nrm(ks[13], (DEPTH, N_BRANCH, D_MODEL), 0.02),
        'w_branch': nrm(ks[14], (DEPTH, N_BRANCH, BRANCH_WIDTH, D_MODEL), BRANCH_WIDTH ** -0.5),
        'w_out': nrm(ks[15], (DEPTH, D_MODEL, D_MODEL), D_MODEL ** -0.5),
    }


def reference(x, positions, norm_g, w_in, mla_q_norm_g, mla_kv_norm_g, mla_w_uq, mla_w_ukv,
              mla_q_g, mla_k_g, dsa_q_g, dsa_k_g, rel_bias, gate_b, w_branch, w_out):
    half = MLA_ROPE // 2
    inv_freq = ROPE_THETA ** (-(jnp.arange(half, dtype=jnp.float32) * 2.0) / MLA_ROPE)
    ang = positions.astype(jnp.float32)[..., None] * inv_freq
    cos, sin = jnp.cos(ang), jnp.sin(ang)
    for l in range(DEPTH):
        x = hybrid_layer(x, positions, cos, sin, norm_g[l], w_in[l], mla_q_norm_g[l], mla_kv_norm_g[l],
                         mla_w_uq[l], mla_w_ukv[l], mla_q_g[l], mla_k_g[l], dsa_q_g[l], dsa_k_g[l],
                         rel_bias, gate_b[l], w_branch[l], w_out[l])
    return x
```

```cpp
#include <hip/hip_runtime.h>
#include <hip/hip_cooperative_groups.h>
#include <stdint.h>
#include <stdio.h>
namespace cg = cooperative_groups;

typedef unsigned short u16;
typedef __attribute__((ext_vector_type(8))) short bf16x8;
typedef __attribute__((ext_vector_type(16))) float f32x16;
typedef __attribute__((ext_vector_type(2))) float f2_t;
typedef __attribute__((ext_vector_type(2))) __bf16 bf2_t;

#define DI __device__ __forceinline__
#ifndef STAGE_LDS
#define STAGE_LDS 1
#endif
#ifndef BIS1
#define BIS1 0
#endif
#ifndef SEL_NOGUARD
#define SEL_NOGUARD 0
#endif
#define MFMA32(a, b, c) __builtin_amdgcn_mfma_f32_32x32x16_bf16((a), (b), (c), 0, 0, 0)

constexpr int SEQ = 4096, NTOK = 16384, DEPTH = 4;
constexpr int D_IN = 7496, NP = 7552;
constexpr int N_DSV = 2496, N_KPEIXK = 2816;
constexpr int LDP = 6016;
constexpr int LDX = 1088, LDB = 576, LDY = 1600;
constexpr int O_CQ = 0, O_CKV = 256, O_DSQ = 384, O_DSK = 896, O_IXQ = 1024, O_KPE = 1280, O_ZA = 1344, O_G = 2880, O_IXW = 5952;
constexpr float LOG2E = 1.4426950408889634f;
constexpr float C_SB = 0.125f * LOG2E;
constexpr float C_MLA = 0.10206207261596577f * LOG2E;
constexpr float EPS = 1e-6f;

constexpr size_t SZ_WT_IN = (size_t)NP * LDX * 2, SZ_WT_UQ = 768 * 256 * 2, SZ_WT_UKV = 1024 * 128 * 2,
                 SZ_WT_BR = 3 * 1024 * LDB * 2, SZ_WT_OUT = 1024 * LDX * 2;
constexpr size_t OFF_WT_UQ = SZ_WT_IN, OFF_WT_UKV = OFF_WT_UQ + SZ_WT_UQ, OFF_WT_BR = OFF_WT_UKV + SZ_WT_UKV,
                 OFF_WT_OUT = OFF_WT_BR + SZ_WT_BR, SZ_WSET = OFF_WT_OUT + SZ_WT_OUT;
constexpr size_t WS_WT = 0;
constexpr size_t WS_XB = WS_WT + 2 * SZ_WSET;
constexpr size_t WS_XSS = WS_XB + (size_t)NTOK * LDX * 2;
constexpr size_t WS_PROJ = WS_XSS + (size_t)NTOK * 16 * 4;
constexpr size_t WS_QB = WS_PROJ + (size_t)NTOK * LDP * 2;
constexpr size_t WS_KB = WS_QB + (size_t)NTOK * 768 * 2;
constexpr size_t WS_VTA = WS_KB + (size_t)NTOK * 768 * 2;
constexpr size_t WS_VTB = WS_VTA + (size_t)NTOK * 512 * 2;
constexpr size_t WS_VTC = WS_VTB + (size_t)NTOK * 512 * 2;
constexpr size_t WS_YBR = WS_VTC + (size_t)NTOK * 64 * 2;
constexpr size_t WS_BM = WS_YBR + (size_t)NTOK * LDY * 2;
constexpr size_t WS_QA = WS_BM + (size_t)NTOK * 128 * 4;
constexpr size_t WS_KA = WS_QA + (size_t)NTOK * 512 * 2;
constexpr size_t WS_DSQ = WS_KA + (size_t)NTOK * 512 * 2;
constexpr size_t WS_DSK = WS_DSQ + (size_t)NTOK * 512 * 2;
constexpr size_t WS_IXK = WS_DSK + (size_t)NTOK * 64 * 2;
constexpr size_t WS_CTR = WS_IXK + (size_t)NTOK * 32 * 2;
constexpr size_t WS_BAR = WS_CTR + 256;
constexpr size_t WS_PMAX = WS_BAR + 32768;
constexpr size_t WS_TOTAL = WS_PMAX + 4096;
constexpr size_t WS_MERGED = WS_QB;

struct Params {
  const float* x; const int* pos; const float* norm_g; const float* w_in; const float* qn_g; const float* kvn_g;
  const float* w_uq; const float* w_ukv; const float* mla_q_g; const float* mla_k_g; const float* dsa_q_g;
  const float* dsa_k_g; const float* rel_bias; const float* gate_b; const float* w_branch; const float* w_out;
  float* out; char* ws;
};

DI uint32_t pack2(float a, float b) { f2_t v = {a, b}; bf2_t r = __builtin_convertvector(v, bf2_t); return __builtin_bit_cast(uint32_t, r); }
DI float bflo(uint32_t u) { return __uint_as_float(u << 16); }
DI float bfhi(uint32_t u) { return __uint_as_float(u & 0xffff0000u); }
DI float bf1(u16 u) { return __uint_as_float(((uint32_t)u) << 16); }
DI u16 f2bf(float x) { return (u16)(pack2(x, 0.f) & 0xffffu); }
DI float xor32(float v) { return __shfl_xor(v, 32); }
DI float xsum32(float v) { unsigned u = __float_as_uint(v); auto r = __builtin_amdgcn_permlane32_swap(u, u, false, false); return __uint_as_float(r[0]) + __uint_as_float(r[1]); }
DI float xmax32(float v) { unsigned u = __float_as_uint(v); auto r = __builtin_amdgcn_permlane32_swap(u, u, false, false); return fmaxf(__uint_as_float(r[0]), __uint_as_float(r[1])); }
DI int crow(int reg, int h) { return (reg & 3) + 8 * (reg >> 2) + 4 * h; }
DI float fexp2(float x) { return __builtin_amdgcn_exp2f(x); }
DI float frcp(float x) { return __builtin_amdgcn_rcpf(x); }
DI int opaque_tid() { int t = threadIdx.x; asm volatile("" : "+v"(t)); return t; }
DI float fsigmoid(float x) { return frcp(1.f + fexp2(-LOG2E * x)); }
DI f32x16 zero16() { f32x16 z; _Pragma("unroll") for (int i = 0; i < 16; ++i) z[i] = 0.f; return z; }

#define XB_TMO      128
#define XB_XCNT(j)  (256  + 64 * (j))
#define XB_XSUB(j)  (1280 + 64 * (j))
#define XB_XGEN(j)  (2304 + 64 * (j))
#define XB_TOP      3328
#define XB_TOPGEN   3392
#define XCD_BAR_WORDS 3456
#define XB_SPIN_CAP (1u << 22)
#define LAS __attribute__((address_space(3)))
DI unsigned xb_ld(unsigned* p) { return __hip_atomic_load(p, __ATOMIC_RELAXED, __HIP_MEMORY_SCOPE_AGENT); }
DI unsigned xb_add(unsigned* p, unsigned v) { return __hip_atomic_fetch_add(p, v, __ATOMIC_RELAXED, __HIP_MEMORY_SCOPE_AGENT); }
DI unsigned xb_xcc_id() { return (unsigned)__builtin_amdgcn_s_getreg((3 << 11) | 20) & 0xFu; }
#define XB_SPIN(cond, bar) do { unsigned _sp = 0; while (cond) { __builtin_amdgcn_s_sleep(1); \
    if ((++_sp & 255u) == 0u) { if (xb_ld(&(bar)[XB_TMO])) break; if (_sp > XB_SPIN_CAP) { atomicAdd(&(bar)[XB_TMO], 1u); break; } } } } while (0)
struct XcdBarrier { unsigned* bar; unsigned x; volatile LAS unsigned* st; };
DI XcdBarrier xcd_barrier_post(unsigned* bar, volatile LAS unsigned* st) {
  XcdBarrier b; b.bar = bar; b.x = xb_xcc_id(); b.st = st;
  if (threadIdx.x == 0) (void)xb_add(&bar[XB_XCNT(b.x)], 1u);
  return b;
}
DI void xcd_barrier_complete(unsigned* bar, unsigned x, unsigned& nloc, unsigned& nx) {
  const unsigned G = gridDim.x * gridDim.y * gridDim.z;
  unsigned sum, cnt, mine, sp = 0u;
  for (;;) {
    sum = 0u; cnt = 0u; mine = 0u;
#pragma unroll
    for (unsigned j = 0; j < 16; ++j) { const unsigned c = xb_ld(&bar[XB_XCNT(j)]); sum += c; cnt += (c > 0u) ? 1u : 0u; mine = (j == x) ? c : mine; }
    if (sum == G) break;
    __builtin_amdgcn_s_sleep(1);
    if ((++sp & 255u) == 0u) { if (xb_ld(&bar[XB_TMO])) break; if (sp > XB_SPIN_CAP) { atomicAdd(&bar[XB_TMO], 1u); break; } }
  }
  nloc = mine > 0u ? mine : 1u; nx = cnt > 0u ? cnt : 1u;
}
DI void xcd_barrier(const XcdBarrier& b) {
  asm volatile("s_waitcnt vmcnt(0)" ::: "memory");
  __syncthreads();
  if (threadIdx.x == 0) {
    unsigned* bar = b.bar;
    __builtin_amdgcn_s_waitcnt(0);
    unsigned nloc = b.st[0], nx = b.st[1];
    if (nloc == 0u) { xcd_barrier_complete(bar, b.x, nloc, nx); b.st[0] = nloc; b.st[1] = nx; }
    const unsigned old = xb_add(&bar[XB_XSUB(b.x)], 1u);
    const unsigned gen = old / nloc;
    if (old + 1u == (gen + 1u) * nloc) {
      __builtin_amdgcn_fence(__ATOMIC_RELEASE, "agent");
      asm volatile("s_waitcnt vmcnt(0)" ::: "memory");
      const unsigned og = xb_add(&bar[XB_TOP], 1u);
      const unsigned tg = og / nx;
      if (og + 1u == (tg + 1u) * nx) xb_add(&bar[XB_TOPGEN], 1u);
      else XB_SPIN(xb_ld(&bar[XB_TOPGEN]) == tg, bar);
      __builtin_amdgcn_fence(__ATOMIC_ACQUIRE, "agent");
      xb_add(&bar[XB_XGEN(b.x)], 1u);
      asm volatile("s_waitcnt vmcnt(0)" ::: "memory");
    } else {
      XB_SPIN(xb_ld(&bar[XB_XGEN(b.x)]) == gen, bar);
      __builtin_amdgcn_fence(__ATOMIC_ACQUIRE, "agent");
      asm volatile("s_waitcnt vmcnt(0)" ::: "memory");
    }
  }
  __syncthreads();
}

#define XB_RND(j) (3456 + 64 * (j))
DI void class_round_sync(unsigned* bar, int cls, int members) {
  __syncthreads();
  if (threadIdx.x == 0) {
    const unsigned t = xb_add(&bar[XB_RND(cls)], 1u);
    const unsigned target = (t / (unsigned)members + 1u) * (unsigned)members;
    unsigned sp = 0;
    while (xb_ld(&bar[XB_RND(cls)]) < target) { __builtin_amdgcn_s_sleep(1); if (++sp > (1u << 16)) break; }
  }
  __syncthreads();
}

DI int src_col(int n) {
  if (n < 1920) return n;
  if (n < 2816) return n + 32;
  if (n < 2848) return n - 896;
  if (n < 2880) return n;
  if (n < 7488) return n + 8;
  if (n < 7496) return n - 4608;
  return -1;
}
template <bool MAP>
DI void transpose_tile(const float* __restrict__ src, int N, int K, int Nvalid, const float* __restrict__ g,
                       u16* __restrict__ dst, int ldd, int k0, int n0, float* sT) {
  const int tid = opaque_tid();
  const int cg = (tid & 15) * 4, kq = tid >> 4;
  const int sc = MAP ? src_col(n0 + cg) : ((n0 + cg < Nvalid) ? n0 + cg : -1);
#pragma unroll
  for (int i = 0; i < 4; ++i) {
    const int kk = i * 16 + kq;
    float4 v = make_float4(0.f, 0.f, 0.f, 0.f);
    if (sc >= 0) {
      v = *(const float4*)(src + (size_t)(k0 + kk) * N + sc);
      if (g) { const float gg = g[k0 + kk]; v.x *= gg; v.y *= gg; v.z *= gg; v.w *= gg; }
    }
    float* d = sT + kk * 65 + cg;
    d[0] = v.x; d[1] = v.y; d[2] = v.z; d[3] = v.w;
  }
  __syncthreads();
  const int n = tid >> 2, kc = (tid & 3) * 16;
  uint32_t o[8];
#pragma unroll
  for (int j = 0; j < 8; ++j) o[j] = pack2(sT[(kc + 2 * j) * 65 + n], sT[(kc + 2 * j + 1) * 65 + n]);
  uint4* d = (uint4*)(dst + (size_t)(n0 + n) * ldd + k0 + kc);
  d[0] = make_uint4(o[0], o[1], o[2], o[3]);
  d[1] = make_uint4(o[4], o[5], o[6], o[7]);
  __syncthreads();
}

constexpr int CV_IN = 16 * 118, CV_UQ = 4 * 12, CV_UKV = 2 * 16, CV_BR = 3 * 8 * 16, CV_OUT = 16 * 16;
constexpr int CV_TOTAL = CV_IN + CV_UQ + CV_UKV + CV_BR + CV_OUT;

DI void convert_item(const Params& p, int layer, int item, float* sT) {
  char* wset = p.ws + WS_WT + (size_t)(layer & 1) * SZ_WSET;
  if (item < CV_IN) {
    int kt = item & 15, nt = item >> 4;
    transpose_tile<true>(p.w_in + (size_t)layer * 1024 * D_IN, D_IN, 1024, D_IN, p.norm_g + layer * 1024, (u16*)wset, LDX, kt * 64, nt * 64, sT);
    return;
  }
  item -= CV_IN;
  if (item < CV_UQ) {
    int kt = item & 3, nt = item >> 2;
    transpose_tile<false>(p.w_uq + (size_t)layer * 256 * 768, 768, 256, 768, p.qn_g + layer * 256, (u16*)(wset + OFF_WT_UQ), 256, kt * 64, nt * 64, sT);
    return;
  }
  item -= CV_UQ;
  if (item < CV_UKV) {
    int kt = item & 1, nt = item >> 1;
    transpose_tile<false>(p.w_ukv + (size_t)layer * 128 * 1024, 1024, 128, 1024, p.kvn_g + layer * 128, (u16*)(wset + OFF_WT_UKV), 128, kt * 64, nt * 64, sT);
    return;
  }
  item -= CV_UKV;
  if (item < CV_BR) {
    int br = item >> 7, rem = item & 127, kt = rem & 7, nt = rem >> 3;
    transpose_tile<false>(p.w_branch + ((size_t)layer * 3 + br) * 512 * 1024, 1024, 512, 1024, nullptr,
                   (u16*)(wset + OFF_WT_BR) + (size_t)br * 1024 * LDB, LDB, kt * 64, nt * 64, sT);
    return;
  }
  item -= CV_BR;
  {
    int kt = item & 15, nt = item >> 4;
    transpose_tile<false>(p.w_out + (size_t)layer * 1024 * 1024, 1024, 1024, 1024, nullptr, (u16*)(wset + OFF_WT_OUT), LDX, kt * 64, nt * 64, sT);
  }
}

DI void gemm128(const u16* __restrict__ W, int ldw, const u16* __restrict__ X, int ldx, int K, f32x16 (&acc)[2][2], char* smem) {
  typedef u16 (*tile_t)[128][72];
  tile_t sw = (tile_t)smem;
  tile_t sx = (tile_t)(smem + 2 * 128 * 72 * 2);
  const int tid = opaque_tid(), lane = tid & 63, wave = __builtin_amdgcn_readfirstlane(tid >> 6), r = lane & 31, h = lane >> 5;
  const int wn = wave & 1, wm = wave >> 1;
  const int lc = tid & 7, lr = tid >> 3;
  const u16* gw = W + (size_t)lr * ldw + lc * 8;
  const u16* gx = X + (size_t)lr * ldx + lc * 8;
  const u16* gw1 = gw + (size_t)32 * ldw; const u16* gw2 = gw + (size_t)64 * ldw; const u16* gw3 = gw + (size_t)96 * ldw;
  const u16* gx1 = gx + (size_t)32 * ldx; const u16* gx2 = gx + (size_t)64 * ldx; const u16* gx3 = gx + (size_t)96 * ldx;
  uint4 rw0, rw1, rw2, rw3, rx0, rx1, rx2, rx3;
#define G_LOAD(KOFF) do { rw0 = *(const uint4*)(gw + (KOFF)); rw1 = *(const uint4*)(gw1 + (KOFF)); rw2 = *(const uint4*)(gw2 + (KOFF)); rw3 = *(const uint4*)(gw3 + (KOFF)); \
                          rx0 = *(const uint4*)(gx + (KOFF)); rx1 = *(const uint4*)(gx1 + (KOFF)); rx2 = *(const uint4*)(gx2 + (KOFF)); rx3 = *(const uint4*)(gx3 + (KOFF)); } while (0)
#define G_STORE(BUF) do { *(uint4*)&sw[(BUF)][lr][lc * 8] = rw0; *(uint4*)&sw[(BUF)][lr + 32][lc * 8] = rw1; *(uint4*)&sw[(BUF)][lr + 64][lc * 8] = rw2; *(uint4*)&sw[(BUF)][lr + 96][lc * 8] = rw3; \
                          *(uint4*)&sx[(BUF)][lr][lc * 8] = rx0; *(uint4*)&sx[(BUF)][lr + 32][lc * 8] = rx1; *(uint4*)&sx[(BUF)][lr + 64][lc * 8] = rx2; *(uint4*)&sx[(BUF)][lr + 96][lc * 8] = rx3; } while (0)
  G_LOAD(0);
  G_STORE(0);
  const int nk = K >> 6;
  G_LOAD(64);
  __syncthreads();
  for (int kt = 0; kt < nk; ++kt) {
    const int buf = kt & 1;
#pragma unroll
    for (int ks = 0; ks < 4; ++ks) {
      bf16x8 a0 = *(const bf16x8*)&sw[buf][wn * 64 + r][ks * 16 + h * 8];
      bf16x8 a1 = *(const bf16x8*)&sw[buf][wn * 64 + 32 + r][ks * 16 + h * 8];
      bf16x8 b0 = *(const bf16x8*)&sx[buf][wm * 64 + r][ks * 16 + h * 8];
      bf16x8 b1 = *(const bf16x8*)&sx[buf][wm * 64 + 32 + r][ks * 16 + h * 8];
      acc[0][0] = MFMA32(a0, b0, acc[0][0]);
      acc[0][1] = MFMA32(a0, b1, acc[0][1]);
      acc[1][0] = MFMA32(a1, b0, acc[1][0]);
      acc[1][1] = MFMA32(a1, b1, acc[1][1]);
    }
    if (kt + 1 < nk) G_STORE(buf ^ 1);
    if (kt + 2 < nk) G_LOAD((kt + 2) * 64);
    __syncthreads();
  }
#undef G_LOAD
#undef G_STORE
}

template <int NT>
DI bool tile_order(int i, int xcd, int& mt, int& nt) {
  constexpr int PER = 8 * NT;
  if (i >= 2 * PER) return false;
  int mh = i / PER, j = i - mh * PER;
  int ng = j >> 6, w = j & 63;
  mt = xcd * 16 + mh * 8 + (w & 7);
  nt = ng * 8 + (w >> 3);
  return true;
}

DI void phase_proj(const Params& p, int layer, char* smem, int xcd, int loc, int nloc) {
  const u16* WT = (const u16*)(p.ws + WS_WT + (size_t)(layer & 1) * SZ_WSET);
  const u16* XB = (const u16*)(p.ws + WS_XB);
  const float* XSS = (const float*)(p.ws + WS_XSS);
  u16* PROJ = (u16*)(p.ws + WS_PROJ);
  u16* VTA = (u16*)(p.ws + WS_VTA);
  u16* VTC = (u16*)(p.ws + WS_VTC);
  const int tid = opaque_tid(), lane = tid & 63, wave = __builtin_amdgcn_readfirstlane(tid >> 6), r = lane & 31, h = lane >> 5;
  const int wn = wave & 1, wm = wave >> 1;
  for (int i = loc;; i += nloc) {
    int mt, nt;
    if (!tile_order<59>(i, xcd, mt, nt)) break;
    const int m0 = mt * 128, n0 = nt * 128;
    f32x16 acc[2][2];
    acc[0][0] = zero16(); acc[0][1] = zero16(); acc[1][0] = zero16(); acc[1][1] = zero16();
    float rinv2[2];
#pragma unroll
    for (int mi = 0; mi < 2; ++mi) {
      const float4* sp = (const float4*)(XSS + (size_t)(m0 + wm * 64 + mi * 32 + r) * 16);
      float4 q0 = sp[0], q1 = sp[1], q2 = sp[2], q3 = sp[3];
      float ss = ((q0.x + q0.y) + (q0.z + q0.w)) + ((q1.x + q1.y) + (q1.z + q1.w)) + ((q2.x + q2.y) + (q2.z + q2.w)) + ((q3.x + q3.y) + (q3.z + q3.w));
      rinv2[mi] = rsqrtf(ss * (1.f / 1024.f) + EPS);
    }
    gemm128(WT + (size_t)n0 * LDX, LDX, XB + (size_t)m0 * LDX, LDX, 1024, acc, smem);
    {
      const int nb = n0 + wn * 64;
      const int mb = m0 + wm * 64;
      const int b = mb >> 12, s0 = mb & 4095;
      u16 (*st)[72] = (u16 (*)[72])(smem + ((wave & 2) ? 55296 : 18432) + (wave & 1) * 9216);
      const bool transposed = (nb >= 1024 && nb < 1536) || (nb == N_DSV);
      const float cs = (nb < 512) ? C_SB : 1.f;
      u16* dst; size_t rstride;
      if (nb < 512) { dst = (u16*)(p.ws + WS_QA) + ((size_t)(b * 8 + (nb >> 6)) * 4096 + s0) * 64; rstride = 64; }
      else if (nb < 1024) { dst = (u16*)(p.ws + WS_KA) + ((size_t)(b * 8 + ((nb - 512) >> 6)) * 4096 + s0) * 64; rstride = 64; }
      else if (nb < 1536) { dst = VTA + ((size_t)(b * 8 + ((nb - 1024) >> 6)) * 64) * 4096 + s0; rstride = 4096; }
      else if (nb == N_DSV) { dst = VTC + ((size_t)b * 64) * 4096 + s0; rstride = 4096; }
      else { dst = PROJ + (size_t)mb * LDP + (nb - 1536); rstride = LDP; }
#pragma unroll
      for (int mi = 0; mi < 2; ++mi) {
        const int m = mb + mi * 32 + r;
        const float rinv = rinv2[mi] * cs;
#pragma unroll
        for (int ni = 0; ni < 2; ++ni) {
          if (transposed) {
#pragma unroll
            for (int i = 0; i < 16; ++i) {
              if (STAGE_LDS) st[ni * 32 + crow(i, h)][mi * 32 + r] = f2bf(acc[ni][mi][i] * rinv);
              else dst[(size_t)(ni * 32 + crow(i, h)) * rstride + mi * 32 + r] = f2bf(acc[ni][mi][i] * rinv);
            }
          } else {
#pragma unroll
            for (int g = 0; g < 4; ++g) {
              const uint2 v = make_uint2(pack2(acc[ni][mi][4 * g] * rinv, acc[ni][mi][4 * g + 1] * rinv), pack2(acc[ni][mi][4 * g + 2] * rinv, acc[ni][mi][4 * g + 3] * rinv));
              if (STAGE_LDS) *(uint2*)&st[mi * 32 + r][ni * 32 + 8 * g + 4 * h] = v;
              else {
                *(uint2*)(dst + (size_t)(mi * 32 + r) * rstride + ni * 32 + 8 * g + 4 * h) = v;
                if (nb == N_KPEIXK && ni == 1) *(uint2*)((u16*)(p.ws + WS_IXK) + (size_t)m * 32 + 8 * g + 4 * h) = v;
              }
            }
          }
        }
      }
      if (STAGE_LDS) {
        __builtin_amdgcn_wave_barrier();
        asm volatile("s_waitcnt lgkmcnt(0)" ::: "memory");
        const int rr = lane >> 3, cc = lane & 7;
#pragma unroll
        for (int it = 0; it < 8; ++it) {
          const int row = it * 8 + rr;
          uint4 v = *(const uint4*)&st[row][cc * 8];
          *(uint4*)(dst + (size_t)row * rstride + cc * 8) = v;
          if (nb == N_KPEIXK && cc >= 4) *(uint4*)((u16*)(p.ws + WS_IXK) + (size_t)(mb + row) * 32 + (cc - 4) * 8) = v;
        }
      }
    }
  }
}

DI void phase_proj_probe(const Params& p, int layer, char* smem, int xcd, int loc, int nloc) {
  const u16* WT = (const u16*)(p.ws + WS_WT + (size_t)(layer & 1) * SZ_WSET);
  const u16* XB = (const u16*)(p.ws + WS_XB);
  float tot = 0.f;
  for (int i = loc;; i += nloc) {
    int mt, nt;
    if (!tile_order<59>(i, xcd, mt, nt)) break;
    f32x16 acc[2][2];
    acc[0][0] = zero16(); acc[0][1] = zero16(); acc[1][0] = zero16(); acc[1][1] = zero16();
    gemm128(WT, LDX, XB, LDX, 1024, acc, smem);
    tot += acc[0][0][0] + acc[0][1][3] + acc[1][0][5] + acc[1][1][7];
  }
  if (tot == 12345.678f) ((float*)(p.ws + WS_CTR))[32] = tot;
}

DI void prep_item(const Params& p, int layer, int item) {
  const char* wset = p.ws + WS_WT + (size_t)(layer & 1) * SZ_WSET;
  const u16* WUQ = (const u16*)(wset + OFF_WT_UQ);
  const u16* WUKV = (const u16*)(wset + OFF_WT_UKV);
  u16* PROJ = (u16*)(p.ws + WS_PROJ);
  u16* QB = (u16*)(p.ws + WS_QB);
  u16* KB = (u16*)(p.ws + WS_KB);
  u16* VTB = (u16*)(p.ws + WS_VTB);
  const int lane = opaque_tid() & 63, r = lane & 31, h = lane >> 5;
  const int tg = item >> 3, hd = item & 7;
  const int token = tg * 32 + r, b = token >> 12, s = token & 4095;
  u16* prow = PROJ + (size_t)token * LDP;

  const float posf = (float)p.pos[token];
  float cs[8], sn[8];
  {
    const float IF0[8] = {1.0f, 0.5623413251903491f, 0.31622776601683794f, 0.1778279410038923f, 0.01f, 0.005623413251903491f, 0.0031622776601683794f, 0.0017782794100389228f};
    const float IF1[8] = {0.1f, 0.05623413251903491f, 0.03162277660168379f, 0.01778279410038923f, 0.001f, 0.0005623413251903491f, 0.00031622776601683794f, 0.00017782794100389227f};
#pragma unroll
    for (int reg = 0; reg < 8; ++reg) {
      const float inv = h ? IF1[reg] : IF0[reg];
      const float ang = posf * inv;
      double rv = (double)ang * 0.15915494309189535;
      rv -= rint(rv);
      const float fr = (float)rv;
      sn[reg] = __builtin_amdgcn_sinf(fr);
      cs[reg] = __builtin_amdgcn_cosf(fr);
    }
  }

  {
    bf16x8 bq[16];
    float ss = 0.f;
#pragma unroll
    for (int ks = 0; ks < 16; ++ks) {
      uint4 u = *(const uint4*)(prow + O_CQ + ks * 16 + 8 * h);
      bq[ks] = __builtin_bit_cast(bf16x8, u);
      float f;
      f = bflo(u.x); ss += f * f; f = bfhi(u.x); ss += f * f; f = bflo(u.y); ss += f * f; f = bfhi(u.y); ss += f * f;
      f = bflo(u.z); ss += f * f; f = bfhi(u.z); ss += f * f; f = bflo(u.w); ss += f * f; f = bfhi(u.w); ss += f * f;
    }
    ss += xor32(ss);
    const float rq = rsqrtf(ss * (1.f / 256.f) + EPS);
    f32x16 acc[3];
    acc[0] = zero16(); acc[1] = zero16(); acc[2] = zero16();
    const u16* wq = WUQ + (size_t)(hd * 96 + r) * 256 + 8 * h;
#pragma unroll
    for (int ks = 0; ks < 16; ++ks) {
#pragma unroll
      for (int nt = 0; nt < 3; ++nt) {
        bf16x8 a = *(const bf16x8*)(wq + (size_t)nt * 32 * 256 + ks * 16);
        acc[nt] = MFMA32(a, bq[ks], acc[nt]);
      }
    }
    float ss2 = 0.f;
#pragma unroll
    for (int nt = 0; nt < 3; ++nt)
#pragma unroll
      for (int i = 0; i < 16; ++i) { acc[nt][i] *= rq; ss2 += acc[nt][i] * acc[nt][i]; }
    ss2 += xor32(ss2);
    const float r2 = rsqrtf(ss2 * (1.f / 96.f) + EPS);
    const float* gq = p.mla_q_g + layer * 96;
#pragma unroll
    for (int nt = 0; nt < 3; ++nt)
#pragma unroll
      for (int g = 0; g < 4; ++g) {
        float4 gg = *(const float4*)(gq + nt * 32 + 8 * g + 4 * h);
        acc[nt][4 * g] *= r2 * gg.x; acc[nt][4 * g + 1] *= r2 * gg.y; acc[nt][4 * g + 2] *= r2 * gg.z; acc[nt][4 * g + 3] *= r2 * gg.w;
      }
#pragma unroll
    for (int reg = 0; reg < 8; ++reg) {
      float x1 = acc[2][reg], x2 = acc[2][reg + 8];
      acc[2][reg] = x1 * cs[reg] - x2 * sn[reg];
      acc[2][reg + 8] = x2 * cs[reg] + x1 * sn[reg];
    }
    u16* qo = QB + ((size_t)token * 8 + hd) * 96;
#pragma unroll
    for (int nt = 0; nt < 3; ++nt)
#pragma unroll
      for (int g = 0; g < 4; ++g)
        *(uint2*)(qo + nt * 32 + 8 * g + 4 * h) = make_uint2(pack2(acc[nt][4 * g] * C_MLA, acc[nt][4 * g + 1] * C_MLA), pack2(acc[nt][4 * g + 2] * C_MLA, acc[nt][4 * g + 3] * C_MLA));
  }
  {
    bf16x8 bk[8];
    float ss = 0.f;
#pragma unroll
    for (int ks = 0; ks < 8; ++ks) {
      uint4 u = *(const uint4*)(prow + O_CKV + ks * 16 + 8 * h);
      bk[ks] = __builtin_bit_cast(bf16x8, u);
      float f;
      f = bflo(u.x); ss += f * f; f = bfhi(u.x); ss += f * f; f = bflo(u.y); ss += f * f; f = bfhi(u.y); ss += f * f;
      f = bflo(u.z); ss += f * f; f = bfhi(u.z); ss += f * f; f = bflo(u.w); ss += f * f; f = bfhi(u.w); ss += f * f;
    }
    ss += xor32(ss);
    const float rkv = rsqrtf(ss * (1.f / 128.f) + EPS);
    f32x16 acc[4];
    acc[0] = zero16(); acc[1] = zero16(); acc[2] = zero16(); acc[3] = zero16();
    const u16* wk = WUKV + (size_t)(hd * 128 + r) * 128 + 8 * h;
#pragma unroll
    for (int ks = 0; ks < 8; ++ks) {
#pragma unroll
      for (int nt = 0; nt < 4; ++nt) {
        bf16x8 a = *(const bf16x8*)(wk + (size_t)nt * 32 * 128 + ks * 16);
        acc[nt] = MFMA32(a, bk[ks], acc[nt]);
      }
    }
    float kpe[16];
#pragma unroll
    for (int g = 0; g < 4; ++g) {
      uint2 u = *(const uint2*)(prow + O_KPE + 8 * g + 4 * h);
      kpe[4 * g] = bflo(u.x); kpe[4 * g + 1] = bfhi(u.x); kpe[4 * g + 2] = bflo(u.y); kpe[4 * g + 3] = bfhi(u.y);
    }
    float ss2 = 0.f;
#pragma unroll
    for (int nt = 0; nt < 4; ++nt)
#pragma unroll
      for (int i = 0; i < 16; ++i) acc[nt][i] *= rkv;
#pragma unroll
    for (int i = 0; i < 16; ++i) ss2 += acc[0][i] * acc[0][i] + acc[1][i] * acc[1][i] + kpe[i] * kpe[i];
    ss2 += xor32(ss2);
    const float r2 = rsqrtf(ss2 * (1.f / 96.f) + EPS);
    const float* gk = p.mla_k_g + layer * 96;
#pragma unroll
    for (int g = 0; g < 4; ++g) {
      float4 g0 = *(const float4*)(gk + 8 * g + 4 * h);
      float4 g1 = *(const float4*)(gk + 32 + 8 * g + 4 * h);
      float4 g2 = *(const float4*)(gk + 64 + 8 * g + 4 * h);
      acc[0][4 * g] *= r2 * g0.x; acc[0][4 * g + 1] *= r2 * g0.y; acc[0][4 * g + 2] *= r2 * g0.z; acc[0][4 * g + 3] *= r2 * g0.w;
      acc[1][4 * g] *= r2 * g1.x; acc[1][4 * g + 1] *= r2 * g1.y; acc[1][4 * g + 2] *= r2 * g1.z; acc[1][4 * g + 3] *= r2 * g1.w;
      kpe[4 * g] *= r2 * g2.x; kpe[4 * g + 1] *= r2 * g2.y; kpe[4 * g + 2] *= r2 * g2.z; kpe[4 * g + 3] *= r2 * g2.w;
    }
#pragma unroll
    for (int reg = 0; reg < 8; ++reg) {
      float x1 = kpe[reg], x2 = kpe[reg + 8];
      kpe[reg] = x1 * cs[reg] - x2 * sn[reg];
      kpe[reg + 8] = x2 * cs[reg] + x1 * sn[reg];
    }
    u16* ko = KB + ((size_t)token * 8 + hd) * 96;
#pragma unroll
    for (int g = 0; g < 4; ++g) {
      *(uint2*)(ko + 8 * g + 4 * h) = make_uint2(pack2(acc[0][4 * g], acc[0][4 * g + 1]), pack2(acc[0][4 * g + 2], acc[0][4 * g + 3]));
      *(uint2*)(ko + 32 + 8 * g + 4 * h) = make_uint2(pack2(acc[1][4 * g], acc[1][4 * g + 1]), pack2(acc[1][4 * g + 2], acc[1][4 * g + 3]));
      *(uint2*)(ko + 64 + 8 * g + 4 * h) = make_uint2(pack2(kpe[4 * g], kpe[4 * g + 1]), pack2(kpe[4 * g + 2], kpe[4 * g + 3]));
    }
#pragma unroll
    for (int nt = 2; nt < 4; ++nt)
#pragma unroll
      for (int i = 0; i < 16; ++i) {
        const int d = (nt - 2) * 32 + crow(i, h);
        VTB[((size_t)((b * 8 + hd) * 64 + d)) * 4096 + s] = f2bf(acc[nt][i]);
      }
  }
  {
    const u16* qp = prow + O_DSQ + hd * 64 + 32 * h;
    u16* qo = (u16*)(p.ws + WS_DSQ) + ((size_t)token * 8 + hd) * 64 + 32 * h;
    uint4 u[4];
    float f[32];
    float ss = 0.f;
#pragma unroll
    for (int i = 0; i < 4; ++i) {
      u[i] = *(const uint4*)(qp + 8 * i);
      f[8 * i] = bflo(u[i].x); f[8 * i + 1] = bfhi(u[i].x); f[8 * i + 2] = bflo(u[i].y); f[8 * i + 3] = bfhi(u[i].y);
      f[8 * i + 4] = bflo(u[i].z); f[8 * i + 5] = bfhi(u[i].z); f[8 * i + 6] = bflo(u[i].w); f[8 * i + 7] = bfhi(u[i].w);
    }
#pragma unroll
    for (int i = 0; i < 32; ++i) ss += f[i] * f[i];
    ss += xor32(ss);
    const float rr = rsqrtf(ss * (1.f / 64.f) + EPS) * C_SB;
    const float* gq = p.dsa_q_g + layer * 64 + 32 * h;
#pragma unroll
    for (int i = 0; i < 4; ++i) {
      float4 ga = *(const float4*)(gq + 8 * i), gb = *(const float4*)(gq + 8 * i + 4);
      *(uint4*)(qo + 8 * i) = make_uint4(pack2(f[8 * i] * rr * ga.x, f[8 * i + 1] * rr * ga.y), pack2(f[8 * i + 2] * rr * ga.z, f[8 * i + 3] * rr * ga.w),
                                         pack2(f[8 * i + 4] * rr * gb.x, f[8 * i + 5] * rr * gb.y), pack2(f[8 * i + 6] * rr * gb.z, f[8 * i + 7] * rr * gb.w));
    }
  }
  if (hd == 1) {
    int pm = p.pos[token];
#pragma unroll
    for (int off = 1; off < 32; off <<= 1) { const int o = __shfl_xor(pm, off); pm = pm > o ? pm : o; }
    if (lane == 0) ((int*)(p.ws + WS_PMAX))[tg] = pm;
  }
  if (hd == 0) {
    const u16* kp = prow + O_DSK + 32 * h;
    u16* ko2 = (u16*)(p.ws + WS_DSK) + (size_t)token * 64 + 32 * h;
    float f[32];
    float ss = 0.f;
#pragma unroll
    for (int i = 0; i < 4; ++i) {
      uint4 u = *(const uint4*)(kp + 8 * i);
      f[8 * i] = bflo(u.x); f[8 * i + 1] = bfhi(u.x); f[8 * i + 2] = bflo(u.y); f[8 * i + 3] = bfhi(u.y);
      f[8 * i + 4] = bflo(u.z); f[8 * i + 5] = bfhi(u.z); f[8 * i + 6] = bflo(u.w); f[8 * i + 7] = bfhi(u.w);
    }
#pragma unroll
    for (int i = 0; i < 32; ++i) ss += f[i] * f[i];
    ss += xor32(ss);
    const float rr = rsqrtf(ss * (1.f / 64.f) + EPS);
    const float* gk = p.dsa_k_g + layer * 64 + 32 * h;
#pragma unroll
    for (int i = 0; i < 4; ++i) {
      float4 ga = *(const float4*)(gk + 8 * i), gb = *(const float4*)(gk + 8 * i + 4);
      *(uint4*)(ko2 + 8 * i) = make_uint4(pack2(f[8 * i] * rr * ga.x, f[8 * i + 1] * rr * ga.y), pack2(f[8 * i + 2] * rr * ga.z, f[8 * i + 3] * rr * ga.w),
                                         pack2(f[8 * i + 4] * rr * gb.x, f[8 * i + 5] * rr * gb.y), pack2(f[8 * i + 6] * rr * gb.z, f[8 * i + 7] * rr * gb.w));
    }
  }
}

struct SelSmem { uint32_t hist[2][4096]; uint32_t pfx[4]; uint32_t need[4]; uint32_t dcut[4]; uint32_t flag; };

template <int PASS>
DI void sel_pass(SelSmem* S, const uint32_t (&sk)[32][2], int ntiles, uint32_t (&pf)[2]) {
  const int tid = opaque_tid(), lane = tid & 63, wave = __builtin_amdgcn_readfirstlane(tid >> 6), r = lane & 31, h = lane >> 5;
  {
    uint4* hz = (uint4*)&S->hist[0][0];
#pragma unroll
    for (int i = 0; i < 8; ++i) hz[tid + 256 * i] = make_uint4(0, 0, 0, 0);
  }
  __syncthreads();
#pragma unroll
  for (int i = 0; i < 32; ++i) {
    const int tile = i * 4 + wave;
    if (tile < ntiles) {
#pragma unroll
      for (int j = 0; j < 2; ++j) {
        const uint32_t k = sk[i][j];
        bool match; uint32_t digit;
        if (PASS == 0) { match = (k != 0u); digit = k >> 20; }
        else if (PASS == 1) { match = ((k >> 20) == pf[j]); digit = (k >> 10) & 1023u; }
        else if (PASS == 2) { match = ((k >> 10) == pf[j]); digit = k & 1023u; }
        else { match = (k == pf[j]); digit = 4095u - (uint32_t)(tile * 32 + r); }
        if (match) atomicAdd(&S->hist[h][digit], j ? 0x10000u : 1u);
      }
    }
  }
  __syncthreads();
  {
    constexpr int PER = (PASS == 0 || PASS == 3) ? 64 : 16;
    const int pair = wave >> 1, sh = (wave & 1) * 16;
    const uint32_t need = S->need[wave];
    const uint32_t prevp = S->pfx[wave];
    const uint32_t* hp = &S->hist[pair][lane * PER];
    uint32_t tot = 0;
    for (int c = 0; c < PER; ++c) tot += (hp[(c + lane) & (PER - 1)] >> sh) & 0xffffu;
    uint32_t incl = tot;
#pragma unroll
    for (int off = 1; off < 64; off <<= 1) {
      uint32_t v = __shfl_down(incl, off);
      if (lane + off < 64) incl += v;
    }
    const uint32_t sfx = incl - tot;
    const bool cross = (sfx < need) && (need <= sfx + tot);
    const unsigned long long cm = __ballot(cross);
    if (cm != 0ull) {
      const int L = __builtin_ctzll(cm);
      const uint32_t cumbase = (uint32_t)__shfl((int)sfx, L);
      const uint32_t cnt = (lane < PER) ? ((S->hist[pair][L * PER + lane] >> sh) & 0xffffu) : 0u;
      uint32_t inc2 = cnt;
#pragma unroll
      for (int off = 1; off < PER; off <<= 1) {
        uint32_t v = __shfl_down(inc2, off);
        if (lane + off < 64) inc2 += v;
      }
      const uint32_t cum = cumbase + (inc2 - cnt);
      if (lane < PER && cum < need && need <= cum + cnt) {
        const uint32_t bin = (uint32_t)(L * PER + lane);
        const uint32_t nn = need - cum;
        if (PASS == 0) S->pfx[wave] = bin;
        else if (PASS == 1 || PASS == 2) S->pfx[wave] = (prevp << 10) | bin;
        else S->dcut[wave] = bin;
        if (PASS == 2 && cnt != nn) atomicOr(&S->flag, 1u);
        S->need[wave] = nn;
      }
    }
  }
  __syncthreads();
  if (PASS < 3) { pf[0] = S->pfx[2 * h]; pf[1] = S->pfx[2 * h + 1]; }
}

DI void select_item(const Params& p, int item, char* smem) {
  SelSmem* S = (SelSmem*)smem;
  const u16* PROJ = (const u16*)(p.ws + WS_PROJ);
  uint32_t* BM = (uint32_t*)(p.ws + WS_BM);
  const int b = item & 3, t0 = (1023 - (item >> 2)) * 4;
  const int tokbase = b * 4096;
  const int tid = opaque_tid(), lane = tid & 63, wave = __builtin_amdgcn_readfirstlane(tid >> 6), r = lane & 31, h = lane >> 5;
  if (t0 + 3 < 256) {
    if (tid < 32) {
      const int q = tid >> 3, tile = tid & 7, t = t0 + q;
      uint32_t wd = (tile < (t >> 5)) ? 0xffffffffu : (tile == (t >> 5) ? (0xffffffffu >> (31 - (t & 31))) : 0u);
      BM[(size_t)(tokbase + t) * 128 + tile] = wd;
    }
    return;
  }
  const int ntiles = 2 * (t0 >> 6) + 2;
  if (tid < 4) { S->need[tid] = 256u; S->pfx[tid] = 0u; S->dcut[tid] = 0u; }
  if (tid == 4) S->flag = 0u;
  bf16x8 a0, a1;
  {
    const int hb = (r >> 2) & 1, idx16 = (r & 3) + 4 * (r >> 3);
    const int q = 2 * hb + (idx16 >> 3), head = idx16 & 7;
    const u16* aq = PROJ + (size_t)(tokbase + t0 + q) * LDP + O_IXQ + head * 32 + 8 * h;
    a0 = *(const bf16x8*)aq;
    a1 = *(const bf16x8*)(aq + 16);
  }
  float wv[16];
#pragma unroll
  for (int j = 0; j < 2; ++j) {
    uint4 u = *(const uint4*)(PROJ + (size_t)(tokbase + t0 + 2 * h + j) * LDP + O_IXW);
    const float c = 0.35355339059327373f * 0.17677669529663687f;
    wv[8 * j] = bflo(u.x) * c; wv[8 * j + 1] = bfhi(u.x) * c; wv[8 * j + 2] = bflo(u.y) * c; wv[8 * j + 3] = bfhi(u.y) * c;
    wv[8 * j + 4] = bflo(u.z) * c; wv[8 * j + 5] = bfhi(u.z) * c; wv[8 * j + 6] = bflo(u.w) * c; wv[8 * j + 7] = bfhi(u.w) * c;
  }
  const u16* IXK = (const u16*)(p.ws + WS_IXK) + (size_t)tokbase * 32;
  uint32_t sk[32][2];
  bf16x8 ka0[4], ka1[4], kb0[4], kb1[4];
#define SEL_LOAD(S0, S1, CC)                                                          \
  _Pragma("unroll") for (int ii = 0; ii < 4; ++ii) {                                   \
    const int key_ = ((((CC) * 4 + ii) * 4 + wave) * 32) + r;                          \
    const u16* kp_ = BIS1 ? (PROJ + (size_t)(tokbase + key_) * LDP + O_KPE + 32 + 8 * h) : (IXK + (size_t)key_ * 32 + 8 * h); \
    S0[ii] = *(const bf16x8*)kp_; S1[ii] = *(const bf16x8*)(kp_ + 16);                 \
  }
#define SEL_COMP(S0, S1, CC)                                                          \
  _Pragma("unroll") for (int ii = 0; ii < 4; ++ii) {                                   \
    const int i_ = (CC) * 4 + ii;                                                      \
    const int key_ = (i_ * 4 + wave) * 32 + r;                                         \
    f32x16 acc_ = zero16();                                                            \
    acc_ = MFMA32(a0, S0[ii], acc_);                                                   \
    acc_ = MFMA32(a1, S1[ii], acc_);                                                   \
    _Pragma("unroll") for (int j = 0; j < 2; ++j) {                                    \
      float sc_ = 0.f;                                                                 \
      _Pragma("unroll") for (int hd = 0; hd < 8; ++hd) sc_ = fmaf(wv[8 * j + hd], fmaxf(acc_[8 * j + hd], 0.f), sc_); \
      sc_ += 0.0f;                                                                     \
      const uint32_t bits_ = __float_as_uint(sc_);                                     \
      const uint32_t k32_ = bits_ ^ (((uint32_t)((int32_t)bits_ >> 31)) | 0x80000000u); \
      sk[i_][j] = (key_ <= t0 + 2 * h + j) ? k32_ : 0u;                                \
    }                                                                                  \
  }
#define SEL_ZERO(CC) _Pragma("unroll") for (int ii = 0; ii < 4; ++ii) { sk[(CC) * 4 + ii][0] = 0u; sk[(CC) * 4 + ii][1] = 0u; }
  if (wave < ntiles) { SEL_LOAD(ka0, ka1, 0) }
#pragma unroll
  for (int cc = 0; cc < 8; cc += 2) {
    if (16 * (cc + 1) + wave < ntiles) { SEL_LOAD(kb0, kb1, cc + 1) }
    if (16 * cc + wave < ntiles) { SEL_COMP(ka0, ka1, cc) } else { SEL_ZERO(cc) }
    if (cc + 2 < 8) { if (16 * (cc + 2) + wave < ntiles) { SEL_LOAD(ka0, ka1, cc + 2) } }
    if (16 * (cc + 1) + wave < ntiles) { SEL_COMP(kb0, kb1, cc + 1) } else { SEL_ZERO(cc + 1) }
  }
#undef SEL_LOAD
#undef SEL_COMP
#undef SEL_ZERO
  uint32_t pf[2] = {0u, 0u};
  sel_pass<0>(S, sk, ntiles, pf);
  sel_pass<1>(S, sk, ntiles, pf);
  sel_pass<2>(S, sk, ntiles, pf);
  uint32_t dc[2] = {0u, 0u};
  if (S->flag) {
    sel_pass<3>(S, sk, ntiles, pf);
    dc[0] = S->dcut[2 * h]; dc[1] = S->dcut[2 * h + 1];
  }
#pragma unroll
  for (int i = 0; i < 32; ++i) {
    const int tile = i * 4 + wave;
    if (tile < ntiles) {
      const uint32_t di = 4095u - (uint32_t)(tile * 32 + r);
#pragma unroll
      for (int j = 0; j < 2; ++j) {
        const uint32_t k = sk[i][j];
        const bool sel = (k > pf[j]) || (k == pf[j] && di >= dc[j]);
        const unsigned long long m = __ballot(sel);
        if (lane == 0) {
          BM[(size_t)(tokbase + t0 + j) * 128 + tile] = (uint32_t)m;
          BM[(size_t)(tokbase + t0 + 2 + j) * 128 + tile] = (uint32_t)(m >> 32);
        }
      }
    }
  }
  __syncthreads();
}

DI bool softmax_bound_ok(const Params& p, int layer, int mode) {
  const int lane = threadIdx.x & 63;
  const float* gq = (mode == 1) ? (p.mla_q_g + layer * 96) : (p.dsa_q_g + layer * 64);
  const float* gk = (mode == 1) ? (p.mla_k_g + layer * 96) : (p.dsa_k_g + layer * 64);
  const int ng = (mode == 1) ? 96 : 64;
  float aq = 0.f, ak = 0.f, ab = 0.f;
  for (int i = lane; i < ng; i += 64) { aq = fmaxf(aq, fabsf(gq[i])); ak = fmaxf(ak, fabsf(gk[i])); }
  if (mode == 2) { for (int i = lane; i < 256; i += 64) ab = fmaxf(ab, fabsf(p.rel_bias[i])); }
#pragma unroll
  for (int off = 1; off < 64; off <<= 1) { aq = fmaxf(aq, __shfl_xor(aq, off)); ak = fmaxf(ak, __shfl_xor(ak, off)); ab = fmaxf(ab, __shfl_xor(ab, off)); }
  const float bound = ((mode == 1) ? 9.7979590f * aq * ak : 8.f * aq * ak + 2.f * ab) * LOG2E * 1.02f;
  return __builtin_amdgcn_readfirstlane((bound < 100.f) ? 1 : 0) != 0;
}

template <int MODE, bool FAST>
DI void attn_item(const Params& p, int layer, int b, int hd, int qt, char* smem) {
  constexpr int DK = (MODE == 1) ? 96 : 64;
  constexpr int KS = DK / 16;
  constexpr int KROW = DK + 8;
  constexpr int KCH = DK / 8;
  constexpr int NKL = (64 * KCH) / 256;
  typedef u16 (*kt_t)[64][KROW];
  typedef u16 (*vt_t)[64][72];
  kt_t sK = (kt_t)smem;
  vt_t sV = (vt_t)(smem + 2 * 64 * KROW * 2);
  int* sPos = (int*)(smem + 2 * 64 * KROW * 2 + 2 * 64 * 72 * 2);
  float* sBias = (float*)(smem + 2 * 64 * KROW * 2 + 2 * 64 * 72 * 2 + 512);

  const u16* PROJ = (const u16*)(p.ws + WS_PROJ);
  u16* YBR = (u16*)(p.ws + WS_YBR);
  const uint32_t* BM = (const uint32_t*)(p.ws + WS_BM);
  const int tid = opaque_tid(), lane = tid & 63, wave = __builtin_amdgcn_readfirstlane(tid >> 6), r = lane & 31, h = lane >> 5;
  const int tokbase = b * 4096;

  int tq, hdl, wmin, wmax, nt64;
  const u16* qrow;
  const u16* kbase; size_t kstride;
  const u16* vbase;
  if (MODE == 0) {
    tq = qt * 128 + wave * 32 + r; hdl = hd; wmin = qt * 128 + wave * 32; wmax = wmin + 31; nt64 = 2 * qt + 2;
    qrow = (const u16*)(p.ws + WS_QA) + ((size_t)(b * 8 + hd) * 4096 + tq) * 64;
    kbase = (const u16*)(p.ws + WS_KA) + ((size_t)(b * 8 + hd) * 4096) * 64; kstride = 64;
    vbase = (const u16*)(p.ws + WS_VTA) + (size_t)((b * 8 + hd) * 64) * 4096;
  } else if (MODE == 1) {
    tq = qt * 128 + wave * 32 + r; hdl = hd; wmin = qt * 128 + wave * 32; wmax = wmin + 31; nt64 = 2 * qt + 2;
    qrow = (const u16*)(p.ws + WS_QB) + ((size_t)(tokbase + tq) * 8 + hd) * 96;
    kbase = (const u16*)(p.ws + WS_KB) + ((size_t)tokbase * 8 + hd) * 96; kstride = 768;
    vbase = (const u16*)(p.ws + WS_VTB) + (size_t)((b * 8 + hd) * 64) * 4096;
  } else {
    tq = qt * 16 + wave * 4 + (r >> 3); hdl = r & 7; wmin = qt * 16 + wave * 4; wmax = wmin + 3; nt64 = (qt >> 2) + 1;
    qrow = (const u16*)(p.ws + WS_DSQ) + ((size_t)(tokbase + tq) * 8 + hdl) * 64;
    kbase = (const u16*)(p.ws + WS_DSK) + (size_t)tokbase * 64; kstride = 64;
    vbase = (const u16*)(p.ws + WS_VTC) + (size_t)(b * 64) * 4096;
  }
  int posq = 0, wposmin = 0;
  if (MODE == 2) {
    posq = p.pos[tokbase + tq];
    wposmin = posq;
#pragma unroll
    for (int off = 1; off < 64; off <<= 1) { const int o = __shfl_xor(wposmin, off); wposmin = wposmin < o ? wposmin : o; }
    wposmin = __builtin_amdgcn_readfirstlane(wposmin);
    for (int e = tid; e < 1024; e += 256) {
      const int n = e >> 3, hh = e & 7;
      int bk = n;
      if (n >= 16) {
        bk = 16 + (n >= 19) + (n >= 21) + (n >= 24) + (n >= 27) + (n >= 31) + (n >= 35) + (n >= 40) + (n >= 46) + (n >= 52) + (n >= 59) + (n >= 67) + (n >= 77) + (n >= 87) + (n >= 99) + (n >= 113);
      }
      sBias[e] = (p.rel_bias[bk * 8 + hh] - p.rel_bias[31 * 8 + hh]) * LOG2E;
    }
  }
  constexpr bool fastsm = FAST;
  bf16x8 qf[KS];
#pragma unroll
  for (int ks = 0; ks < KS; ++ks) qf[ks] = *(const bf16x8*)(qrow + ks * 16 + 8 * h);

  f32x16 o[2];
  o[0] = zero16(); o[1] = zero16();
  float carry = 1.f;
  float mrun = -INFINITY, lrun = 0.f;

  uint4 rk0, rk1, rk2 = make_uint4(0, 0, 0, 0), rv0, rv1;
  int rp = 0;
  const int krow0 = tid / KCH, kc0 = tid - krow0 * KCH;
  const int krow1 = (tid + 256) / KCH, kc1 = (tid + 256) - krow1 * KCH;
  const int krow2 = (tid + 512) / KCH, kc2 = (tid + 512) - krow2 * KCH;
  const int vd0 = tid >> 3, vc0 = tid & 7, vd1 = vd0 + 32;
#define ATT_GLOAD(KT)                                                                         \
  do {                                                                                        \
    const int key0_ = (KT) * 64;                                                              \
    rk0 = *(const uint4*)(kbase + (size_t)(key0_ + krow0) * kstride + kc0 * 8);               \
    rk1 = *(const uint4*)(kbase + (size_t)(key0_ + krow1) * kstride + kc1 * 8);               \
    if (NKL > 2) rk2 = *(const uint4*)(kbase + (size_t)(key0_ + krow2) * kstride + kc2 * 8);  \
    rv0 = *(const uint4*)(vbase + (size_t)vd0 * 4096 + key0_ + vc0 * 8);                      \
    rv1 = *(const uint4*)(vbase + (size_t)vd1 * 4096 + key0_ + vc0 * 8);                      \
    if (MODE == 2) { if (tid < 64) rp = p.pos[tokbase + key0_ + tid]; }                       \
  } while (0)
#define ATT_SSTORE(BUF)                                                  \
  do {                                                                   \
    *(uint4*)&sK[(BUF)][krow0][kc0 * 8] = rk0;                           \
    *(uint4*)&sK[(BUF)][krow1][kc1 * 8] = rk1;                           \
    if (NKL > 2) *(uint4*)&sK[(BUF)][krow2][kc2 * 8] = rk2;              \
    *(uint4*)&sV[(BUF)][vd0][vc0 * 8] = rv0;                             \
    *(uint4*)&sV[(BUF)][vd1][vc0 * 8] = rv1;                             \
    if (MODE == 2) { if (tid < 64) sPos[(BUF) * 64 + tid] = rp; }        \
  } while (0)

  ATT_GLOAD(MODE == 0 ? nt64 - 1 : 0);
  ATT_SSTORE(0);
  if (nt64 > 1) ATT_GLOAD(MODE == 0 ? nt64 - 2 : 1);
  __syncthreads();
  for (int step = 0; step < nt64; ++step) {
    const int kt = (MODE == 0) ? (nt64 - 1 - step) : step;
    const int buf = step & 1;
    const bool more = (step + 1 < nt64);
#pragma unroll
    for (int subi = 0; subi < 2; ++subi) {
      const int sub = (MODE == 0) ? (1 - subi) : subi;
      const int ks0 = kt * 64 + sub * 32;
      const bool skip = (MODE == 0) ? (ks0 >= wmax) : (ks0 > wmax);
      if (!skip) {
        uint32_t wd = 0;
        if (MODE == 2) wd = BM[(size_t)(tokbase + tq) * 128 + (ks0 >> 5)];
        f32x16 s = zero16();
#pragma unroll
        for (int ks = 0; ks < KS; ++ks) {
          bf16x8 a = *(const bf16x8*)&sK[buf][sub * 32 + r][ks * 16 + 8 * h];
          s = MFMA32(a, qf[ks], s);
        }
        float pv[16];
        if (MODE == 0) {
          const bool needmask = (ks0 + 31 >= wmin);
          float e[16];
#pragma unroll
          for (int i = 0; i < 16; ++i) e[i] = frcp(1.f + fexp2(s[i]));
          if (needmask) {
#pragma unroll
            for (int i = 0; i < 16; ++i) e[i] = ((ks0 + crow(i, h)) < tq) ? e[i] : 1.f;
          }
          float tot[4], pr[4], sel[4];
#pragma unroll
          for (int g = 0; g < 4; ++g) tot[g] = (e[4 * g + 3] * e[4 * g + 2]) * (e[4 * g + 1] * e[4 * g]);
#pragma unroll
          for (int g = 0; g < 4; ++g) {
            unsigned uu = __float_as_uint(tot[g]);
            auto rr = __builtin_amdgcn_permlane32_swap(uu, uu, false, false);
            const float r0 = __uint_as_float(rr[0]), r1 = __uint_as_float(rr[1]);
            pr[g] = r0 * r1;
            sel[g] = h ? 1.f : r1;
          }
          float R[4];
          R[3] = carry; R[2] = R[3] * pr[3]; R[1] = R[2] * pr[2]; R[0] = R[1] * pr[1];
          carry = R[0] * pr[0];
#pragma unroll
          for (int g = 0; g < 4; ++g) {
            const float p4 = R[g] * sel[g];
            const float p3 = p4 * e[4 * g + 3];
            const float p2 = p3 * e[4 * g + 2];
            const float p1 = p2 * e[4 * g + 1];
            const float p0 = p1 * e[4 * g];
            pv[4 * g + 3] = p4 - p3; pv[4 * g + 2] = p3 - p2; pv[4 * g + 1] = p2 - p1; pv[4 * g] = p1 - p0;
          }
        } else {
          float u[16];
          if (MODE == 1) {
            const bool needmask = (ks0 + 31 > wmin);
#pragma unroll
            for (int i = 0; i < 16; ++i) u[i] = s[i];
            if (needmask) {
              asm volatile("" ::: "memory");
#pragma unroll
              for (int i = 0; i < 16; ++i) { if ((ks0 + crow(i, h)) > tq) u[i] = -INFINITY; }
            }
          } else if (wposmin - ((const int*)(p.ws + WS_PMAX))[b * 128 + (ks0 >> 5)] >= 113) {
#pragma unroll
            for (int i = 0; i < 16; ++i) u[i] = ((wd >> crow(i, h)) & 1u) ? s[i] : -INFINITY;
          } else {
#pragma unroll
            for (int i = 0; i < 16; ++i) {
              const int kk = crow(i, h);
              const int pk = sPos[buf * 64 + sub * 32 + kk];
              int dist = posq - pk;
              dist = dist < 0 ? 0 : (dist > 127 ? 127 : dist);
              const float bias = sBias[dist * 8 + hdl];
              const float negm = ((wd >> kk) & 1u) ? 0.f : -INFINITY;
              u[i] = (s[i] + bias) + negm;
            }
          }
          if (fastsm) {
            float ls = 0.f;
#pragma unroll
            for (int i = 0; i < 16; ++i) { pv[i] = fexp2(u[i]); ls += pv[i]; }
            lrun += ls;
          } else {
          float mx = u[0];
#pragma unroll
          for (int i = 1; i < 16; ++i) mx = fmaxf(mx, u[i]);
          mx = xmax32(mx);
          const float mnew = fmaxf(mrun, mx);
          const float muse = (mnew == -INFINITY) ? 0.f : mnew;
          const float alpha = fexp2(mrun - muse);
          float ls = 0.f;
#pragma unroll
          for (int i = 0; i < 16; ++i) { pv[i] = fexp2(u[i] - muse); ls += pv[i]; }
          lrun = lrun * alpha + ls;
          mrun = mnew;
          if (__any(alpha != 1.f)) {
#pragma unroll
            for (int i = 0; i < 16; ++i) { o[0][i] *= alpha; o[1][i] *= alpha; }
          }
          }
        }
#pragma unroll
        for (int sidx = 0; sidx < 2; ++sidx) {
          uint4 pk4 = make_uint4(pack2(pv[8 * sidx], pv[8 * sidx + 1]), pack2(pv[8 * sidx + 2], pv[8 * sidx + 3]),
                                 pack2(pv[8 * sidx + 4], pv[8 * sidx + 5]), pack2(pv[8 * sidx + 6], pv[8 * sidx + 7]));
          bf16x8 pf = __builtin_bit_cast(bf16x8, pk4);
#pragma unroll
          for (int dt = 0; dt < 2; ++dt) {
            const u16* vp = &sV[buf][dt * 32 + r][sub * 32 + 16 * sidx + 4 * h];
            uint2 lo = *(const uint2*)vp;
            uint2 hi = *(const uint2*)(vp + 8);
            bf16x8 va = __builtin_bit_cast(bf16x8, make_uint4(lo.x, lo.y, hi.x, hi.y));
            o[dt] = MFMA32(va, pf, o[dt]);
          }
        }
      }
    }
    if (more) ATT_SSTORE(buf ^ 1);
    if (step + 2 < nt64) ATT_GLOAD((MODE == 0) ? kt - 2 : kt + 2);
    if (MODE == 0) {
      const int alive = __any(carry >= 5.42101086e-20f) ? 1 : 0;
      if (!__syncthreads_or(alive)) break;
    } else {
      __syncthreads();
    }
  }
  float inv = 1.f;
  if (MODE != 0) { const float lt = xsum32(lrun); inv = 1.f / lt; }
  const size_t tok = (size_t)(tokbase + tq);
  const u16* zrow = PROJ + tok * LDP + O_ZA + MODE * 512 + hdl * 64;
  u16* yrow = YBR + tok * LDY + MODE * 512 + hdl * 64;
#pragma unroll
  for (int dt = 0; dt < 2; ++dt)
#pragma unroll
    for (int g = 0; g < 4; ++g) {
      const int d4 = dt * 32 + 8 * g + 4 * h;
      uint2 zu = *(const uint2*)(zrow + d4);
      float z0 = bflo(zu.x), z1 = bfhi(zu.x), z2 = bflo(zu.y), z3 = bfhi(zu.y);
      float y0 = o[dt][4 * g] * inv, y1 = o[dt][4 * g + 1] * inv, y2 = o[dt][4 * g + 2] * inv, y3 = o[dt][4 * g + 3] * inv;
      y0 *= z0 * fsigmoid(z0); y1 *= z1 * fsigmoid(z1); y2 *= z2 * fsigmoid(z2); y3 *= z3 * fsigmoid(z3);
      *(uint2*)(yrow + d4) = make_uint2(pack2(y0, y1), pack2(y2, y3));
    }
}

DI void phase_branch(const Params& p, int layer, char* smem, int xcd, int loc, int nloc) {
  const char* wset = p.ws + WS_WT + (size_t)(layer & 1) * SZ_WSET;
  const u16* WBR = (const u16*)(wset + OFF_WT_BR);
  const u16* YBR = (const u16*)(p.ws + WS_YBR);
  const u16* PROJ = (const u16*)(p.ws + WS_PROJ);
  u16* MG = (u16*)(p.ws + WS_MERGED);
  const int tid = opaque_tid(), lane = tid & 63, wave = __builtin_amdgcn_readfirstlane(tid >> 6), r = lane & 31, h = lane >> 5;
  const int wn = wave & 1, wm = wave >> 1;
  for (int i = loc;; i += nloc) {
    int mt, nt;
    if (!tile_order<8>(i, xcd, mt, nt)) break;
    const int m0 = mt * 128, d0 = nt * 128;
    f32x16 sum[2][2];
    sum[0][0] = zero16(); sum[0][1] = zero16(); sum[1][0] = zero16(); sum[1][1] = zero16();
#pragma unroll 1
    for (int n = 0; n < 3; ++n) {
      f32x16 acc[2][2];
      acc[0][0] = zero16(); acc[0][1] = zero16(); acc[1][0] = zero16(); acc[1][1] = zero16();
      gemm128(WBR + ((size_t)n * 1024 + d0) * LDB, LDB, YBR + (size_t)m0 * LDY + n * 512, LDY, 512, acc, smem);
      const float* gb = p.gate_b + ((size_t)layer * 3 + n) * 1024;
#pragma unroll
      for (int mi = 0; mi < 2; ++mi) {
        const int m = m0 + wm * 64 + mi * 32 + r;
#pragma unroll
        for (int ni = 0; ni < 2; ++ni)
#pragma unroll
          for (int g = 0; g < 4; ++g) {
            const int d4 = d0 + wn * 64 + ni * 32 + 8 * g + 4 * h;
            uint2 gu = *(const uint2*)(PROJ + (size_t)m * LDP + O_G + n * 1024 + d4);
            float4 bb = *(const float4*)(gb + d4);
            float g0 = bflo(gu.x) + bb.x, g1 = bfhi(gu.x) + bb.y, g2 = bflo(gu.y) + bb.z, g3 = bfhi(gu.y) + bb.w;
            sum[ni][mi][4 * g] += acc[ni][mi][4 * g] * fsigmoid(g0);
            sum[ni][mi][4 * g + 1] += acc[ni][mi][4 * g + 1] * fsigmoid(g1);
            sum[ni][mi][4 * g + 2] += acc[ni][mi][4 * g + 2] * fsigmoid(g2);
            sum[ni][mi][4 * g + 3] += acc[ni][mi][4 * g + 3] * fsigmoid(g3);
          }
      }
    }
#pragma unroll
    for (int mi = 0; mi < 2; ++mi) {
      const int m = m0 + wm * 64 + mi * 32 + r;
#pragma unroll
      for (int ni = 0; ni < 2; ++ni)
#pragma unroll
        for (int g = 0; g < 4; ++g) {
          const int d4 = d0 + wn * 64 + ni * 32 + 8 * g + 4 * h;
          *(uint2*)(MG + (size_t)m * LDX + d4) = make_uint2(pack2(sum[ni][mi][4 * g], sum[ni][mi][4 * g + 1]), pack2(sum[ni][mi][4 * g + 2], sum[ni][mi][4 * g + 3]));
        }
    }
  }
}

DI void phase_out(const Params& p, int layer, char* smem, int xcd, int loc, int nloc) {
  const char* wset = p.ws + WS_WT + (size_t)(layer & 1) * SZ_WSET;
  const u16* WOUT = (const u16*)(wset + OFF_WT_OUT);
  const u16* MG = (const u16*)(p.ws + WS_MERGED);
  u16* XB = (u16*)(p.ws + WS_XB);
  float* XSS = (float*)(p.ws + WS_XSS);
  const float* xin = (layer == 0) ? p.x : p.out;
  const int tid = opaque_tid(), lane = tid & 63, wave = __builtin_amdgcn_readfirstlane(tid >> 6), r = lane & 31, h = lane >> 5;
  const int wn = wave & 1, wm = wave >> 1;
  for (int i = loc;; i += nloc) {
    int mt, nt;
    if (!tile_order<8>(i, xcd, mt, nt)) break;
    const int m0 = mt * 128, n0 = nt * 128;
    f32x16 acc[2][2];
    acc[0][0] = zero16(); acc[0][1] = zero16(); acc[1][0] = zero16(); acc[1][1] = zero16();
    gemm128(WOUT + (size_t)n0 * LDX, LDX, MG + (size_t)m0 * LDX, LDX, 1024, acc, smem);
#pragma unroll
    for (int mi = 0; mi < 2; ++mi) {
      const int m = m0 + wm * 64 + mi * 32 + r;
      float ss = 0.f;
#pragma unroll
      for (int ni = 0; ni < 2; ++ni)
#pragma unroll
        for (int g = 0; g < 4; ++g) {
          const int n4 = n0 + wn * 64 + ni * 32 + 8 * g + 4 * h;
          float4 xo = *(const float4*)(xin + (size_t)m * 1024 + n4);
          xo.x += acc[ni][mi][4 * g]; xo.y += acc[ni][mi][4 * g + 1]; xo.z += acc[ni][mi][4 * g + 2]; xo.w += acc[ni][mi][4 * g + 3];
          *(float4*)(p.out + (size_t)m * 1024 + n4) = xo;
          *(uint2*)(XB + (size_t)m * LDX + n4) = make_uint2(pack2(xo.x, xo.y), pack2(xo.z, xo.w));
          ss += xo.x * xo.x + xo.y * xo.y + xo.z * xo.z + xo.w * xo.w;
        }
      ss += xor32(ss);
      if (h == 0) XSS[(size_t)m * 16 + nt * 2 + wn] = ss;
    }
  }
}

DI void phase_init(const Params& p) {
  u16* XB = (u16*)(p.ws + WS_XB);
  float* XSS = (float*)(p.ws + WS_XSS);
  const int lane = threadIdx.x & 63;
  const int gw = blockIdx.x * 4 + (threadIdx.x >> 6), nw = gridDim.x * 4;
  for (int row = gw; row < NTOK; row += nw) {
    const float* xr = p.x + (size_t)row * 1024;
    float ss = 0.f;
#pragma unroll
    for (int i = 0; i < 4; ++i) {
      float4 v = *(const float4*)(xr + i * 256 + lane * 4);
      ss += v.x * v.x + v.y * v.y + v.z * v.z + v.w * v.w;
      *(uint2*)(XB + (size_t)row * LDX + i * 256 + lane * 4) = make_uint2(pack2(v.x, v.y), pack2(v.z, v.w));
    }
#pragma unroll
    for (int off = 32; off >= 1; off >>= 1) ss += __shfl_xor(ss, off);
    if (lane < 16) XSS[(size_t)row * 16 + lane] = (lane == 0) ? ss : 0.f;
  }
  if (blockIdx.x == 0 && threadIdx.x < 64) ((int*)(p.ws + WS_CTR))[threadIdx.x] = 0;
}


#ifndef DUP_MASK
#define DUP_MASK 0
#endif
constexpr int SMEM_BYTES = 73728;
constexpr int N_PHASES = 1 + 5 * DEPTH;

__global__ void __launch_bounds__(256, 2) hybrid_megakernel(Params p, int ph_lo, int ph_hi, int do_sync) {
  __shared__ __attribute__((aligned(16))) char smem[SMEM_BYTES];
  __shared__ int s_item;
  __shared__ uint4 xb_words;
  const int tid = threadIdx.x, bid = blockIdx.x, nb = gridDim.x;
  __shared__ int s_xinfo[4];
  if (tid == 0) { xb_words = make_uint4(0u, 0u, 0u, 0u); s_xinfo[3] = 0; }
  __syncthreads();
  XcdBarrier xb = xcd_barrier_post((unsigned*)(p.ws + WS_BAR), (volatile LAS unsigned*)&xb_words);
  if (tid == 0) s_xinfo[1] = (int)xb_add((unsigned*)(p.ws + WS_BAR) + 8 * xb.x, 1u);
  int t_cls = bid & 7, t_loc = bid >> 3, t_step = (nb - (bid & 7) + 7) >> 3;
  for (int ph = ph_lo; ph < ph_hi; ++ph) {
    if (ph == 0) {
      phase_init(p);
      for (int it = bid; it < CV_TOTAL; it += nb) convert_item(p, 0, it, (float*)smem);
    } else {
      const int layer = (ph - 1) / 5, sub = (ph - 1) % 5;
      if (sub == 0) {
        phase_proj(p, layer, smem, t_cls, t_loc, t_step);
        if (DUP_MASK & 1) { __syncthreads(); phase_proj(p, layer, smem, t_cls, t_loc, t_step); }
        if (DUP_MASK & 16) { __syncthreads(); phase_proj_probe(p, layer, smem, t_cls, t_loc, t_step); }
      } else if (sub == 1) {
        const int ncv = (layer + 1 < DEPTH) ? CV_TOTAL : 0;
        const int total = 4096 + 1024 + ncv;
        for (int rep = 0; rep < ((DUP_MASK & 4) ? 2 : 1); ++rep)
        for (int it = bid; it < total; it += nb) {
          if (it < 4096) select_item(p, it, smem);
          else if (it < 5120) prep_item(p, layer, (it - 4096) * 4 + (tid >> 6));
          else convert_item(p, layer + 1, it - 5120, (float*)smem);
        }
      } else if (sub == 2) {
        const bool fast1 = softmax_bound_ok(p, layer, 1), fast2 = softmax_bound_ok(p, layer, 2);
        const bool xq = (s_xinfo[3] == 8);
        int* ctr = (int*)(p.ws + WS_CTR) + (xq ? (16 + layer * 8 + t_cls) : layer);
        const int limit = xq ? 384 : 3072;
        while (true) {
          if (tid == 0) s_item = atomicAdd(ctr, 1);
          __syncthreads();
          const int w = s_item;
          __syncthreads();
          if (w >= limit) break;
          int type, b, hd, d, jt;
          if (xq) {
            const int level = w / 12, within = w - level * 12;
            d = 31 - level;
            type = within >> 2;
            const int pr = 4 * t_cls + (within & 3);
            b = (type == 2) ? (t_cls >> 1) : (pr >> 3);
            hd = pr & 7;
            jt = d * 8 + 2 * (within & 3) + (t_cls & 1);
          } else {
            d = 31 - w / 96;
            const int within = w % 96, idx = within & 31;
            type = within >> 5; b = idx >> 3; hd = idx & 7; jt = d * 8 + (idx & 7);
          }
          if (type == 0) attn_item<0, false>(p, layer, b, hd, d, smem);
          else if (type == 1) { if (fast1) attn_item<1, true>(p, layer, b, hd, d, smem); else attn_item<1, false>(p, layer, b, hd, d, smem); }
          else { if (fast2) attn_item<2, true>(p, layer, b, 0, jt, smem); else attn_item<2, false>(p, layer, b, 0, jt, smem); }
        }
      } else if (sub == 3) {
        phase_branch(p, layer, smem, t_cls, t_loc, t_step);
        if (DUP_MASK & 8) { __syncthreads(); phase_branch(p, layer, smem, t_cls, t_loc, t_step); }
      } else {
        phase_out(p, layer, smem, t_cls, t_loc, t_step);
      }
    }
    if (do_sync == 2) cg::this_grid().sync();
    if (do_sync && ph + 1 < ph_hi) {
      xcd_barrier(xb);
      if (ph == ph_lo) {
        if (tid == 0) {
          unsigned* bar = (unsigned*)(p.ws + WS_BAR);
          int xi = 0;
          for (unsigned j = 0; j < xb.x; ++j) xi += (xb_ld(&bar[XB_XCNT(j)]) > 0u) ? 1 : 0;
          s_xinfo[0] = xi; s_xinfo[2] = (int)xb_words.x; s_xinfo[3] = (int)xb_words.y;
        }
        __syncthreads();
        if (s_xinfo[3] == 8) { t_cls = s_xinfo[0]; t_loc = s_xinfo[1]; t_step = s_xinfo[2]; }
      }
    }
  }
}

#ifndef MK_MULTI
#define MK_MULTI 0
#endif

extern "C" void kernel_launch(void* const* d_in, const int* in_sizes, int n_in, void* d_out, int out_size, void* d_ws,
                              size_t ws_size, hipStream_t stream) {
  (void)in_sizes; (void)n_in; (void)out_size;
  if (ws_size < WS_TOTAL) { fprintf(stderr, "workspace too small: %zu < %zu\n", ws_size, (size_t)WS_TOTAL); return; }
  Params p{};
  p.x = (const float*)d_in[0]; p.pos = (const int*)d_in[1]; p.norm_g = (const float*)d_in[2]; p.w_in = (const float*)d_in[3];
  p.qn_g = (const float*)d_in[4]; p.kvn_g = (const float*)d_in[5]; p.w_uq = (const float*)d_in[6]; p.w_ukv = (const float*)d_in[7];
  p.mla_q_g = (const float*)d_in[8]; p.mla_k_g = (const float*)d_in[9]; p.dsa_q_g = (const float*)d_in[10]; p.dsa_k_g = (const float*)d_in[11];
  p.rel_bias = (const float*)d_in[12]; p.gate_b = (const float*)d_in[13]; p.w_branch = (const float*)d_in[14]; p.w_out = (const float*)d_in[15];
  p.out = (float*)d_out; p.ws = (char*)d_ws;
  static int grid_blocks = 0;
  if (!grid_blocks) {
    int dev = 0, cus = 0, per_cu = 0;
    hipGetDevice(&dev);
    hipDeviceGetAttribute(&cus, hipDeviceAttributeMultiprocessorCount, dev);
    hipOccupancyMaxActiveBlocksPerMultiprocessor(&per_cu, hybrid_megakernel, 256, 0);
    if (per_cu > 2) per_cu = 2;
    grid_blocks = cus * per_cu;
    if (grid_blocks < 8) grid_blocks = 8;
  }
#if MK_MULTI
  for (int ph = 0; ph < N_PHASES; ++ph) {
    hipLaunchKernelGGL(hybrid_megakernel, dim3(grid_blocks), dim3(256), 0, stream, p, ph, ph + 1, 0);
  }
#else
  hipMemsetAsync((char*)d_ws + WS_BAR, 0, 32768, stream);
  int lo = 0, hi = N_PHASES, sy = 1;
  void* args[] = {&p, &lo, &hi, &sy};
  hipError_t e = hipLaunchCooperativeKernel((void*)hybrid_megakernel, dim3(grid_blocks), dim3(256), args, 0, stream);
  if (e != hipSuccess) fprintf(stderr, "cooperative launch failed: %s (grid %d)\n", hipGetErrorString(e), grid_blocks);
#endif
}
```

```cpp
#include <hip/hip_runtime.h>
#include <hip/hip_cooperative_groups.h>
#include <stdint.h>
#include <stdio.h>
namespace cg = cooperative_groups;

typedef unsigned short u16;
typedef __attribute__((ext_vector_type(8))) short bf16x8;
typedef __attribute__((ext_vector_type(16))) float f32x16;
typedef __attribute__((ext_vector_type(2))) float f2_t;
typedef __attribute__((ext_vector_type(2))) __bf16 bf2_t;

#define DI __device__ __forceinline__
#ifndef STAGE_LDS
#define STAGE_LDS 1
#endif
#ifndef BIS1
#define BIS1 0
#endif
#ifndef SEL_NOGUARD
#define SEL_NOGUARD 0
#endif
#define MFMA32(a, b, c) __builtin_amdgcn_mfma_f32_32x32x16_bf16((a), (b), (c), 0, 0, 0)

constexpr int SEQ = 4096, NTOK = 16384, DEPTH = 4;
constexpr int D_IN = 7496, NP = 7552;
constexpr int N_DSV = 2496, N_KPEIXK = 2816;
constexpr int LDP = 6016;
constexpr int LDX = 1088, LDB = 576, LDY = 1600;
constexpr int O_CQ = 0, O_CKV = 256, O_DSQ = 384, O_DSK = 896, O_IXQ = 1024, O_KPE = 1280, O_ZA = 1344, O_G = 2880, O_IXW = 5952;
constexpr float LOG2E = 1.4426950408889634f;
constexpr float C_SB = 0.125f * LOG2E;
constexpr float C_MLA = 0.10206207261596577f * LOG2E;
constexpr float EPS = 1e-6f;

constexpr size_t SZ_WT_IN = (size_t)NP * LDX * 2, SZ_WT_UQ = 768 * 256 * 2, SZ_WT_UKV = 1024 * 128 * 2,
                 SZ_WT_BR = 3 * 1024 * LDB * 2, SZ_WT_OUT = 1024 * LDX * 2;
constexpr size_t OFF_WT_UQ = SZ_WT_IN, OFF_WT_UKV = OFF_WT_UQ + SZ_WT_UQ, OFF_WT_BR = OFF_WT_UKV + SZ_WT_UKV,
                 OFF_WT_OUT = OFF_WT_BR + SZ_WT_BR, SZ_WSET = OFF_WT_OUT + SZ_WT_OUT;
constexpr size_t WS_WT = 0;
constexpr size_t WS_XB = WS_WT + 2 * SZ_WSET;
constexpr size_t WS_XSS = WS_XB + (size_t)NTOK * LDX * 2;
constexpr size_t WS_PROJ = WS_XSS + (size_t)NTOK * 16 * 4;
constexpr size_t WS_QB = WS_PROJ + (size_t)NTOK * LDP * 2;
constexpr size_t WS_KB = WS_QB + (size_t)NTOK * 768 * 2;
constexpr size_t WS_VTA = WS_KB + (size_t)NTOK * 768 * 2;
constexpr size_t WS_VTB = WS_VTA + (size_t)NTOK * 512 * 2;
constexpr size_t WS_VTC = WS_VTB + (size_t)NTOK * 512 * 2;
constexpr size_t WS_YBR = WS_VTC + (size_t)NTOK * 64 * 2;
constexpr size_t WS_BM = WS_YBR + (size_t)NTOK * LDY * 2;
constexpr size_t WS_QA = WS_BM + (size_t)NTOK * 128 * 4;
constexpr size_t WS_KA = WS_QA + (size_t)NTOK * 512 * 2;
constexpr size_t WS_DSQ = WS_KA + (size_t)NTOK * 512 * 2;
constexpr size_t WS_DSK = WS_DSQ + (size_t)NTOK * 512 * 2;
constexpr size_t WS_IXK = WS_DSK + (size_t)NTOK * 64 * 2;
constexpr size_t WS_CTR = WS_IXK + (size_t)NTOK * 32 * 2;
constexpr size_t WS_BAR = WS_CTR + 256;
constexpr size_t WS_PMAX = WS_BAR + 32768;
constexpr size_t WS_TOTAL = WS_PMAX + 4096;
constexpr size_t WS_MERGED = WS_QB;

struct Params {
  const float* x; const int* pos; const float* norm_g; const float* w_in; const float* qn_g; const float* kvn_g;
  const float* w_uq; const float* w_ukv; const float* mla_q_g; const float* mla_k_g; const float* dsa_q_g;
  const float* dsa_k_g; const float* rel_bias; const float* gate_b; const float* w_branch; const float* w_out;
  float* out; char* ws;
};

DI uint32_t pack2(float a, float b) { f2_t v = {a, b}; bf2_t r = __builtin_convertvector(v, bf2_t); return __builtin_bit_cast(uint32_t, r); }
DI float bflo(uint32_t u) { return __uint_as_float(u << 16); }
DI float bfhi(uint32_t u) { return __uint_as_float(u & 0xffff0000u); }
DI float bf1(u16 u) { return __uint_as_float(((uint32_t)u) << 16); }
DI u16 f2bf(float x) { return (u16)(pack2(x, 0.f) & 0xffffu); }
DI float xor32(float v) { return __shfl_xor(v, 32); }
DI float xsum32(float v) { unsigned u = __float_as_uint(v); auto r = __builtin_amdgcn_permlane32_swap(u, u, false, false); return __uint_as_float(r[0]) + __uint_as_float(r[1]); }
DI float xmax32(float v) { unsigned u = __float_as_uint(v); auto r = __builtin_amdgcn_permlane32_swap(u, u, false, false); return fmaxf(__uint_as_float(r[0]), __uint_as_float(r[1])); }
DI int crow(int reg, int h) { return (reg & 3) + 8 * (reg >> 2) + 4 * h; }
DI float fexp2(float x) { return __builtin_amdgcn_exp2f(x); }
DI float frcp(float x) { return __builtin_amdgcn_rcpf(x); }
DI int opaque_tid() { int t = threadIdx.x; asm volatile("" : "+v"(t)); return t; }
DI float fsigmoid(float x) { return frcp(1.f + fexp2(-LOG2E * x)); }
DI f32x16 zero16() { f32x16 z; _Pragma("unroll") for (int i = 0; i < 16; ++i) z[i] = 0.f; return z; }

#define XB_TMO      128
#define XB_XCNT(j)  (256  + 64 * (j))
#define XB_XSUB(j)  (1280 + 64 * (j))
#define XB_XGEN(j)  (2304 + 64 * (j))
#define XB_TOP      3328
#define XB_TOPGEN   3392
#define XCD_BAR_WORDS 3456
#define XB_SPIN_CAP (1u << 22)
#define LAS __attribute__((address_space(3)))
DI unsigned xb_ld(unsigned* p) { return __hip_atomic_load(p, __ATOMIC_RELAXED, __HIP_MEMORY_SCOPE_AGENT); }
DI unsigned xb_add(unsigned* p, unsigned v) { return __hip_atomic_fetch_add(p, v, __ATOMIC_RELAXED, __HIP_MEMORY_SCOPE_AGENT); }
DI unsigned xb_xcc_id() { return (unsigned)__builtin_amdgcn_s_getreg((3 << 11) | 20) & 0xFu; }
#define XB_SPIN(cond, bar) do { unsigned _sp = 0; while (cond) { __builtin_amdgcn_s_sleep(1); \
    if ((++_sp & 255u) == 0u) { if (xb_ld(&(bar)[XB_TMO])) break; if (_sp > XB_SPIN_CAP) { atomicAdd(&(bar)[XB_TMO], 1u); break; } } } } while (0)
struct XcdBarrier { unsigned* bar; unsigned x; volatile LAS unsigned* st; };
DI XcdBarrier xcd_barrier_post(unsigned* bar, volatile LAS unsigned* st) {
  XcdBarrier b; b.bar = bar; b.x = xb_xcc_id(); b.st = st;
  if (threadIdx.x == 0) (void)xb_add(&bar[XB_XCNT(b.x)], 1u);
  return b;
}
DI void xcd_barrier_complete(unsigned* bar, unsigned x, unsigned& nloc, unsigned& nx) {
  const unsigned G = gridDim.x * gridDim.y * gridDim.z;
  unsigned sum, cnt, mine, sp = 0u;
  for (;;) {
    sum = 0u; cnt = 0u; mine = 0u;
#pragma unroll
    for (unsigned j = 0; j < 16; ++j) { const unsigned c = xb_ld(&bar[XB_XCNT(j)]); sum += c; cnt += (c > 0u) ? 1u : 0u; mine = (j == x) ? c : mine; }
    if (sum == G) break;
    __builtin_amdgcn_s_sleep(1);
    if ((++sp & 255u) == 0u) { if (xb_ld(&bar[XB_TMO])) break; if (sp > XB_SPIN_CAP) { atomicAdd(&bar[XB_TMO], 1u); break; } }
  }
  nloc = mine > 0u ? mine : 1u; nx = cnt > 0u ? cnt : 1u;
}
DI void xcd_barrier(const XcdBarrier& b) {
  asm volatile("s_waitcnt vmcnt(0)" ::: "memory");
  __syncthreads();
  if (threadIdx.x == 0) {
    unsigned* bar = b.bar;
    __builtin_amdgcn_s_waitcnt(0);
    unsigned nloc = b.st[0], nx = b.st[1];
    if (nloc == 0u) { xcd_barrier_complete(bar, b.x, nloc, nx); b.st[0] = nloc; b.st[1] = nx; }
    const unsigned old = xb_add(&bar[XB_XSUB(b.x)], 1u);
    const unsigned gen = old / nloc;
    if (old + 1u == (gen + 1u) * nloc) {
      __builtin_amdgcn_fence(__ATOMIC_RELEASE, "agent");
      asm volatile("s_waitcnt vmcnt(0)" ::: "memory");
      const unsigned og = xb_add(&bar[XB_TOP], 1u);
      const unsigned tg = og / nx;
      if (og + 1u == (tg + 1u) * nx) xb_add(&bar[XB_TOPGEN], 1u);
      else XB_SPIN(xb_ld(&bar[XB_TOPGEN]) == tg, bar);
      __builtin_amdgcn_fence(__ATOMIC_ACQUIRE, "agent");
      xb_add(&bar[XB_XGEN(b.x)], 1u);
      asm volatile("s_waitcnt vmcnt(0)" ::: "memory");
    } else {
      XB_SPIN(xb_ld(&bar[XB_XGEN(b.x)]) == gen, bar);
      __builtin_amdgcn_fence(__ATOMIC_ACQUIRE, "agent");
      asm volatile("s_waitcnt vmcnt(0)" ::: "memory");
    }
  }
  __syncthreads();
}

#define XB_RND(j) (3456 + 64 * (j))
DI void class_round_sync(unsigned* bar, int cls, int members) {
  __syncthreads();
  if (threadIdx.x == 0) {
    const unsigned t = xb_add(&bar[XB_RND(cls)], 1u);
    const unsigned target = (t / (unsigned)members + 1u) * (unsigned)members;
    unsigned sp = 0;
    while (xb_ld(&bar[XB_RND(cls)]) < target) { __builtin_amdgcn_s_sleep(1); if (++sp > (1u << 16)) break; }
  }
  __syncthreads();
}

DI int src_col(int n) {
  if (n < 1920) return n;
  if (n < 2816) return n + 32;
  if (n < 2848) return n - 896;
  if (n < 2880) return n;
  if (n < 7488) return n + 8;
  if (n < 7496) return n - 4608;
  return -1;
}
template <bool MAP>
DI void transpose_tile(const float* __restrict__ src, int N, int K, int Nvalid, const float* __restrict__ g,
                       u16* __restrict__ dst, int ldd, int k0, int n0, float* sT) {
  const int tid = opaque_tid();
  const int cg = (tid & 15) * 4, kq = tid >> 4;
  const int sc = MAP ? src_col(n0 + cg) : ((n0 + cg < Nvalid) ? n0 + cg : -1);
#pragma unroll
  for (int i = 0; i < 4; ++i) {
    const int kk = i * 16 + kq;
    float4 v = make_float4(0.f, 0.f, 0.f, 0.f);
    if (sc >= 0) {
      v = *(const float4*)(src + (size_t)(k0 + kk) * N + sc);
      if (g) { const float gg = g[k0 + kk]; v.x *= gg; v.y *= gg; v.z *= gg; v.w *= gg; }
    }
    float* d = sT + kk * 65 + cg;
    d[0] = v.x; d[1] = v.y; d[2] = v.z; d[3] = v.w;
  }
  __syncthreads();
  const int n = tid >> 2, kc = (tid & 3) * 16;
  uint32_t o[8];
#pragma unroll
  for (int j = 0; j < 8; ++j) o[j] = pack2(sT[(kc + 2 * j) * 65 + n], sT[(kc + 2 * j + 1) * 65 + n]);
  uint4* d = (uint4*)(dst + (size_t)(n0 + n) * ldd + k0 + kc);
  d[0] = make_uint4(o[0], o[1], o[2], o[3]);
  d[1] = make_uint4(o[4], o[5], o[6], o[7]);
  __syncthreads();
}

constexpr int CV_IN = 16 * 118, CV_UQ = 4 * 12, CV_UKV = 2 * 16, CV_BR = 3 * 8 * 16, CV_OUT = 16 * 16;
constexpr int CV_TOTAL = CV_IN + CV_UQ + CV_UKV + CV_BR + CV_OUT;

DI void convert_item(const Params& p, int layer, int item, float* sT) {
  char* wset = p.ws + WS_WT + (size_t)(layer & 1) * SZ_WSET;
  if (item < CV_IN) {
    int kt = item & 15, nt = item >> 4;
    transpose_tile<true>(p.w_in + (size_t)layer * 1024 * D_IN, D_IN, 1024, D_IN, p.norm_g + layer * 1024, (u16*)wset, LDX, kt * 64, nt * 64, sT);
    return;
  }
  item -= CV_IN;
  if (item < CV_UQ) {
    int kt = item & 3, nt = item >> 2;
    transpose_tile<false>(p.w_uq + (size_t)layer * 256 * 768, 768, 256, 768, p.qn_g + layer * 256, (u16*)(wset + OFF_WT_UQ), 256, kt * 64, nt * 64, sT);
    return;
  }
  item -= CV_UQ;
  if (item < CV_UKV) {
    int kt = item & 1, nt = item >> 1;
    transpose_tile<false>(p.w_ukv + (size_t)layer * 128 * 1024, 1024, 128, 1024, p.kvn_g + layer * 128, (u16*)(wset + OFF_WT_UKV), 128, kt * 64, nt * 64, sT);
    return;
  }
  item -= CV_UKV;
  if (item < CV_BR) {
    int br = item >> 7, rem = item & 127, kt = rem & 7, nt = rem >> 3;
    transpose_tile<false>(p.w_branch + ((size_t)layer * 3 + br) * 512 * 1024, 1024, 512, 1024, nullptr,
                   (u16*)(wset + OFF_WT_BR) + (size_t)br * 1024 * LDB, LDB, kt * 64, nt * 64, sT);
    return;
  }
  item -= CV_BR;
  {
    int kt = item & 15, nt = item >> 4;
    transpose_tile<false>(p.w_out + (size_t)layer * 1024 * 1024, 1024, 1024, 1024, nullptr, (u16*)(wset + OFF_WT_OUT), LDX, kt * 64, nt * 64, sT);
  }
}

DI void gemm128(const u16* __restrict__ W, int ldw, const u16* __restrict__ X, int ldx, int K, f32x16 (&acc)[2][2], char* smem) {
  typedef u16 (*tile_t)[128][72];
  tile_t sw = (tile_t)smem;
  tile_t sx = (tile_t)(smem + 2 * 128 * 72 * 2);
  const int tid = opaque_tid(), lane = tid & 63, wave = __builtin_amdgcn_readfirstlane(tid >> 6), r = lane & 31, h = lane >> 5;
  const int wn = wave & 1, wm = wave >> 1;
  const int lc = tid & 7, lr = tid >> 3;
  const u16* gw = W + (size_t)lr * ldw + lc * 8;
  const u16* gx = X + (size_t)lr * ldx + lc * 8;
  const u16* gw1 = gw + (size_t)32 * ldw; const u16* gw2 = gw + (size_t)64 * ldw; const u16* gw3 = gw + (size_t)96 * ldw;
  const u16* gx1 = gx + (size_t)32 * ldx; const u16* gx2 = gx + (size_t)64 * ldx; const u16* gx3 = gx + (size_t)96 * ldx;
  uint4 rw0, rw1, rw2, rw3, rx0, rx1, rx2, rx3;
#define G_LOAD(KOFF) do { rw0 = *(const uint4*)(gw + (KOFF)); rw1 = *(const uint4*)(gw1 + (KOFF)); rw2 = *(const uint4*)(gw2 + (KOFF)); rw3 = *(const uint4*)(gw3 + (KOFF)); \
                          rx0 = *(const uint4*)(gx + (KOFF)); rx1 = *(const uint4*)(gx1 + (KOFF)); rx2 = *(const uint4*)(gx2 + (KOFF)); rx3 = *(const uint4*)(gx3 + (KOFF)); } while (0)
#define G_STORE(BUF) do { *(uint4*)&sw[(BUF)][lr][lc * 8] = rw0; *(uint4*)&sw[(BUF)][lr + 32][lc * 8] = rw1; *(uint4*)&sw[(BUF)][lr + 64][lc * 8] = rw2; *(uint4*)&sw[(BUF)][lr + 96][lc * 8] = rw3; \
                          *(uint4*)&sx[(BUF)][lr][lc * 8] = rx0; *(uint4*)&sx[(BUF)][lr + 32][lc * 8] = rx1; *(uint4*)&sx[(BUF)][lr + 64][lc * 8] = rx2; *(uint4*)&sx[(BUF)][lr + 96][lc * 8] = rx3; } while (0)
  G_LOAD(0);
  G_STORE(0);
  const int nk = K >> 6;
  G_LOAD(64);
  __syncthreads();
  for (int kt = 0; kt < nk; ++kt) {
    const int buf = kt & 1;
#pragma unroll
    for (int ks = 0; ks < 4; ++ks) {
      bf16x8 a0 = *(const bf16x8*)&sw[buf][wn * 64 + r][ks * 16 + h * 8];
      bf16x8 a1 = *(const bf16x8*)&sw[buf][wn * 64 + 32 + r][ks * 16 + h * 8];
      bf16x8 b0 = *(const bf16x8*)&sx[buf][wm * 64 + r][ks * 16 + h * 8];
      bf16x8 b1 = *(const bf16x8*)&sx[buf][wm * 64 + 32 + r][ks * 16 + h * 8];
      acc[0][0] = MFMA32(a0, b0, acc[0][0]);
      acc[0][1] = MFMA32(a0, b1, acc[0][1]);
      acc[1][0] = MFMA32(a1, b0, acc[1][0]);
      acc[1][1] = MFMA32(a1, b1, acc[1][1]);
    }
    if (kt + 1 < nk) G_STORE(buf ^ 1);
    if (kt + 2 < nk) G_LOAD((kt + 2) * 64);
    __syncthreads();
  }
#undef G_LOAD
#undef G_STORE
}

template <int NT>
DI bool tile_order(int i, int xcd, int& mt, int& nt) {
  constexpr int PER = 8 * NT;
  if (i >= 2 * PER) return false;
  int mh = i / PER, j = i - mh * PER;
  int ng = j >> 6, w = j & 63;
  mt = xcd * 16 + mh * 8 + (w & 7);
  nt = ng * 8 + (w >> 3);
  return true;
}

DI void phase_proj(const Params& p, int layer, char* smem, int xcd, int loc, int nloc) {
  const u16* WT = (const u16*)(p.ws + WS_WT + (size_t)(layer & 1) * SZ_WSET);
  const u16* XB = (const u16*)(p.ws + WS_XB);
  const float* XSS = (const float*)(p.ws + WS_XSS);
  u16* PROJ = (u16*)(p.ws + WS_PROJ);
  u16* VTA = (u16*)(p.ws + WS_VTA);
  u16* VTC = (u16*)(p.ws + WS_VTC);
  const int tid = opaque_tid(), lane = tid & 63, wave = __builtin_amdgcn_readfirstlane(tid >> 6), r = lane & 31, h = lane >> 5;
  const int wn = wave & 1, wm = wave >> 1;
  for (int i = loc;; i += nloc) {
    int mt, nt;
    if (!tile_order<59>(i, xcd, mt, nt)) break;
    const int m0 = mt * 128, n0 = nt * 128;
    f32x16 acc[2][2];
    acc[0][0] = zero16(); acc[0][1] = zero16(); acc[1][0] = zero16(); acc[1][1] = zero16();
    float rinv2[2];
#pragma unroll
    for (int mi = 0; mi < 2; ++mi) {
      const float4* sp = (const float4*)(XSS + (size_t)(m0 + wm * 64 + mi * 32 + r) * 16);
      float4 q0 = sp[0], q1 = sp[1], q2 = sp[2], q3 = sp[3];
      float ss = ((q0.x + q0.y) + (q0.z + q0.w)) + ((q1.x + q1.y) + (q1.z + q1.w)) + ((q2.x + q2.y) + (q2.z + q2.w)) + ((q3.x + q3.y) + (q3.z + q3.w));
      rinv2[mi] = rsqrtf(ss * (1.f / 1024.f) + EPS);
    }
    gemm128(WT + (size_t)n0 * LDX, LDX, XB + (size_t)m0 * LDX, LDX, 1024, acc, smem);
    {
      const int nb = n0 + wn * 64;
      const int mb = m0 + wm * 64;
      const int b = mb >> 12, s0 = mb & 4095;
      u16 (*st)[72] = (u16 (*)[72])(smem + ((wave & 2) ? 55296 : 18432) + (wave & 1) * 9216);
      const bool transposed = (nb >= 1024 && nb < 1536) || (nb == N_DSV);
      const float cs = (nb < 512) ? C_SB : 1.f;
      u16* dst; size_t rstride;
      if (nb < 512) { dst = (u16*)(p.ws + WS_QA) + ((size_t)(b * 8 + (nb >> 6)) * 4096 + s0) * 64; rstride = 64; }
      else if (nb < 1024) { dst = (u16*)(p.ws + WS_KA) + ((size_t)(b * 8 + ((nb - 512) >> 6)) * 4096 + s0) * 64; rstride = 64; }
      else if (nb < 1536) { dst = VTA + ((size_t)(b * 8 + ((nb - 1024) >> 6)) * 64) * 4096 + s0; rstride = 4096; }
      else if (nb == N_DSV) { dst = VTC + ((size_t)b * 64) * 4096 + s0; rstride = 4096; }
      else { dst = PROJ + (size_t)mb * LDP + (nb - 1536); rstride = LDP; }
#pragma unroll
      for (int mi = 0; mi < 2; ++mi) {
        const int m = mb + mi * 32 + r;
        const float rinv = rinv2[mi] * cs;
#pragma unroll
        for (int ni = 0; ni < 2; ++ni) {
          if (transposed) {
#pragma unroll
            for (int i = 0; i < 16; ++i) {
              if (STAGE_LDS) st[ni * 32 + crow(i, h)][mi * 32 + r] = f2bf(acc[ni][mi][i] * rinv);
              else dst[(size_t)(ni * 32 + crow(i, h)) * rstride + mi * 32 + r] = f2bf(acc[ni][mi][i] * rinv);
            }
          } else {
#pragma unroll
            for (int g = 0; g < 4; ++g) {
              const uint2 v = make_uint2(pack2(acc[ni][mi][4 * g] * rinv, acc[ni][mi][4 * g + 1] * rinv), pack2(acc[ni][mi][4 * g + 2] * rinv, acc[ni][mi][4 * g + 3] * rinv));
              if (STAGE_LDS) *(uint2*)&st[mi * 32 + r][ni * 32 + 8 * g + 4 * h] = v;
              else {
                *(uint2*)(dst + (size_t)(mi * 32 + r) * rstride + ni * 32 + 8 * g + 4 * h) = v;
                if (nb == N_KPEIXK && ni == 1) *(uint2*)((u16*)(p.ws + WS_IXK) + (size_t)m * 32 + 8 * g + 4 * h) = v;
              }
            }
          }
        }
      }
      if (STAGE_LDS) {
        __builtin_amdgcn_wave_barrier();
        asm volatile("s_waitcnt lgkmcnt(0)" ::: "memory");
        const int rr = lane >> 3, cc = lane & 7;
#pragma unroll
        for (int it = 0; it < 8; ++it) {
          const int row = it * 8 + rr;
          uint4 v = *(const uint4*)&st[row][cc * 8];
          *(uint4*)(dst + (size_t)row * rstride + cc * 8) = v;
          if (nb == N_KPEIXK && cc >= 4) *(uint4*)((u16*)(p.ws + WS_IXK) + (size_t)(mb + row) * 32 + (cc - 4) * 8) = v;
        }
      }
    }
  }
}

DI void phase_proj_probe(const Params& p, int layer, char* smem, int xcd, int loc, int nloc) {
  const u16* WT = (const u16*)(p.ws + WS_WT + (size_t)(layer & 1) * SZ_WSET);
  const u16* XB = (const u16*)(p.ws + WS_XB);
  float tot = 0.f;
  for (int i = loc;; i += nloc) {
    int mt, nt;
    if (!tile_order<59>(i, xcd, mt, nt)) break;
    f32x16 acc[2][2];
    acc[0][0] = zero16(); acc[0][1] = zero16(); acc[1][0] = zero16(); acc[1][1] = zero16();
    gemm128(WT, LDX, XB, LDX, 1024, acc, smem);
    tot += acc[0][0][0] + acc[0][1][3] + acc[1][0][5] + acc[1][1][7];
  }
  if (tot == 12345.678f) ((float*)(p.ws + WS_CTR))[32] = tot;
}

DI void prep_item(const Params& p, int layer, int item) {
  const char* wset = p.ws + WS_WT + (size_t)(layer & 1) * SZ_WSET;
  const u16* WUQ = (const u16*)(wset + OFF_WT_UQ);
  const u16* WUKV = (const u16*)(wset + OFF_WT_UKV);
  u16* PROJ = (u16*)(p.ws + WS_PROJ);
  u16* QB = (u16*)(p.ws + WS_QB);
  u16* KB = (u16*)(p.ws + WS_KB);
  u16* VTB = (u16*)(p.ws + WS_VTB);
  const int lane = opaque_tid() & 63, r = lane & 31, h = lane >> 5;
  const int tg = item >> 3, hd = item & 7;
  const int token = tg * 32 + r, b = token >> 12, s = token & 4095;
  u16* prow = PROJ + (size_t)token * LDP;

  const float posf = (float)p.pos[token];
  float cs[8], sn[8];
  {
    const float IF0[8] = {1.0f, 0.5623413251903491f, 0.31622776601683794f, 0.1778279410038923f, 0.01f, 0.005623413251903491f, 0.0031622776601683794f, 0.0017782794100389228f};
    const float IF1[8] = {0.1f, 0.05623413251903491f, 0.03162277660168379f, 0.01778279410038923f, 0.001f, 0.0005623413251903491f, 0.00031622776601683794f, 0.00017782794100389227f};
#pragma unroll
    for (int reg = 0; reg < 8; ++reg) {
      const float inv = h ? IF1[reg] : IF0[reg];
      const float ang = posf * inv;
      double rv = (double)ang * 0.15915494309189535;
      rv -= rint(rv);
      const float fr = (float)rv;
      sn[reg] = __builtin_amdgcn_sinf(fr);
      cs[reg] = __builtin_amdgcn_cosf(fr);
    }
  }

  {
    bf16x8 bq[16];
    float ss = 0.f;
#pragma unroll
    for (int ks = 0; ks < 16; ++ks) {
      uint4 u = *(const uint4*)(prow + O_CQ + ks * 16 + 8 * h);
      bq[ks] = __builtin_bit_cast(bf16x8, u);
      float f;
      f = bflo(u.x); ss += f * f; f = bfhi(u.x); ss += f * f; f = bflo(u.y); ss += f * f; f = bfhi(u.y); ss += f * f;
      f = bflo(u.z); ss += f * f; f = bfhi(u.z); ss += f * f; f = bflo(u.w); ss += f * f; f = bfhi(u.w); ss += f * f;
    }
    ss += xor32(ss);
    const float rq = rsqrtf(ss * (1.f / 256.f) + EPS);
    f32x16 acc[3];
    acc[0] = zero16(); acc[1] = zero16(); acc[2] = zero16();
    const u16* wq = WUQ + (size_t)(hd * 96 + r) * 256 + 8 * h;
#pragma unroll
    for (int ks = 0; ks < 16; ++ks) {
#pragma unroll
      for (int nt = 0; nt < 3; ++nt) {
        bf16x8 a = *(const bf16x8*)(wq + (size_t)nt * 32 * 256 + ks * 16);
        acc[nt] = MFMA32(a, bq[ks], acc[nt]);
      }
    }
    float ss2 = 0.f;
#pragma unroll
    for (int nt = 0; nt < 3; ++nt)
#pragma unroll
      for (int i = 0; i < 16; ++i) { acc[nt][i] *= rq; ss2 += acc[nt][i] * acc[nt][i]; }
    ss2 += xor32(ss2);
    const float r2 = rsqrtf(ss2 * (1.f / 96.f) + EPS);
    const float* gq = p.mla_q_g + layer * 96;
#pragma unroll
    for (int nt = 0; nt < 3; ++nt)
#pragma unroll
      for (int g = 0; g < 4; ++g) {
        float4 gg = *(const float4*)(gq + nt * 32 + 8 * g + 4 * h);
        acc[nt][4 * g] *= r2 * gg.x; acc[nt][4 * g + 1] *= r2 * gg.y; acc[nt][4 * g + 2] *= r2 * gg.z; acc[nt][4 * g + 3] *= r2 * gg.w;
      }
#pragma unroll
    for (int reg = 0; reg < 8; ++reg) {
      float x1 = acc[2][reg], x2 = acc[2][reg + 8];
      acc[2][reg] = x1 * cs[reg] - x2 * sn[reg];
      acc[2][reg + 8] = x2 * cs[reg] + x1 * sn[reg];
    }
    u16* qo = QB + ((size_t)token * 8 + hd) * 96;
#pragma unroll
    for (int nt = 0; nt < 3; ++nt)
#pragma unroll
      for (int g = 0; g < 4; ++g)
        *(uint2*)(qo + nt * 32 + 8 * g + 4 * h) = make_uint2(pack2(acc[nt][4 * g] * C_MLA, acc[nt][4 * g + 1] * C_MLA), pack2(acc[nt][4 * g + 2] * C_MLA, acc[nt][4 * g + 3] * C_MLA));
  }
  {
    bf16x8 bk[8];
    float ss = 0.f;
#pragma unroll
    for (int ks = 0; ks < 8; ++ks) {
      uint4 u = *(const uint4*)(prow + O_CKV + ks * 16 + 8 * h);
      bk[ks] = __builtin_bit_cast(bf16x8, u);
      float f;
      f = bflo(u.x); ss += f * f; f = bfhi(u.x); ss += f * f; f = bflo(u.y); ss += f * f; f = bfhi(u.y); ss += f * f;
      f = bflo(u.z); ss += f * f; f = bfhi(u.z); ss += f * f; f = bflo(u.w); ss += f * f; f = bfhi(u.w); ss += f * f;
    }
    ss += xor32(ss);
    const float rkv = rsqrtf(ss * (1.f / 128.f) + EPS);
    f32x16 acc[4];
    acc[0] = zero16(); acc[1] = zero16(); acc[2] = zero16(); acc[3] = zero16();
    const u16* wk = WUKV + (size_t)(hd * 128 + r) * 128 + 8 * h;
#pragma unroll
    for (int ks = 0; ks < 8; ++ks) {
#pragma unroll
      for (int nt = 0; nt < 4; ++nt) {
        bf16x8 a = *(const bf16x8*)(wk + (size_t)nt * 32 * 128 + ks * 16);
        acc[nt] = MFMA32(a, bk[ks], acc[nt]);
      }
    }
    float kpe[16];
#pragma unroll
    for (int g = 0; g < 4; ++g) {
      uint2 u = *(const uint2*)(prow + O_KPE + 8 * g + 4 * h);
      kpe[4 * g] = bflo(u.x); kpe[4 * g + 1] = bfhi(u.x); kpe[4 * g + 2] = bflo(u.y); kpe[4 * g + 3] = bfhi(u.y);
    }
    float ss2 = 0.f;
#pragma unroll
    for (int nt = 0; nt < 4; ++nt)
#pragma unroll
      for (int i = 0; i < 16; ++i) acc[nt][i] *= rkv;
#pragma unroll
    for (int i = 0; i < 16; ++i) ss2 += acc[0][i] * acc[0][i] + acc[1][i] * acc[1][i] + kpe[i] * kpe[i];
    ss2 += xor32(ss2);
    const float r2 = rsqrtf(ss2 * (1.f / 96.f) + EPS);
    const float* gk = p.mla_k_g + layer * 96;
#pragma unroll
    for (int g = 0; g < 4; ++g) {
      float4 g0 = *(const float4*)(gk + 8 * g + 4 * h);
      float4 g1 = *(const float4*)(gk + 32 + 8 * g + 4 * h);
      float4 g2 = *(const float4*)(gk + 64 + 8 * g + 4 * h);
      acc[0][4 * g] *= r2 * g0.x; acc[0][4 * g + 1] *= r2 * g0.y; acc[0][4 * g + 2] *= r2 * g0.z; acc[0][4 * g + 3] *= r2 * g0.w;
      acc[1][4 * g] *= r2 * g1.x; acc[1][4 * g + 1] *= r2 * g1.y; acc[1][4 * g + 2] *= r2 * g1.z; acc[1][4 * g + 3] *= r2 * g1.w;
      kpe[4 * g] *= r2 * g2.x; kpe[4 * g + 1] *= r2 * g2.y; kpe[4 * g + 2] *= r2 * g2.z; kpe[4 * g + 3] *= r2 * g2.w;
    }
#pragma unroll
    for (int reg = 0; reg < 8; ++reg) {
      float x1 = kpe[reg], x2 = kpe[reg + 8];
      kpe[reg] = x1 * cs[reg] - x2 * sn[reg];
      kpe[reg + 8] = x2 * cs[reg] + x1 * sn[reg];
    }
    u16* ko = KB + ((size_t)token * 8 + hd) * 96;
#pragma unroll
    for (int g = 0; g < 4; ++g) {
      *(uint2*)(ko + 8 * g + 4 * h) = make_uint2(pack2(acc[0][4 * g], acc[0][4 * g + 1]), pack2(acc[0][4 * g + 2], acc[0][4 * g + 3]));
      *(uint2*)(ko + 32 + 8 * g + 4 * h) = make_uint2(pack2(acc[1][4 * g], acc[1][4 * g + 1]), pack2(acc[1][4 * g + 2], acc[1][4 * g + 3]));
      *(uint2*)(ko + 64 + 8 * g + 4 * h) = make_uint2(pack2(kpe[4 * g], kpe[4 * g + 1]), pack2(kpe[4 * g + 2], kpe[4 * g + 3]));
    }
#pragma unroll
    for (int nt = 2; nt < 4; ++nt)
#pragma unroll
      for (int i = 0; i < 16; ++i) {
        const int d = (nt - 2) * 32 + crow(i, h);
        VTB[((size_t)((b * 8 + hd) * 64 + d)) * 4096 + s] = f2bf(acc[nt][i]);
      }
  }
  {
    const u16* qp = prow + O_DSQ + hd * 64 + 32 * h;
    u16* qo = (u16*)(p.ws + WS_DSQ) + ((size_t)token * 8 + hd) * 64 + 32 * h;
    uint4 u[4];
    float f[32];
    float ss = 0.f;
#pragma unroll
    for (int i = 0; i < 4; ++i) {
      u[i] = *(const uint4*)(qp + 8 * i);
      f[8 * i] = bflo(u[i].x); f[8 * i + 1] = bfhi(u[i].x); f[8 * i + 2] = bflo(u[i].y); f[8 * i + 3] = bfhi(u[i].y);
      f[8 * i + 4] = bflo(u[i].z); f[8 * i + 5] = bfhi(u[i].z); f[8 * i + 6] = bflo(u[i].w); f[8 * i + 7] = bfhi(u[i].w);
    }
#pragma unroll
    for (int i = 0; i < 32; ++i) ss += f[i] * f[i];
    ss += xor32(ss);
    const float rr = rsqrtf(ss * (1.f / 64.f) + EPS) * C_SB;
    const float* gq = p.dsa_q_g + layer * 64 + 32 * h;
#pragma unroll
    for (int i = 0; i < 4; ++i) {
      float4 ga = *(const float4*)(gq + 8 * i), gb = *(const float4*)(gq + 8 * i + 4);
      *(uint4*)(qo + 8 * i) = make_uint4(pack2(f[8 * i] * rr * ga.x, f[8 * i + 1] * rr * ga.y), pack2(f[8 * i + 2] * rr * ga.z, f[8 * i + 3] * rr * ga.w),
                                         pack2(f[8 * i + 4] * rr * gb.x, f[8 * i + 5] * rr * gb.y), pack2(f[8 * i + 6] * rr * gb.z, f[8 * i + 7] * rr * gb.w));
    }
  }
  if (hd == 1) {
    int pm = p.pos[token];
#pragma unroll
    for (int off = 1; off < 32; off <<= 1) { const int o = __shfl_xor(pm, off); pm = pm > o ? pm : o; }
    if (lane == 0) ((int*)(p.ws + WS_PMAX))[tg] = pm;
  }
  if (hd == 0) {
    const u16* kp = prow + O_DSK + 32 * h;
    u16* ko2 = (u16*)(p.ws + WS_DSK) + (size_t)token * 64 + 32 * h;
    float f[32];
    float ss = 0.f;
#pragma unroll
    for (int i = 0; i < 4; ++i) {
      uint4 u = *(const uint4*)(kp + 8 * i);
      f[8 * i] = bflo(u.x); f[8 * i + 1] = bfhi(u.x); f[8 * i + 2] = bflo(u.y); f[8 * i + 3] = bfhi(u.y);
      f[8 * i + 4] = bflo(u.z); f[8 * i + 5] = bfhi(u.z); f[8 * i + 6] = bflo(u.w); f[8 * i + 7] = bfhi(u.w);
    }
#pragma unroll
    for (int i = 0; i < 32; ++i) ss += f[i] * f[i];
    ss += xor32(ss);
    const float rr = rsqrtf(ss * (1.f / 64.f) + EPS);
    const float* gk = p.dsa_k_g + layer * 64 + 32 * h;
#pragma unroll
    for (int i = 0; i < 4; ++i) {
      float4 ga = *(const float4*)(gk + 8 * i), gb = *(const float4*)(gk + 8 * i + 4);
      *(uint4*)(ko2 + 8 * i) = make_uint4(pack2(f[8 * i] * rr * ga.x, f[8 * i + 1] * rr * ga.y), pack2(f[8 * i + 2] * rr * ga.z, f[8 * i + 3] * rr * ga.w),
                                         pack2(f[8 * i + 4] * rr * gb.x, f[8 * i + 5] * rr * gb.y), pack2(f[8 * i + 6] * rr * gb.z, f[8 * i + 7] * rr * gb.w));
    }
  }
}

struct SelSmem { uint32_t hist[2][4096]; uint32_t pfx[4]; uint32_t need[4]; uint32_t dcut[4]; uint32_t flag; };

template <int PASS>
DI void sel_pass(SelSmem* S, const uint32_t (&sk)[32][2], int ntiles, uint32_t (&pf)[2]) {
  const int tid = opaque_tid(), lane = tid & 63, wave = __builtin_amdgcn_readfirstlane(tid >> 6), r = lane & 31, h = lane >> 5;
  {
    uint4* hz = (uint4*)&S->hist[0][0];
#pragma unroll
    for (int i = 0; i < 8; ++i) hz[tid + 256 * i] = make_uint4(0, 0, 0, 0);
  }
  __syncthreads();
#pragma unroll
  for (int i = 0; i < 32; ++i) {
    const int tile = i * 4 + wave;
    if (tile < ntiles) {
#pragma unroll
      for (int j = 0; j < 2; ++j) {
        const uint32_t k = sk[i][j];
        bool match; uint32_t digit;
        if (PASS == 0) { match = (k != 0u); digit = k >> 20; }
        else if (PASS == 1) { match = ((k >> 20) == pf[j]); digit = (k >> 10) & 1023u; }
        else if (PASS == 2) { match = ((k >> 10) == pf[j]); digit = k & 1023u; }
        else { match = (k == pf[j]); digit = 4095u - (uint32_t)(tile * 32 + r); }
        if (match) atomicAdd(&S->hist[h][digit], j ? 0x10000u : 1u);
      }
    }
  }
  __syncthreads();
  {
    constexpr int PER = (PASS == 0 || PASS == 3) ? 64 : 16;
    const int pair = wave >> 1, sh = (wave & 1) * 16;
    const uint32_t need = S->need[wave];
    const uint32_t prevp = S->pfx[wave];
    const uint32_t* hp = &S->hist[pair][lane * PER];
    uint32_t tot = 0;
    for (int c = 0; c < PER; ++c) tot += (hp[(c + lane) & (PER - 1)] >> sh) & 0xffffu;
    uint32_t incl = tot;
#pragma unroll
    for (int off = 1; off < 64; off <<= 1) {
      uint32_t v = __shfl_down(incl, off);
      if (lane + off < 64) incl += v;
    }
    const uint32_t sfx = incl - tot;
    const bool cross = (sfx < need) && (need <= sfx + tot);
    const unsigned long long cm = __ballot(cross);
    if (cm != 0ull) {
      const int L = __builtin_ctzll(cm);
      const uint32_t cumbase = (uint32_t)__shfl((int)sfx, L);
      const uint32_t cnt = (lane < PER) ? ((S->hist[pair][L * PER + lane] >> sh) & 0xffffu) : 0u;
      uint32_t inc2 = cnt;
#pragma unroll
      for (int off = 1; off < PER; off <<= 1) {
        uint32_t v = __shfl_down(inc2, off);
        if (lane + off < 64) inc2 += v;
      }
      const uint32_t cum = cumbase + (inc2 - cnt);
      if (lane < PER && cum < need && need <= cum + cnt) {
        const uint32_t bin = (uint32_t)(L * PER + lane);
        const uint32_t nn = need - cum;
        if (PASS == 0) S->pfx[wave] = bin;
        else if (PASS == 1 || PASS == 2) S->pfx[wave] = (prevp << 10) | bin;
        else S->dcut[wave] = bin;
        if (PASS == 2 && cnt != nn) atomicOr(&S->flag, 1u);
        S->need[wave] = nn;
      }
    }
  }
  __syncthreads();
  if (PASS < 3) { pf[0] = S->pfx[2 * h]; pf[1] = S->pfx[2 * h + 1]; }
}

DI void select_item(const Params& p, int item, char* smem) {
  SelSmem* S = (SelSmem*)smem;
  const u16* PROJ = (const u16*)(p.ws + WS_PROJ);
  uint32_t* BM = (uint32_t*)(p.ws + WS_BM);
  const int b = item & 3, t0 = (1023 - (item >> 2)) * 4;
  const int tokbase = b * 4096;
  const int tid = opaque_tid(), lane = tid & 63, wave = __builtin_amdgcn_readfirstlane(tid >> 6), r = lane & 31, h = lane >> 5;
  if (t0 + 3 < 256) {
    if (tid < 32) {
      const int q = tid >> 3, tile = tid & 7, t = t0 + q;
      uint32_t wd = (tile < (t >> 5)) ? 0xffffffffu : (tile == (t >> 5) ? (0xffffffffu >> (31 - (t & 31))) : 0u);
      BM[(size_t)(tokbase + t) * 128 + tile] = wd;
    }
    return;
  }
  const int ntiles = 2 * (t0 >> 6) + 2;
  if (tid < 4) { S->need[tid] = 256u; S->pfx[tid] = 0u; S->dcut[tid] = 0u; }
  if (tid == 4) S->flag = 0u;
  bf16x8 a0, a1;
  {
    const int hb = (r >> 2) & 1, idx16 = (r & 3) + 4 * (r >> 3);
    const int q = 2 * hb + (idx16 >> 3), head = idx16 & 7;
    const u16* aq = PROJ + (size_t)(tokbase + t0 + q) * LDP + O_IXQ + head * 32 + 8 * h;
    a0 = *(const bf16x8*)aq;
    a1 = *(const bf16x8*)(aq + 16);
  }
  float wv[16];
#pragma unroll
  for (int j = 0; j < 2; ++j) {
    uint4 u = *(const uint4*)(PROJ + (size_t)(tokbase + t0 + 2 * h + j) * LDP + O_IXW);
    const float c = 0.35355339059327373f * 0.17677669529663687f;
    wv[8 * j] = bflo(u.x) * c; wv[8 * j + 1] = bfhi(u.x) * c; wv[8 * j + 2] = bflo(u.y) * c; wv[8 * j + 3] = bfhi(u.y) * c;
    wv[8 * j + 4] = bflo(u.z) * c; wv[8 * j + 5] = bfhi(u.z) * c; wv[8 * j + 6] = bflo(u.w) * c; wv[8 * j + 7] = bfhi(u.w) * c;
  }
  const u16* IXK = (const u16*)(p.ws + WS_IXK) + (size_t)tokbase * 32;
  uint32_t sk[32][2];
  bf16x8 ka0[4], ka1[4], kb0[4], kb1[4];
#define SEL_LOAD(S0, S1, CC)                                                          \
  _Pragma("unroll") for (int ii = 0; ii < 4; ++ii) {                                   \
    const int key_ = ((((CC) * 4 + ii) * 4 + wave) * 32) + r;                          \
    const u16* kp_ = BIS1 ? (PROJ + (size_t)(tokbase + key_) * LDP + O_KPE + 32 + 8 * h) : (IXK + (size_t)key_ * 32 + 8 * h); \
    S0[ii] = *(const bf16x8*)kp_; S1[ii] = *(const bf16x8*)(kp_ + 16);                 \
  }
#define SEL_COMP(S0, S1, CC)                                                          \
  _Pragma("unroll") for (int ii = 0; ii < 4; ++ii) {                                   \
    const int i_ = (CC) * 4 + ii;                                                      \
    const int key_ = (i_ * 4 + wave) * 32 + r;                                         \
    f32x16 acc_ = zero16();                                                            \
    acc_ = MFMA32(a0, S0[ii], acc_);                                                   \
    acc_ = MFMA32(a1, S1[ii], acc_);                                                   \
    _Pragma("unroll") for (int j = 0; j < 2; ++j) {                                    \
      float sc_ = 0.f;                                                                 \
      _Pragma("unroll") for (int hd = 0; hd < 8; ++hd) sc_ = fmaf(wv[8 * j + hd], fmaxf(acc_[8 * j + hd], 0.f), sc_); \
      sc_ += 0.0f;                                                                     \
      const uint32_t bits_ = __float_as_uint(sc_);                                     \
      const uint32_t k32_ = bits_ ^ (((uint32_t)((int32_t)bits_ >> 31)) | 0x80000000u); \
      sk[i_][j] = (key_ <= t0 + 2 * h + j) ? k32_ : 0u;                                \
    }                                                                                  \
  }
#define SEL_ZERO(CC) _Pragma("unroll") for (int ii = 0; ii < 4; ++ii) { sk[(CC) * 4 + ii][0] = 0u; sk[(CC) * 4 + ii][1] = 0u; }
  if (wave < ntiles) { SEL_LOAD(ka0, ka1, 0) }
#pragma unroll
  for (int cc = 0; cc < 8; cc += 2) {
    if (16 * (cc + 1) + wave < ntiles) { SEL_LOAD(kb0, kb1, cc + 1) }
    if (16 * cc + wave < ntiles) { SEL_COMP(ka0, ka1, cc) } else { SEL_ZERO(cc) }
    if (cc + 2 < 8) { if (16 * (cc + 2) + wave < ntiles) { SEL_LOAD(ka0, ka1, cc + 2) } }
    if (16 * (cc + 1) + wave < ntiles) { SEL_COMP(kb0, kb1, cc + 1) } else { SEL_ZERO(cc + 1) }
  }
#undef SEL_LOAD
#undef SEL_COMP
#undef SEL_ZERO
  uint32_t pf[2] = {0u, 0u};
  sel_pass<0>(S, sk, ntiles, pf);
  sel_pass<1>(S, sk, ntiles, pf);
  sel_pass<2>(S, sk, ntiles, pf);
  uint32_t dc[2] = {0u, 0u};
  if (S->flag) {
    sel_pass<3>(S, sk, ntiles, pf);
    dc[0] = S->dcut[2 * h]; dc[1] = S->dcut[2 * h + 1];
  }
#pragma unroll
  for (int i = 0; i < 32; ++i) {
    const int tile = i * 4 + wave;
    if (tile < ntiles) {
      const uint32_t di = 4095u - (uint32_t)(tile * 32 + r);
#pragma unroll
      for (int j = 0; j < 2; ++j) {
        const uint32_t k = sk[i][j];
        const bool sel = (k > pf[j]) || (k == pf[j] && di >= dc[j]);
        const unsigned long long m = __ballot(sel);
        if (lane == 0) {
          BM[(size_t)(tokbase + t0 + j) * 128 + tile] = (uint32_t)m;
          BM[(size_t)(tokbase + t0 + 2 + j) * 128 + tile] = (uint32_t)(m >> 32);
        }
      }
    }
  }
  __syncthreads();
}

DI bool softmax_bound_ok(const Params& p, int layer, int mode) {
  const int lane = threadIdx.x & 63;
  const float* gq = (mode == 1) ? (p.mla_q_g + layer * 96) : (p.dsa_q_g + layer * 64);
  const float* gk = (mode == 1) ? (p.mla_k_g + layer * 96) : (p.dsa_k_g + layer * 64);
  const int ng = (mode == 1) ? 96 : 64;
  float aq = 0.f, ak = 0.f, ab = 0.f;
  for (int i = lane; i < ng; i += 64) { aq = fmaxf(aq, fabsf(gq[i])); ak = fmaxf(ak, fabsf(gk[i])); }
  if (mode == 2) { for (int i = lane; i < 256; i += 64) ab = fmaxf(ab, fabsf(p.rel_bias[i])); }
#pragma unroll
  for (int off = 1; off < 64; off <<= 1) { aq = fmaxf(aq, __shfl_xor(aq, off)); ak = fmaxf(ak, __shfl_xor(ak, off)); ab = fmaxf(ab, __shfl_xor(ab, off)); }
  const float bound = ((mode == 1) ? 9.7979590f * aq * ak : 8.f * aq * ak + 2.f * ab) * LOG2E * 1.02f;
  return __builtin_amdgcn_readfirstlane((bound < 100.f) ? 1 : 0) != 0;
}

template <int MODE, bool FAST>
DI void attn_item(const Params& p, int layer, int b, int hd, int qt, char* smem) {
  constexpr int DK = (MODE == 1) ? 96 : 64;
  constexpr int KS = DK / 16;
  constexpr int KROW = DK + 8;
  constexpr int KCH = DK / 8;
  constexpr int NKL = (64 * KCH) / 256;
  typedef u16 (*kt_t)[64][KROW];
  typedef u16 (*vt_t)[64][72];
  kt_t sK = (kt_t)smem;
  vt_t sV = (vt_t)(smem + 2 * 64 * KROW * 2);
  int* sPos = (int*)(smem + 2 * 64 * KROW * 2 + 2 * 64 * 72 * 2);
  float* sBias = (float*)(smem + 2 * 64 * KROW * 2 + 2 * 64 * 72 * 2 + 512);
  int* sWd = (int*)(smem + 2 * 64 * KROW * 2 + 2 * 64 * 72 * 2 + 512 + 4096);

  const u16* PROJ = (const u16*)(p.ws + WS_PROJ);
  u16* YBR = (u16*)(p.ws + WS_YBR);
  const uint32_t* BM = (const uint32_t*)(p.ws + WS_BM);
  const int tid = opaque_tid(), lane = tid & 63, wave = __builtin_amdgcn_readfirstlane(tid >> 6), r = lane & 31, h = lane >> 5;
  const int tokbase = b * 4096;

  int tq, hdl, wmin, wmax, nt64;
  const u16* qrow;
  const u16* kbase; size_t kstride;
  const u16* vbase;
  if (MODE == 0) {
    tq = qt * 128 + wave * 32 + r; hdl = hd; wmin = qt * 128 + wave * 32; wmax = wmin + 31; nt64 = 2 * qt + 2;
    qrow = (const u16*)(p.ws + WS_QA) + ((size_t)(b * 8 + hd) * 4096 + tq) * 64;
    kbase = (const u16*)(p.ws + WS_KA) + ((size_t)(b * 8 + hd) * 4096) * 64; kstride = 64;
    vbase = (const u16*)(p.ws + WS_VTA) + (size_t)((b * 8 + hd) * 64) * 4096;
  } else if (MODE == 1) {
    tq = qt * 128 + wave * 32 + r; hdl = hd; wmin = qt * 128 + wave * 32; wmax = wmin + 31; nt64 = 2 * qt + 2;
    qrow = (const u16*)(p.ws + WS_QB) + ((size_t)(tokbase + tq) * 8 + hd) * 96;
    kbase = (const u16*)(p.ws + WS_KB) + ((size_t)tokbase * 8 + hd) * 96; kstride = 768;
    vbase = (const u16*)(p.ws + WS_VTB) + (size_t)((b * 8 + hd) * 64) * 4096;
  } else {
    tq = qt * 16 + wave * 4 + (r >> 3); hdl = r & 7; wmin = qt * 16 + wave * 4; wmax = wmin + 3; nt64 = (qt >> 2) + 1;
    qrow = (const u16*)(p.ws + WS_DSQ) + ((size_t)(tokbase + tq) * 8 + hdl) * 64;
    kbase = (const u16*)(p.ws + WS_DSK) + (size_t)tokbase * 64; kstride = 64;
    vbase = (const u16*)(p.ws + WS_VTC) + (size_t)(b * 64) * 4096;
  }
  int posq = 0, wposmin = 0;
  if (MODE == 2) {
    posq = p.pos[tokbase + tq];
    wposmin = posq;
#pragma unroll
    for (int off = 1; off < 64; off <<= 1) { const int o = __shfl_xor(wposmin, off); wposmin = wposmin < o ? wposmin : o; }
    wposmin = __builtin_amdgcn_readfirstlane(wposmin);
    for (int e = tid; e < 1024; e += 256) {
      const int n = e >> 3, hh = e & 7;
      int bk = n;
      if (n >= 16) {
        bk = 16 + (n >= 19) + (n >= 21) + (n >= 24) + (n >= 27) + (n >= 31) + (n >= 35) + (n >= 40) + (n >= 46) + (n >= 52) + (n >= 59) + (n >= 67) + (n >= 77) + (n >= 87) + (n >= 99) + (n >= 113);
      }
      sBias[e] = (p.rel_bias[bk * 8 + hh] - p.rel_bias[31 * 8 + hh]) * LOG2E;
    }
  }
  constexpr bool fastsm = FAST;
  bf16x8 qf[KS];
#pragma unroll
  for (int ks = 0; ks < KS; ++ks) qf[ks] = *(const bf16x8*)(qrow + ks * 16 + 8 * h);

  f32x16 o[2];
  o[0] = zero16(); o[1] = zero16();
  float carry = 1.f;
  float mrun = -INFINITY, lrun = 0.f;

  uint4 rk0, rk1, rk2 = make_uint4(0, 0, 0, 0), rv0, rv1;
  int rp = 0;
  const int krow0 = tid / KCH, kc0 = tid - krow0 * KCH;
  const int krow1 = (tid + 256) / KCH, kc1 = (tid + 256) - krow1 * KCH;
  const int krow2 = (tid + 512) / KCH, kc2 = (tid + 512) - krow2 * KCH;
  const int vd0 = tid >> 3, vc0 = tid & 7, vd1 = vd0 + 32;
#define ATT_GLOAD(KT)                                                                         \
  do {                                                                                        \
    const int key0_ = (KT) * 64;                                                              \
    rk0 = *(const uint4*)(kbase + (size_t)(key0_ + krow0) * kstride + kc0 * 8);               \
    rk1 = *(const uint4*)(kbase + (size_t)(key0_ + krow1) * kstride + kc1 * 8);               \
    if (NKL > 2) rk2 = *(const uint4*)(kbase + (size_t)(key0_ + krow2) * kstride + kc2 * 8);  \
    rv0 = *(const uint4*)(vbase + (size_t)vd0 * 4096 + key0_ + vc0 * 8);                      \
    rv1 = *(const uint4*)(vbase + (size_t)vd1 * 4096 + key0_ + vc0 * 8);                      \
    if (MODE == 2) {                                                                          \
      if (tid < 64) rp = p.pos[tokbase + key0_ + tid];                                        \
      else if (tid < 96) rp = (int)BM[(size_t)(tokbase + qt * 16 + ((tid - 64) >> 1)) * 128 + 2 * (KT) + (tid & 1)]; \
      else if (tid < 98) rp = ((const int*)(p.ws + WS_PMAX))[b * 128 + 2 * (KT) + (tid & 1)]; \
    }                                                                                         \
  } while (0)
#define ATT_SSTORE(BUF)                                                  \
  do {                                                                   \
    *(uint4*)&sK[(BUF)][krow0][kc0 * 8] = rk0;                           \
    *(uint4*)&sK[(BUF)][krow1][kc1 * 8] = rk1;                           \
    if (NKL > 2) *(uint4*)&sK[(BUF)][krow2][kc2 * 8] = rk2;              \
    *(uint4*)&sV[(BUF)][vd0][vc0 * 8] = rv0;                             \
    *(uint4*)&sV[(BUF)][vd1][vc0 * 8] = rv1;                             \
    if (MODE == 2) {                                                     \
      if (tid < 64) sPos[(BUF) * 64 + tid] = rp;                         \
      else if (tid < 98) sWd[(BUF) * 34 + (tid - 64)] = rp;              \
    }                                                                    \
  } while (0)

  ATT_GLOAD(MODE == 0 ? nt64 - 1 : 0);
  ATT_SSTORE(0);
  if (nt64 > 1) ATT_GLOAD(MODE == 0 ? nt64 - 2 : 1);
  __syncthreads();
  for (int step = 0; step < nt64; ++step) {
    const int kt = (MODE == 0) ? (nt64 - 1 - step) : step;
    const int buf = step & 1;
    const bool more = (step + 1 < nt64);
#pragma unroll
    for (int subi = 0; subi < 2; ++subi) {
      const int sub = (MODE == 0) ? (1 - subi) : subi;
      const int ks0 = kt * 64 + sub * 32;
      const bool skip = (MODE == 0) ? (ks0 >= wmax) : (ks0 > wmax);
      if (!skip) {
        uint32_t wd = 0;
        int pmaxk = 0;
        if (MODE == 2) { wd = (uint32_t)sWd[buf * 34 + (wave * 4 + (r >> 3)) * 2 + sub]; pmaxk = sWd[buf * 34 + 32 + sub]; }
        f32x16 s = zero16();
#pragma unroll
        for (int ks = 0; ks < KS; ++ks) {
          bf16x8 a = *(const bf16x8*)&sK[buf][sub * 32 + r][ks * 16 + 8 * h];
          s = MFMA32(a, qf[ks], s);
        }
        float pv[16];
        if (MODE == 0) {
          const bool needmask = (ks0 + 31 >= wmin);
          float e[16];
#pragma unroll
          for (int i = 0; i < 16; ++i) e[i] = frcp(1.f + fexp2(s[i]));
          if (needmask) {
#pragma unroll
            for (int i = 0; i < 16; ++i) e[i] = ((ks0 + crow(i, h)) < tq) ? e[i] : 1.f;
          }
          float tot[4], pr[4], sel[4];
#pragma unroll
          for (int g = 0; g < 4; ++g) tot[g] = (e[4 * g + 3] * e[4 * g + 2]) * (e[4 * g + 1] * e[4 * g]);
#pragma unroll
          for (int g = 0; g < 4; ++g) {
            unsigned uu = __float_as_uint(tot[g]);
            auto rr = __builtin_amdgcn_permlane32_swap(uu, uu, false, false);
            const float r0 = __uint_as_float(rr[0]), r1 = __uint_as_float(rr[1]);
            pr[g] = r0 * r1;
            sel[g] = h ? 1.f : r1;
          }
          float R[4];
          R[3] = carry; R[2] = R[3] * pr[3]; R[1] = R[2] * pr[2]; R[0] = R[1] * pr[1];
          carry = R[0] * pr[0];
#pragma unroll
          for (int g = 0; g < 4; ++g) {
            const float p4 = R[g] * sel[g];
            const float p3 = p4 * e[4 * g + 3];
            const float p2 = p3 * e[4 * g + 2];
            const float p1 = p2 * e[4 * g + 1];
            const float p0 = p1 * e[4 * g];
            pv[4 * g + 3] = p4 - p3; pv[4 * g + 2] = p3 - p2; pv[4 * g + 1] = p2 - p1; pv[4 * g] = p1 - p0;
          }
        } else {
          float u[16];
          if (MODE == 1) {
            const bool needmask = (ks0 + 31 > wmin);
#pragma unroll
            for (int i = 0; i < 16; ++i) u[i] = s[i];
            if (needmask) {
              asm volatile("" ::: "memory");
#pragma unroll
              for (int i = 0; i < 16; ++i) { if ((ks0 + crow(i, h)) > tq) u[i] = -INFINITY; }
            }
          } else if (wposmin - pmaxk >= 113) {
#pragma unroll
            for (int i = 0; i < 16; ++i) u[i] = ((wd >> crow(i, h)) & 1u) ? s[i] : -INFINITY;
          } else {
#pragma unroll
            for (int i = 0; i < 16; ++i) {
              const int kk = crow(i, h);
              const int pk = sPos[buf * 64 + sub * 32 + kk];
              int dist = posq - pk;
              dist = dist < 0 ? 0 : (dist > 127 ? 127 : dist);
              const float bias = sBias[dist * 8 + hdl];
              const float negm = ((wd >> kk) & 1u) ? 0.f : -INFINITY;
              u[i] = (s[i] + bias) + negm;
            }
          }
          if (fastsm) {
            float ls = 0.f;
#pragma unroll
            for (int i = 0; i < 16; ++i) { pv[i] = fexp2(u[i]); ls += pv[i]; }
            lrun += ls;
          } else {
          float mx = u[0];
#pragma unroll
          for (int i = 1; i < 16; ++i) mx = fmaxf(mx, u[i]);
          mx = xmax32(mx);
          const float mnew = fmaxf(mrun, mx);
          const float muse = (mnew == -INFINITY) ? 0.f : mnew;
          const float alpha = fexp2(mrun - muse);
          float ls = 0.f;
#pragma unroll
          for (int i = 0; i < 16; ++i) { pv[i] = fexp2(u[i] - muse); ls += pv[i]; }
          lrun = lrun * alpha + ls;
          mrun = mnew;
          if (__any(alpha != 1.f)) {
#pragma unroll
            for (int i = 0; i < 16; ++i) { o[0][i] *= alpha; o[1][i] *= alpha; }
          }
          }
        }
#pragma unroll
        for (int sidx = 0; sidx < 2; ++sidx) {
          uint4 pk4 = make_uint4(pack2(pv[8 * sidx], pv[8 * sidx + 1]), pack2(pv[8 * sidx + 2], pv[8 * sidx + 3]),
                                 pack2(pv[8 * sidx + 4], pv[8 * sidx + 5]), pack2(pv[8 * sidx + 6], pv[8 * sidx + 7]));
          bf16x8 pf = __builtin_bit_cast(bf16x8, pk4);
#pragma unroll
          for (int dt = 0; dt < 2; ++dt) {
            const u16* vp = &sV[buf][dt * 32 + r][sub * 32 + 16 * sidx + 4 * h];
            uint2 lo = *(const uint2*)vp;
            uint2 hi = *(const uint2*)(vp + 8);
            bf16x8 va = __builtin_bit_cast(bf16x8, make_uint4(lo.x, lo.y, hi.x, hi.y));
            o[dt] = MFMA32(va, pf, o[dt]);
          }
        }
      }
    }
    if (more) ATT_SSTORE(buf ^ 1);
    if (step + 2 < nt64) ATT_GLOAD((MODE == 0) ? kt - 2 : kt + 2);
    if (MODE == 0) {
      const int alive = __any(carry >= 5.42101086e-20f) ? 1 : 0;
      if (!__syncthreads_or(alive)) break;
    } else {
      __syncthreads();
    }
  }
  float inv = 1.f;
  if (MODE != 0) { const float lt = xsum32(lrun); inv = 1.f / lt; }
  const size_t tok = (size_t)(tokbase + tq);
  const u16* zrow = PROJ + tok * LDP + O_ZA + MODE * 512 + hdl * 64;
  u16* yrow = YBR + tok * LDY + MODE * 512 + hdl * 64;
#pragma unroll
  for (int dt = 0; dt < 2; ++dt)
#pragma unroll
    for (int g = 0; g < 4; ++g) {
      const int d4 = dt * 32 + 8 * g + 4 * h;
      uint2 zu = *(const uint2*)(zrow + d4);
      float z0 = bflo(zu.x), z1 = bfhi(zu.x), z2 = bflo(zu.y), z3 = bfhi(zu.y);
      float y0 = o[dt][4 * g] * inv, y1 = o[dt][4 * g + 1] * inv, y2 = o[dt][4 * g + 2] * inv, y3 = o[dt][4 * g + 3] * inv;
      y0 *= z0 * fsigmoid(z0); y1 *= z1 * fsigmoid(z1); y2 *= z2 * fsigmoid(z2); y3 *= z3 * fsigmoid(z3);
      *(uint2*)(yrow + d4) = make_uint2(pack2(y0, y1), pack2(y2, y3));
    }
}

DI void phase_branch(const Params& p, int layer, char* smem, int xcd, int loc, int nloc) {
  const char* wset = p.ws + WS_WT + (size_t)(layer & 1) * SZ_WSET;
  const u16* WBR = (const u16*)(wset + OFF_WT_BR);
  const u16* YBR = (const u16*)(p.ws + WS_YBR);
  const u16* PROJ = (const u16*)(p.ws + WS_PROJ);
  u16* MG = (u16*)(p.ws + WS_MERGED);
  const int tid = opaque_tid(), lane = tid & 63, wave = __builtin_amdgcn_readfirstlane(tid >> 6), r = lane & 31, h = lane >> 5;
  const int wn = wave & 1, wm = wave >> 1;
  for (int i = loc;; i += nloc) {
    int mt, nt;
    if (!tile_order<8>(i, xcd, mt, nt)) break;
    const int m0 = mt * 128, d0 = nt * 128;
    f32x16 sum[2][2];
    sum[0][0] = zero16(); sum[0][1] = zero16(); sum[1][0] = zero16(); sum[1][1] = zero16();
#pragma unroll 1
    for (int n = 0; n < 3; ++n) {
      f32x16 acc[2][2];
      acc[0][0] = zero16(); acc[0][1] = zero16(); acc[1][0] = zero16(); acc[1][1] = zero16();
      gemm128(WBR + ((size_t)n * 1024 + d0) * LDB, LDB, YBR + (size_t)m0 * LDY + n * 512, LDY, 512, acc, smem);
      const float* gb = p.gate_b + ((size_t)layer * 3 + n) * 1024;
#pragma unroll
      for (int mi = 0; mi < 2; ++mi) {
        const int m = m0 + wm * 64 + mi * 32 + r;
#pragma unroll
        for (int ni = 0; ni < 2; ++ni)
#pragma unroll
          for (int g = 0; g < 4; ++g) {
            const int d4 = d0 + wn * 64 + ni * 32 + 8 * g + 4 * h;
            uint2 gu = *(const uint2*)(PROJ + (size_t)m * LDP + O_G + n * 1024 + d4);
            float4 bb = *(const float4*)(gb + d4);
            float g0 = bflo(gu.x) + bb.x, g1 = bfhi(gu.x) + bb.y, g2 = bflo(gu.y) + bb.z, g3 = bfhi(gu.y) + bb.w;
            sum[ni][mi][4 * g] += acc[ni][mi][4 * g] * fsigmoid(g0);
            sum[ni][mi][4 * g + 1] += acc[ni][mi][4 * g + 1] * fsigmoid(g1);
            sum[ni][mi][4 * g + 2] += acc[ni][mi][4 * g + 2] * fsigmoid(g2);
            sum[ni][mi][4 * g + 3] += acc[ni][mi][4 * g + 3] * fsigmoid(g3);
          }
      }
    }
#pragma unroll
    for (int mi = 0; mi < 2; ++mi) {
      const int m = m0 + wm * 64 + mi * 32 + r;
#pragma unroll
      for (int ni = 0; ni < 2; ++ni)
#pragma unroll
        for (int g = 0; g < 4; ++g) {
          const int d4 = d0 + wn * 64 + ni * 32 + 8 * g + 4 * h;
          *(uint2*)(MG + (size_t)m * LDX + d4) = make_uint2(pack2(sum[ni][mi][4 * g], sum[ni][mi][4 * g + 1]), pack2(sum[ni][mi][4 * g + 2], sum[ni][mi][4 * g + 3]));
        }
    }
  }
}

DI void phase_out(const Params& p, int layer, char* smem, int xcd, int loc, int nloc) {
  const char* wset = p.ws + WS_WT + (size_t)(layer & 1) * SZ_WSET;
  const u16* WOUT = (const u16*)(wset + OFF_WT_OUT);
  const u16* MG = (const u16*)(p.ws + WS_MERGED);
  u16* XB = (u16*)(p.ws + WS_XB);
  float* XSS = (float*)(p.ws + WS_XSS);
  const float* xin = (layer == 0) ? p.x : p.out;
  const int tid = opaque_tid(), lane = tid & 63, wave = __builtin_amdgcn_readfirstlane(tid >> 6), r = lane & 31, h = lane >> 5;
  const int wn = wave & 1, wm = wave >> 1;
  for (int i = loc;; i += nloc) {
    int mt, nt;
    if (!tile_order<8>(i, xcd, mt, nt)) break;
    const int m0 = mt * 128, n0 = nt * 128;
    f32x16 acc[2][2];
    acc[0][0] = zero16(); acc[0][1] = zero16(); acc[1][0] = zero16(); acc[1][1] = zero16();
    gemm128(WOUT + (size_t)n0 * LDX, LDX, MG + (size_t)m0 * LDX, LDX, 1024, acc, smem);
#pragma unroll
    for (int mi = 0; mi < 2; ++mi) {
      const int m = m0 + wm * 64 + mi * 32 + r;
      float ss = 0.f;
#pragma unroll
      for (int ni = 0; ni < 2; ++ni)
#pragma unroll
        for (int g = 0; g < 4; ++g) {
          const int n4 = n0 + wn * 64 + ni * 32 + 8 * g + 4 * h;
          float4 xo = *(const float4*)(xin + (size_t)m * 1024 + n4);
          xo.x += acc[ni][mi][4 * g]; xo.y += acc[ni][mi][4 * g + 1]; xo.z += acc[ni][mi][4 * g + 2]; xo.w += acc[ni][mi][4 * g + 3];
          *(float4*)(p.out + (size_t)m * 1024 + n4) = xo;
          *(uint2*)(XB + (size_t)m * LDX + n4) = make_uint2(pack2(xo.x, xo.y), pack2(xo.z, xo.w));
          ss += xo.x * xo.x + xo.y * xo.y + xo.z * xo.z + xo.w * xo.w;
        }
      ss += xor32(ss);
      if (h == 0) XSS[(size_t)m * 16 + nt * 2 + wn] = ss;
    }
  }
}

DI void phase_init(const Params& p) {
  u16* XB = (u16*)(p.ws + WS_XB);
  float* XSS = (float*)(p.ws + WS_XSS);
  const int lane = threadIdx.x & 63;
  const int gw = blockIdx.x * 4 + (threadIdx.x >> 6), nw = gridDim.x * 4;
  for (int row = gw; row < NTOK; row += nw) {
    const float* xr = p.x + (size_t)row * 1024;
    float ss = 0.f;
#pragma unroll
    for (int i = 0; i < 4; ++i) {
      float4 v = *(const float4*)(xr + i * 256 + lane * 4);
      ss += v.x * v.x + v.y * v.y + v.z * v.z + v.w * v.w;
      *(uint2*)(XB + (size_t)row * LDX + i * 256 + lane * 4) = make_uint2(pack2(v.x, v.y), pack2(v.z, v.w));
    }
#pragma unroll
    for (int off = 32; off >= 1; off >>= 1) ss += __shfl_xor(ss, off);
    if (lane < 16) XSS[(size_t)row * 16 + lane] = (lane == 0) ? ss : 0.f;
  }
  if (blockIdx.x == 0 && threadIdx.x < 64) ((int*)(p.ws + WS_CTR))[threadIdx.x] = 0;
}


#ifndef DUP_MASK
#define DUP_MASK 0
#endif
constexpr int SMEM_BYTES = 73728;
constexpr int N_PHASES = 1 + 5 * DEPTH;

__global__ void __launch_bounds__(256, 2) hybrid_megakernel(Params p, int ph_lo, int ph_hi, int do_sync) {
  __shared__ __attribute__((aligned(16))) char smem[SMEM_BYTES];
  __shared__ int s_item;
  __shared__ uint4 xb_words;
  const int tid = threadIdx.x, bid = blockIdx.x, nb = gridDim.x;
  __shared__ int s_xinfo[4];
  if (tid == 0) { xb_words = make_uint4(0u, 0u, 0u, 0u); s_xinfo[3] = 0; }
  __syncthreads();
  XcdBarrier xb = xcd_barrier_post((unsigned*)(p.ws + WS_BAR), (volatile LAS unsigned*)&xb_words);
  if (tid == 0) s_xinfo[1] = (int)xb_add((unsigned*)(p.ws + WS_BAR) + 8 * xb.x, 1u);
  int t_cls = bid & 7, t_loc = bid >> 3, t_step = (nb - (bid & 7) + 7) >> 3;
  for (int ph = ph_lo; ph < ph_hi; ++ph) {
    if (ph == 0) {
      phase_init(p);
      for (int it = bid; it < CV_TOTAL; it += nb) convert_item(p, 0, it, (float*)smem);
    } else {
      const int layer = (ph - 1) / 5, sub = (ph - 1) % 5;
      if (sub == 0) {
        phase_proj(p, layer, smem, t_cls, t_loc, t_step);
        if (DUP_MASK & 1) { __syncthreads(); phase_proj(p, layer, smem, t_cls, t_loc, t_step); }
        if (DUP_MASK & 16) { __syncthreads(); phase_proj_probe(p, layer, smem, t_cls, t_loc, t_step); }
      } else if (sub == 1) {
        const int ncv = (layer + 1 < DEPTH) ? CV_TOTAL : 0;
        const int total = 4096 + 1024 + ncv;
        for (int rep = 0; rep < ((DUP_MASK & 4) ? 2 : 1); ++rep)
        for (int it = bid; it < total; it += nb) {
          if (it < 4096) select_item(p, it, smem);
          else if (it < 5120) prep_item(p, layer, (it - 4096) * 4 + (tid >> 6));
          else convert_item(p, layer + 1, it - 5120, (float*)smem);
        }
      } else if (sub == 2) {
        const bool fast1 = softmax_bound_ok(p, layer, 1), fast2 = softmax_bound_ok(p, layer, 2);
        const bool xq = (s_xinfo[3] == 8);
        int* ctr = (int*)(p.ws + WS_CTR) + (xq ? (16 + layer * 8 + t_cls) : layer);
        const int limit = xq ? 384 : 3072;
        while (true) {
          if (tid == 0) s_item = atomicAdd(ctr, 1);
          __syncthreads();
          const int w = s_item;
          __syncthreads();
          if (w >= limit) break;
          int type, b, hd, d, jt;
          if (xq) {
            const int level = w / 12, within = w - level * 12;
            d = 31 - level;
            type = within >> 2;
            const int pr = 4 * t_cls + (within & 3);
            b = (type == 2) ? (t_cls >> 1) : (pr >> 3);
            hd = pr & 7;
            jt = d * 8 + 2 * (within & 3) + (t_cls & 1);
          } else {
            d = 31 - w / 96;
            const int within = w % 96, idx = within & 31;
            type = within >> 5; b = idx >> 3; hd = idx & 7; jt = d * 8 + (idx & 7);
          }
          if (type == 0) attn_item<0, false>(p, layer, b, hd, d, smem);
          else if (type == 1) { if (fast1) attn_item<1, true>(p, layer, b, hd, d, smem); else attn_item<1, false>(p, layer, b, hd, d, smem); }
          else { if (fast2) attn_item<2, true>(p, layer, b, 0, jt, smem); else attn_item<2, false>(p, layer, b, 0, jt, smem); }
        }
      } else if (sub == 3) {
        phase_branch(p, layer, smem, t_cls, t_loc, t_step);
        if (DUP_MASK & 8) { __syncthreads(); phase_branch(p, layer, smem, t_cls, t_loc, t_step); }
      } else {
        phase_out(p, layer, smem, t_cls, t_loc, t_step);
      }
    }
    if (do_sync == 2) cg::this_grid().sync();
    if (do_sync && ph + 1 < ph_hi) {
      xcd_barrier(xb);
      if (ph == ph_lo) {
        if (tid == 0) {
          unsigned* bar = (unsigned*)(p.ws + WS_BAR);
          int xi = 0;
          for (unsigned j = 0; j < xb.x; ++j) xi += (xb_ld(&bar[XB_XCNT(j)]) > 0u) ? 1 : 0;
          s_xinfo[0] = xi; s_xinfo[2] = (int)xb_words.x; s_xinfo[3] = (int)xb_words.y;
        }
        __syncthreads();
        if (s_xinfo[3] == 8) { t_cls = s_xinfo[0]; t_loc = s_xinfo[1]; t_step = s_xinfo[2]; }
      }
    }
  }
}

#ifndef MK_MULTI
#define MK_MULTI 0
#endif

extern "C" void kernel_launch(void* const* d_in, const int* in_sizes, int n_in, void* d_out, int out_size, void* d_ws,
                              size_t ws_size, hipStream_t stream) {
  (void)in_sizes; (void)n_in; (void)out_size;
  if (ws_size < WS_TOTAL) { fprintf(stderr, "workspace too small: %zu < %zu\n", ws_size, (size_t)WS_TOTAL); return; }
  Params p{};
  p.x = (const float*)d_in[0]; p.pos = (const int*)d_in[1]; p.norm_g = (const float*)d_in[2]; p.w_in = (const float*)d_in[3];
  p.qn_g = (const float*)d_in[4]; p.kvn_g = (const float*)d_in[5]; p.w_uq = (const float*)d_in[6]; p.w_ukv = (const float*)d_in[7];
  p.mla_q_g = (const float*)d_in[8]; p.mla_k_g = (const float*)d_in[9]; p.dsa_q_g = (const float*)d_in[10]; p.dsa_k_g = (const float*)d_in[11];
  p.rel_bias = (const float*)d_in[12]; p.gate_b = (const float*)d_in[13]; p.w_branch = (const float*)d_in[14]; p.w_out = (const float*)d_in[15];
  p.out = (float*)d_out; p.ws = (char*)d_ws;
  static int grid_blocks = 0;
  if (!grid_blocks) {
    int dev = 0, cus = 0, per_cu = 0;
    hipGetDevice(&dev);
    hipDeviceGetAttribute(&cus, hipDeviceAttributeMultiprocessorCount, dev);
    hipOccupancyMaxActiveBlocksPerMultiprocessor(&per_cu, hybrid_megakernel, 256, 0);
    if (per_cu > 2) per_cu = 2;
    grid_blocks = cus * per_cu;
    if (grid_blocks < 8) grid_blocks = 8;
  }
#if MK_MULTI
  for (int ph = 0; ph < N_PHASES; ++ph) {
    hipLaunchKernelGGL(hybrid_megakernel, dim3(grid_blocks), dim3(256), 0, stream, p, ph, ph + 1, 0);
  }
#else
  hipMemsetAsync((char*)d_ws + WS_BAR, 0, 32768, stream);
  int lo = 0, hi = N_PHASES, sy = 1;
  void* args[] = {&p, &lo, &hi, &sy};
  hipError_t e = hipLaunchCooperativeKernel((void*)hybrid_megakernel, dim3(grid_blocks), dim3(256), args, 0, stream);
  if (e != hipSuccess) fprintf(stderr, "cooperative launch failed: %s (grid %d)\n", hipGetErrorString(e), grid_blocks);
#endif
}
```

```cpp
#include <hip/hip_runtime.h>
#include <hip/hip_cooperative_groups.h>
#include <stdint.h>
#include <stdio.h>
namespace cg = cooperative_groups;

typedef unsigned short u16;
typedef __attribute__((ext_vector_type(8))) short bf16x8;
typedef __attribute__((ext_vector_type(16))) float f32x16;
typedef __attribute__((ext_vector_type(2))) float f2_t;
typedef __attribute__((ext_vector_type(2))) __bf16 bf2_t;

#define DI __device__ __forceinline__
#ifndef STAGE_LDS
#define STAGE_LDS 1
#endif
#ifndef BIS1
#define BIS1 0
#endif
#ifndef SEL_NOGUARD
#define SEL_NOGUARD 0
#endif
#define MFMA32(a, b, c) __builtin_amdgcn_mfma_f32_32x32x16_bf16((a), (b), (c), 0, 0, 0)

constexpr int SEQ = 4096, NTOK = 16384, DEPTH = 4;
constexpr int D_IN = 7496, NP = 7552;
constexpr int N_DSV = 2496, N_KPEIXK = 2816;
constexpr int LDP = 6016;
constexpr int LDX = 1088, LDB = 576, LDY = 1600;
constexpr int O_CQ = 0, O_CKV = 256, O_DSQ = 384, O_DSK = 896, O_IXQ = 1024, O_KPE = 1280, O_ZA = 1344, O_G = 2880, O_IXW = 5952;
constexpr float LOG2E = 1.4426950408889634f;
constexpr float C_SB = 0.125f * LOG2E;
constexpr float C_MLA = 0.10206207261596577f * LOG2E;
constexpr float EPS = 1e-6f;

constexpr size_t SZ_WT_IN = (size_t)NP * LDX * 2, SZ_WT_UQ = 768 * 256 * 2, SZ_WT_UKV = 1024 * 128 * 2,
                 SZ_WT_BR = 3 * 1024 * LDB * 2, SZ_WT_OUT = 1024 * LDX * 2;
constexpr size_t OFF_WT_UQ = SZ_WT_IN, OFF_WT_UKV = OFF_WT_UQ + SZ_WT_UQ, OFF_WT_BR = OFF_WT_UKV + SZ_WT_UKV,
                 OFF_WT_OUT = OFF_WT_BR + SZ_WT_BR, SZ_WSET = OFF_WT_OUT + SZ_WT_OUT;
constexpr size_t WS_WT = 0;
constexpr size_t WS_XB = WS_WT + 2 * SZ_WSET;
constexpr size_t WS_XSS = WS_XB + (size_t)NTOK * LDX * 2;
constexpr size_t WS_PROJ = WS_XSS + (size_t)NTOK * 16 * 4;
constexpr size_t WS_QB = WS_PROJ + (size_t)NTOK * LDP * 2;
constexpr size_t WS_KB = WS_QB + (size_t)NTOK * 768 * 2;
constexpr size_t WS_VTA = WS_KB + (size_t)NTOK * 768 * 2;
constexpr size_t WS_VTB = WS_VTA + (size_t)NTOK * 512 * 2;
constexpr size_t WS_VTC = WS_VTB + (size_t)NTOK * 512 * 2;
constexpr size_t WS_YBR = WS_VTC + (size_t)NTOK * 64 * 2;
constexpr size_t WS_BM = WS_YBR + (size_t)NTOK * LDY * 2;
constexpr size_t WS_QA = WS_BM + (size_t)NTOK * 128 * 4;
constexpr size_t WS_KA = WS_QA + (size_t)NTOK * 512 * 2;
constexpr size_t WS_DSQ = WS_KA + (size_t)NTOK * 512 * 2;
constexpr size_t WS_DSK = WS_DSQ + (size_t)NTOK * 512 * 2;
constexpr size_t WS_IXK = WS_DSK + (size_t)NTOK * 64 * 2;
constexpr size_t WS_CTR = WS_IXK + (size_t)NTOK * 32 * 2;
constexpr size_t WS_BAR = WS_CTR + 256;
constexpr size_t WS_PMAX = WS_BAR + 32768;
constexpr size_t WS_TOTAL = WS_PMAX + 4096;
constexpr size_t WS_MERGED = WS_QB;

struct Params {
  const float* x; const int* pos; const float* norm_g; const float* w_in; const float* qn_g; const float* kvn_g;
  const float* w_uq; const float* w_ukv; const float* mla_q_g; const float* mla_k_g; const float* dsa_q_g;
  const float* dsa_k_g; const float* rel_bias; const float* gate_b; const float* w_branch; const float* w_out;
  float* out; char* ws;
};

DI uint32_t pack2(float a, float b) { f2_t v = {a, b}; bf2_t r = __builtin_convertvector(v, bf2_t); return __builtin_bit_cast(uint32_t, r); }
DI float bflo(uint32_t u) { return __uint_as_float(u << 16); }
DI float bfhi(uint32_t u) { return __uint_as_float(u & 0xffff0000u); }
DI float bf1(u16 u) { return __uint_as_float(((uint32_t)u) << 16); }
DI u16 f2bf(float x) { return (u16)(pack2(x, 0.f) & 0xffffu); }
DI float xor32(float v) { return __shfl_xor(v, 32); }
DI float xsum32(float v) { unsigned u = __float_as_uint(v); auto r = __builtin_amdgcn_permlane32_swap(u, u, false, false); return __uint_as_float(r[0]) + __uint_as_float(r[1]); }
DI float xmax32(float v) { unsigned u = __float_as_uint(v); auto r = __builtin_amdgcn_permlane32_swap(u, u, false, false); return fmaxf(__uint_as_float(r[0]), __uint_as_float(r[1])); }
DI int crow(int reg, int h) { return (reg & 3) + 8 * (reg >> 2) + 4 * h; }
DI float fexp2(float x) { return __builtin_amdgcn_exp2f(x); }
DI float frcp(float x) { return __builtin_amdgcn_rcpf(x); }
DI int opaque_tid() { int t = threadIdx.x; asm volatile("" : "+v"(t)); return t; }
DI float fsigmoid(float x) { return frcp(1.f + fexp2(-LOG2E * x)); }
DI f32x16 zero16() { f32x16 z; _Pragma("unroll") for (int i = 0; i < 16; ++i) z[i] = 0.f; return z; }

#define XB_TMO      128
#define XB_XCNT(j)  (256  + 64 * (j))
#define XB_XSUB(j)  (1280 + 64 * (j))
#define XB_XGEN(j)  (2304 + 64 * (j))
#define XB_TOP      3328
#define XB_TOPGEN   3392
#define XCD_BAR_WORDS 3456
#define XB_SPIN_CAP (1u << 22)
#define LAS __attribute__((address_space(3)))
DI unsigned xb_ld(unsigned* p) { return __hip_atomic_load(p, __ATOMIC_RELAXED, __HIP_MEMORY_SCOPE_AGENT); }
DI unsigned xb_add(unsigned* p, unsigned v) { return __hip_atomic_fetch_add(p, v, __ATOMIC_RELAXED, __HIP_MEMORY_SCOPE_AGENT); }
DI unsigned xb_xcc_id() { return (unsigned)__builtin_amdgcn_s_getreg((3 << 11) | 20) & 0xFu; }
#define XB_SPIN(cond, bar) do { unsigned _sp = 0; while (cond) { __builtin_amdgcn_s_sleep(1); \
    if ((++_sp & 255u) == 0u) { if (xb_ld(&(bar)[XB_TMO])) break; if (_sp > XB_SPIN_CAP) { atomicAdd(&(bar)[XB_TMO], 1u); break; } } } } while (0)
struct XcdBarrier { unsigned* bar; unsigned x; volatile LAS unsigned* st; };
DI XcdBarrier xcd_barrier_post(unsigned* bar, volatile LAS unsigned* st) {
  XcdBarrier b; b.bar = bar; b.x = xb_xcc_id(); b.st = st;
  if (threadIdx.x == 0) (void)xb_add(&bar[XB_XCNT(b.x)], 1u);
  return b;
}
DI void xcd_barrier_complete(unsigned* bar, unsigned x, unsigned& nloc, unsigned& nx) {
  const unsigned G = gridDim.x * gridDim.y * gridDim.z;
  unsigned sum, cnt, mine, sp = 0u;
  for (;;) {
    sum = 0u; cnt = 0u; mine = 0u;
#pragma unroll
    for (unsigned j = 0; j < 16; ++j) { const unsigned c = xb_ld(&bar[XB_XCNT(j)]); sum += c; cnt += (c > 0u) ? 1u : 0u; mine = (j == x) ? c : mine; }
    if (sum == G) break;
    __builtin_amdgcn_s_sleep(1);
    if ((++sp & 255u) == 0u) { if (xb_ld(&bar[XB_TMO])) break; if (sp > XB_SPIN_CAP) { atomicAdd(&bar[XB_TMO], 1u); break; } }
  }
  nloc = mine > 0u ? mine : 1u; nx = cnt > 0u ? cnt : 1u;
}
DI void xcd_barrier(const XcdBarrier& b) {
  asm volatile("s_waitcnt vmcnt(0)" ::: "memory");
  __syncthreads();
  if (threadIdx.x == 0) {
    unsigned* bar = b.bar;
    __builtin_amdgcn_s_waitcnt(0);
    unsigned nloc = b.st[0], nx = b.st[1];
    if (nloc == 0u) { xcd_barrier_complete(bar, b.x, nloc, nx); b.st[0] = nloc; b.st[1] = nx; }
    const unsigned old = xb_add(&bar[XB_XSUB(b.x)], 1u);
    const unsigned gen = old / nloc;
    if (old + 1u == (gen + 1u) * nloc) {
      __builtin_amdgcn_fence(__ATOMIC_RELEASE, "agent");
      asm volatile("s_waitcnt vmcnt(0)" ::: "memory");
      const unsigned og = xb_add(&bar[XB_TOP], 1u);
      const unsigned tg = og / nx;
      if (og + 1u == (tg + 1u) * nx) xb_add(&bar[XB_TOPGEN], 1u);
      else XB_SPIN(xb_ld(&bar[XB_TOPGEN]) == tg, bar);
      __builtin_amdgcn_fence(__ATOMIC_ACQUIRE, "agent");
      xb_add(&bar[XB_XGEN(b.x)], 1u);
      asm volatile("s_waitcnt vmcnt(0)" ::: "memory");
    } else {
      XB_SPIN(xb_ld(&bar[XB_XGEN(b.x)]) == gen, bar);
      __builtin_amdgcn_fence(__ATOMIC_ACQUIRE, "agent");
      asm volatile("s_waitcnt vmcnt(0)" ::: "memory");
    }
  }
  __syncthreads();
}

#define XB_RND(j) (3456 + 64 * (j))
DI void class_round_sync(unsigned* bar, int cls, int members) {
  __syncthreads();
  if (threadIdx.x == 0) {
    const unsigned t = xb_add(&bar[XB_RND(cls)], 1u);
    const unsigned target = (t / (unsigned)members + 1u) * (unsigned)members;
    unsigned sp = 0;
    while (xb_ld(&bar[XB_RND(cls)]) < target) { __builtin_amdgcn_s_sleep(1); if (++sp > (1u << 16)) break; }
  }
  __syncthreads();
}

DI int src_col(int n) {
  if (n < 1920) return n;
  if (n < 2816) return n + 32;
  if (n < 2848) return n - 896;
  if (n < 2880) return n;
  if (n < 7488) return n + 8;
  if (n < 7496) return n - 4608;
  return -1;
}
template <bool MAP>
DI void transpose_tile(const float* __restrict__ src, int N, int K, int Nvalid, const float* __restrict__ g,
                       u16* __restrict__ dst, int ldd, int k0, int n0, float* sT) {
  const int tid = opaque_tid();
  const int cg = (tid & 15) * 4, kq = tid >> 4;
  const int sc = MAP ? src_col(n0 + cg) : ((n0 + cg < Nvalid) ? n0 + cg : -1);
#pragma unroll
  for (int i = 0; i < 4; ++i) {
    const int kk = i * 16 + kq;
    float4 v = make_float4(0.f, 0.f, 0.f, 0.f);
    if (sc >= 0) {
      v = *(const float4*)(src + (size_t)(k0 + kk) * N + sc);
      if (g) { const float gg = g[k0 + kk]; v.x *= gg; v.y *= gg; v.z *= gg; v.w *= gg; }
    }
    float* d = sT + kk * 65 + cg;
    d[0] = v.x; d[1] = v.y; d[2] = v.z; d[3] = v.w;
  }
  __syncthreads();
  const int n = tid >> 2, kc = (tid & 3) * 16;
  uint32_t o[8];
#pragma unroll
  for (int j = 0; j < 8; ++j) o[j] = pack2(sT[(kc + 2 * j) * 65 + n], sT[(kc + 2 * j + 1) * 65 + n]);
  uint4* d = (uint4*)(dst + (size_t)(n0 + n) * ldd + k0 + kc);
  d[0] = make_uint4(o[0], o[1], o[2], o[3]);
  d[1] = make_uint4(o[4], o[5], o[6], o[7]);
  __syncthreads();
}

constexpr int CV_IN = 16 * 118, CV_UQ = 4 * 12, CV_UKV = 2 * 16, CV_BR = 3 * 8 * 16, CV_OUT = 16 * 16;
constexpr int CV_TOTAL = CV_IN + CV_UQ + CV_UKV + CV_BR + CV_OUT;

DI void convert_item(const Params& p, int layer, int item, float* sT) {
  char* wset = p.ws + WS_WT + (size_t)(layer & 1) * SZ_WSET;
  if (item < CV_IN) {
    int kt = item & 15, nt = item >> 4;
    transpose_tile<true>(p.w_in + (size_t)layer * 1024 * D_IN, D_IN, 1024, D_IN, p.norm_g + layer * 1024, (u16*)wset, LDX, kt * 64, nt * 64, sT);
    return;
  }
  item -= CV_IN;
  if (item < CV_UQ) {
    int kt = item & 3, nt = item >> 2;
    transpose_tile<false>(p.w_uq + (size_t)layer * 256 * 768, 768, 256, 768, p.qn_g + layer * 256, (u16*)(wset + OFF_WT_UQ), 256, kt * 64, nt * 64, sT);
    return;
  }
  item -= CV_UQ;
  if (item < CV_UKV) {
    int kt = item & 1, nt = item >> 1;
    transpose_tile<false>(p.w_ukv + (size_t)layer * 128 * 1024, 1024, 128, 1024, p.kvn_g + layer * 128, (u16*)(wset + OFF_WT_UKV), 128, kt * 64, nt * 64, sT);
    return;
  }
  item -= CV_UKV;
  if (item < CV_BR) {
    int br = item >> 7, rem = item & 127, kt = rem & 7, nt = rem >> 3;
    transpose_tile<false>(p.w_branch + ((size_t)layer * 3 + br) * 512 * 1024, 1024, 512, 1024, nullptr,
                   (u16*)(wset + OFF_WT_BR) + (size_t)br * 1024 * LDB, LDB, kt * 64, nt * 64, sT);
    return;
  }
  item -= CV_BR;
  {
    int kt = item & 15, nt = item >> 4;
    transpose_tile<false>(p.w_out + (size_t)layer * 1024 * 1024, 1024, 1024, 1024, nullptr, (u16*)(wset + OFF_WT_OUT), LDX, kt * 64, nt * 64, sT);
  }
}

DI void gemm128(const u16* __restrict__ W, int ldw, const u16* __restrict__ X, int ldx, int K, f32x16 (&acc)[2][2], char* smem) {
  typedef u16 (*tile_t)[128][72];
  tile_t sw = (tile_t)smem;
  tile_t sx = (tile_t)(smem + 2 * 128 * 72 * 2);
  const int tid = opaque_tid(), lane = tid & 63, wave = __builtin_amdgcn_readfirstlane(tid >> 6), r = lane & 31, h = lane >> 5;
  const int wn = wave & 1, wm = wave >> 1;
  const int lc = tid & 7, lr = tid >> 3;
  const u16* gw = W + (size_t)lr * ldw + lc * 8;
  const u16* gx = X + (size_t)lr * ldx + lc * 8;
  const u16* gw1 = gw + (size_t)32 * ldw; const u16* gw2 = gw + (size_t)64 * ldw; const u16* gw3 = gw + (size_t)96 * ldw;
  const u16* gx1 = gx + (size_t)32 * ldx; const u16* gx2 = gx + (size_t)64 * ldx; const u16* gx3 = gx + (size_t)96 * ldx;
  uint4 rw0, rw1, rw2, rw3, rx0, rx1, rx2, rx3;
#define G_LOAD(KOFF) do { rw0 = *(const uint4*)(gw + (KOFF)); rw1 = *(const uint4*)(gw1 + (KOFF)); rw2 = *(const uint4*)(gw2 + (KOFF)); rw3 = *(const uint4*)(gw3 + (KOFF)); \
                          rx0 = *(const uint4*)(gx + (KOFF)); rx1 = *(const uint4*)(gx1 + (KOFF)); rx2 = *(const uint4*)(gx2 + (KOFF)); rx3 = *(const uint4*)(gx3 + (KOFF)); } while (0)
#define G_STORE(BUF) do { *(uint4*)&sw[(BUF)][lr][lc * 8] = rw0; *(uint4*)&sw[(BUF)][lr + 32][lc * 8] = rw1; *(uint4*)&sw[(BUF)][lr + 64][lc * 8] = rw2; *(uint4*)&sw[(BUF)][lr + 96][lc * 8] = rw3; \
                          *(uint4*)&sx[(BUF)][lr][lc * 8] = rx0; *(uint4*)&sx[(BUF)][lr + 32][lc * 8] = rx1; *(uint4*)&sx[(BUF)][lr + 64][lc * 8] = rx2; *(uint4*)&sx[(BUF)][lr + 96][lc * 8] = rx3; } while (0)
  G_LOAD(0);
  G_STORE(0);
  const int nk = K >> 6;
  G_LOAD(64);
  __syncthreads();
  for (int kt = 0; kt < nk; ++kt) {
    const int buf = kt & 1;
#pragma unroll
    for (int ks = 0; ks < 4; ++ks) {
      bf16x8 a0 = *(const bf16x8*)&sw[buf][wn * 64 + r][ks * 16 + h * 8];
      bf16x8 a1 = *(const bf16x8*)&sw[buf][wn * 64 + 32 + r][ks * 16 + h * 8];
      bf16x8 b0 = *(const bf16x8*)&sx[buf][wm * 64 + r][ks * 16 + h * 8];
      bf16x8 b1 = *(const bf16x8*)&sx[buf][wm * 64 + 32 + r][ks * 16 + h * 8];
      acc[0][0] = MFMA32(a0, b0, acc[0][0]);
      acc[0][1] = MFMA32(a0, b1, acc[0][1]);
      acc[1][0] = MFMA32(a1, b0, acc[1][0]);
      acc[1][1] = MFMA32(a1, b1, acc[1][1]);
    }
    if (kt + 1 < nk) G_STORE(buf ^ 1);
    if (kt + 2 < nk) G_LOAD((kt + 2) * 64);
    __syncthreads();
  }
#undef G_LOAD
#undef G_STORE
}

template <int NT>
DI bool tile_order(int i, int xcd, int& mt, int& nt) {
  constexpr int PER = 8 * NT;
  if (i >= 2 * PER) return false;
  int mh = i / PER, j = i - mh * PER;
  int ng = j >> 6, w = j & 63;
  mt = xcd * 16 + mh * 8 + (w & 7);
  nt = ng * 8 + (w >> 3);
  return true;
}

DI void phase_proj(const Params& p, int layer, char* smem, int xcd, int loc, int nloc) {
  const u16* WT = (const u16*)(p.ws + WS_WT + (size_t)(layer & 1) * SZ_WSET);
  const u16* XB = (const u16*)(p.ws + WS_XB);
  const float* XSS = (const float*)(p.ws + WS_XSS);
  u16* PROJ = (u16*)(p.ws + WS_PROJ);
  u16* VTA = (u16*)(p.ws + WS_VTA);
  u16* VTC = (u16*)(p.ws + WS_VTC);
  const int tid = opaque_tid(), lane = tid & 63, wave = __builtin_amdgcn_readfirstlane(tid >> 6), r = lane & 31, h = lane >> 5;
  const int wn = wave & 1, wm = wave >> 1;
  for (int i = loc;; i += nloc) {
    int mt, nt;
    if (!tile_order<59>(i, xcd, mt, nt)) break;
    const int m0 = mt * 128, n0 = nt * 128;
    f32x16 acc[2][2];
    acc[0][0] = zero16(); acc[0][1] = zero16(); acc[1][0] = zero16(); acc[1][1] = zero16();
    float rinv2[2];
#pragma unroll
    for (int mi = 0; mi < 2; ++mi) {
      const float4* sp = (const float4*)(XSS + (size_t)(m0 + wm * 64 + mi * 32 + r) * 16);
      float4 q0 = sp[0], q1 = sp[1], q2 = sp[2], q3 = sp[3];
      float ss = ((q0.x + q0.y) + (q0.z + q0.w)) + ((q1.x + q1.y) + (q1.z + q1.w)) + ((q2.x + q2.y) + (q2.z + q2.w)) + ((q3.x + q3.y) + (q3.z + q3.w));
      rinv2[mi] = rsqrtf(ss * (1.f / 1024.f) + EPS);
    }
    gemm128(WT + (size_t)n0 * LDX, LDX, XB + (size_t)m0 * LDX, LDX, 1024, acc, smem);
    {
      const int nb = n0 + wn * 64;
      const int mb = m0 + wm * 64;
      const int b = mb >> 12, s0 = mb & 4095;
      u16 (*st)[72] = (u16 (*)[72])(smem + ((wave & 2) ? 55296 : 18432) + (wave & 1) * 9216);
      const bool transposed = (nb >= 1024 && nb < 1536) || (nb == N_DSV);
      const float cs = (nb < 512) ? C_SB : 1.f;
      u16* dst; size_t rstride;
      if (nb < 512) { dst = (u16*)(p.ws + WS_QA) + ((size_t)(b * 8 + (nb >> 6)) * 4096 + s0) * 64; rstride = 64; }
      else if (nb < 1024) { dst = (u16*)(p.ws + WS_KA) + ((size_t)(b * 8 + ((nb - 512) >> 6)) * 4096 + s0) * 64; rstride = 64; }
      else if (nb < 1536) { dst = VTA + ((size_t)(b * 8 + ((nb - 1024) >> 6)) * 64) * 4096 + s0; rstride = 4096; }
      else if (nb == N_DSV) { dst = VTC + ((size_t)b * 64) * 4096 + s0; rstride = 4096; }
      else { dst = PROJ + (size_t)mb * LDP + (nb - 1536); rstride = LDP; }
#pragma unroll
      for (int mi = 0; mi < 2; ++mi) {
        const int m = mb + mi * 32 + r;
        const float rinv = rinv2[mi] * cs;
#pragma unroll
        for (int ni = 0; ni < 2; ++ni) {
          if (transposed) {
#pragma unroll
            for (int i = 0; i < 16; ++i) {
              if (STAGE_LDS) st[ni * 32 + crow(i, h)][mi * 32 + r] = f2bf(acc[ni][mi][i] * rinv);
              else dst[(size_t)(ni * 32 + crow(i, h)) * rstride + mi * 32 + r] = f2bf(acc[ni][mi][i] * rinv);
            }
          } else {
#pragma unroll
            for (int g = 0; g < 4; ++g) {
              const uint2 v = make_uint2(pack2(acc[ni][mi][4 * g] * rinv, acc[ni][mi][4 * g + 1] * rinv), pack2(acc[ni][mi][4 * g + 2] * rinv, acc[ni][mi][4 * g + 3] * rinv));
              if (STAGE_LDS) *(uint2*)&st[mi * 32 + r][ni * 32 + 8 * g + 4 * h] = v;
              else {
                *(uint2*)(dst + (size_t)(mi * 32 + r) * rstride + ni * 32 + 8 * g + 4 * h) = v;
                if (nb == N_KPEIXK && ni == 1) *(uint2*)((u16*)(p.ws + WS_IXK) + (size_t)m * 32 + 8 * g + 4 * h) = v;
              }
            }
          }
        }
      }
      if (STAGE_LDS) {
        __builtin_amdgcn_wave_barrier();
        asm volatile("s_waitcnt lgkmcnt(0)" ::: "memory");
        const int rr = lane >> 3, cc = lane & 7;
#pragma unroll
        for (int it = 0; it < 8; ++it) {
          const int row = it * 8 + rr;
          uint4 v = *(const uint4*)&st[row][cc * 8];
          *(uint4*)(dst + (size_t)row * rstride + cc * 8) = v;
          if (nb == N_KPEIXK && cc >= 4) *(uint4*)((u16*)(p.ws + WS_IXK) + (size_t)(mb + row) * 32 + (cc - 4) * 8) = v;
        }
      }
    }
  }
}

DI void phase_proj_probe(const Params& p, int layer, char* smem, int xcd, int loc, int nloc) {
  const u16* WT = (const u16*)(p.ws + WS_WT + (size_t)(layer & 1) * SZ_WSET);
  const u16* XB = (const u16*)(p.ws + WS_XB);
  float tot = 0.f;
  for (int i = loc;; i += nloc) {
    int mt, nt;
    if (!tile_order<59>(i, xcd, mt, nt)) break;
    f32x16 acc[2][2];
    acc[0][0] = zero16(); acc[0][1] = zero16(); acc[1][0] = zero16(); acc[1][1] = zero16();
    gemm128(WT, LDX, XB, LDX, 1024, acc, smem);
    tot += acc[0][0][0] + acc[0][1][3] + acc[1][0][5] + acc[1][1][7];
  }
  if (tot == 12345.678f) ((float*)(p.ws + WS_CTR))[32] = tot;
}

DI void prep_item(const Params& p, int layer, int item) {
  const char* wset = p.ws + WS_WT + (size_t)(layer & 1) * SZ_WSET;
  const u16* WUQ = (const u16*)(wset + OFF_WT_UQ);
  const u16* WUKV = (const u16*)(wset + OFF_WT_UKV);
  u16* PROJ = (u16*)(p.ws + WS_PROJ);
  u16* QB = (u16*)(p.ws + WS_QB);
  u16* KB = (u16*)(p.ws + WS_KB);
  u16* VTB = (u16*)(p.ws + WS_VTB);
  const int lane = opaque_tid() & 63, r = lane & 31, h = lane >> 5;
  const int tg = item >> 3, hd = item & 7;
  const int token = tg * 32 + r, b = token >> 12, s = token & 4095;
  u16* prow = PROJ + (size_t)token * LDP;

  const float posf = (float)p.pos[token];
  float cs[8], sn[8];
  {
    const float IF0[8] = {1.0f, 0.5623413251903491f, 0.31622776601683794f, 0.1778279410038923f, 0.01f, 0.005623413251903491f, 0.0031622776601683794f, 0.0017782794100389228f};
    const float IF1[8] = {0.1f, 0.05623413251903491f, 0.03162277660168379f, 0.01778279410038923f, 0.001f, 0.0005623413251903491f, 0.00031622776601683794f, 0.00017782794100389227f};
#pragma unroll
    for (int reg = 0; reg < 8; ++reg) {
      const float inv = h ? IF1[reg] : IF0[reg];
      const float ang = posf * inv;
      double rv = (double)ang * 0.15915494309189535;
      rv -= rint(rv);
      const float fr = (float)rv;
      sn[reg] = __builtin_amdgcn_sinf(fr);
      cs[reg] = __builtin_amdgcn_cosf(fr);
    }
  }

  {
    bf16x8 bq[16];
    float ss = 0.f;
#pragma unroll
    for (int ks = 0; ks < 16; ++ks) {
      uint4 u = *(const uint4*)(prow + O_CQ + ks * 16 + 8 * h);
      bq[ks] = __builtin_bit_cast(bf16x8, u);
      float f;
      f = bflo(u.x); ss += f * f; f = bfhi(u.x); ss += f * f; f = bflo(u.y); ss += f * f; f = bfhi(u.y); ss += f * f;
      f = bflo(u.z); ss += f * f; f = bfhi(u.z); ss += f * f; f = bflo(u.w); ss += f * f; f = bfhi(u.w); ss += f * f;
    }
    ss += xor32(ss);
    const float rq = rsqrtf(ss * (1.f / 256.f) + EPS);
    f32x16 acc[3];
    acc[0] = zero16(); acc[1] = zero16(); acc[2] = zero16();
    const u16* wq = WUQ + (size_t)(hd * 96 + r) * 256 + 8 * h;
#pragma unroll
    for (int ks = 0; ks < 16; ++ks) {
#pragma unroll
      for (int nt = 0; nt < 3; ++nt) {
        bf16x8 a = *(const bf16x8*)(wq + (size_t)nt * 32 * 256 + ks * 16);
        acc[nt] = MFMA32(a, bq[ks], acc[nt]);
      }
    }
    float ss2 = 0.f;
#pragma unroll
    for (int nt = 0; nt < 3; ++nt)
#pragma unroll
      for (int i = 0; i < 16; ++i) { acc[nt][i] *= rq; ss2 += acc[nt][i] * acc[nt][i]; }
    ss2 += xor32(ss2);
    const float r2 = rsqrtf(ss2 * (1.f / 96.f) + EPS);
    const float* gq = p.mla_q_g + layer * 96;
#pragma unroll
    for (int nt = 0; nt < 3; ++nt)
#pragma unroll
      for (int g = 0; g < 4; ++g) {
        float4 gg = *(const float4*)(gq + nt * 32 + 8 * g + 4 * h);
        acc[nt][4 * g] *= r2 * gg.x; acc[nt][4 * g + 1] *= r2 * gg.y; acc[nt][4 * g + 2] *= r2 * gg.z; acc[nt][4 * g + 3] *= r2 * gg.w;
      }
#pragma unroll
    for (int reg = 0; reg < 8; ++reg) {
      float x1 = acc[2][reg], x2 = acc[2][reg + 8];
      acc[2][reg] = x1 * cs[reg] - x2 * sn[reg];
      acc[2][reg + 8] = x2 * cs[reg] + x1 * sn[reg];
    }
    u16* qo = QB + ((size_t)token * 8 + hd) * 96;
#pragma unroll
    for (int nt = 0; nt < 3; ++nt)
#pragma unroll
      for (int g = 0; g < 4; ++g)
        *(uint2*)(qo + nt * 32 + 8 * g + 4 * h) = make_uint2(pack2(acc[nt][4 * g] * C_MLA, acc[nt][4 * g + 1] * C_MLA), pack2(acc[nt][4 * g + 2] * C_MLA, acc[nt][4 * g + 3] * C_MLA));
  }
  {
    bf16x8 bk[8];
    float ss = 0.f;
#pragma unroll
    for (int ks = 0; ks < 8; ++ks) {
      uint4 u = *(const uint4*)(prow + O_CKV + ks * 16 + 8 * h);
      bk[ks] = __builtin_bit_cast(bf16x8, u);
      float f;
      f = bflo(u.x); ss += f * f; f = bfhi(u.x); ss += f * f; f = bflo(u.y); ss += f * f; f = bfhi(u.y); ss += f * f;
      f = bflo(u.z); ss += f * f; f = bfhi(u.z); ss += f * f; f = bflo(u.w); ss += f * f; f = bfhi(u.w); ss += f * f;
    }
    ss += xor32(ss);
    const float rkv = rsqrtf(ss * (1.f / 128.f) + EPS);
    f32x16 acc[4];
    acc[0] = zero16(); acc[1] = zero16(); acc[2] = zero16(); acc[3] = zero16();
    const u16* wk = WUKV + (size_t)(hd * 128 + r) * 128 + 8 * h;
#pragma unroll
    for (int ks = 0; ks < 8; ++ks) {
#pragma unroll
      for (int nt = 0; nt < 4; ++nt) {
        bf16x8 a = *(const bf16x8*)(wk + (size_t)nt * 32 * 128 + ks * 16);
        acc[nt] = MFMA32(a, bk[ks], acc[nt]);
      }
    }
    float kpe[16];
#pragma unroll
    for (int g = 0; g < 4; ++g) {
      uint2 u = *(const uint2*)(prow + O_KPE + 8 * g + 4 * h);
      kpe[4 * g] = bflo(u.x); kpe[4 * g + 1] = bfhi(u.x); kpe[4 * g + 2] = bflo(u.y); kpe[4 * g + 3] = bfhi(u.y);
    }
    float ss2 = 0.f;
#pragma unroll
    for (int nt = 0; nt < 4; ++nt)
#pragma unroll
      for (int i = 0; i < 16; ++i) acc[nt][i] *= rkv;
#pragma unroll
    for (int i = 0; i < 16; ++i) ss2 += acc[0][i] * acc[0][i] + acc[1][i] * acc[1][i] + kpe[i] * kpe[i];
    ss2 += xor32(ss2);
    const float r2 = rsqrtf(ss2 * (1.f / 96.f) + EPS);
    const float* gk = p.mla_k_g + layer * 96;
#pragma unroll
    for (int g = 0; g < 4; ++g) {
      float4 g0 = *(const float4*)(gk + 8 * g + 4 * h);
      float4 g1 = *(const float4*)(gk + 32 + 8 * g + 4 * h);
      float4 g2 = *(const float4*)(gk + 64 + 8 * g + 4 * h);
      acc[0][4 * g] *= r2 * g0.x; acc[0][4 * g + 1] *= r2 * g0.y; acc[0][4 * g + 2] *= r2 * g0.z; acc[0][4 * g + 3] *= r2 * g0.w;
      acc[1][4 * g] *= r2 * g1.x; acc[1][4 * g + 1] *= r2 * g1.y; acc[1][4 * g + 2] *= r2 * g1.z; acc[1][4 * g + 3] *= r2 * g1.w;
      kpe[4 * g] *= r2 * g2.x; kpe[4 * g + 1] *= r2 * g2.y; kpe[4 * g + 2] *= r2 * g2.z; kpe[4 * g + 3] *= r2 * g2.w;
    }
#pragma unroll
    for (int reg = 0; reg < 8; ++reg) {
      float x1 = kpe[reg], x2 = kpe[reg + 8];
      kpe[reg] = x1 * cs[reg] - x2 * sn[reg];
      kpe[reg + 8] = x2 * cs[reg] + x1 * sn[reg];
    }
    u16* ko = KB + ((size_t)token * 8 + hd) * 96;
#pragma unroll
    for (int g = 0; g < 4; ++g) {
      *(uint2*)(ko + 8 * g + 4 * h) = make_uint2(pack2(acc[0][4 * g], acc[0][4 * g + 1]), pack2(acc[0][4 * g + 2], acc[0][4 * g + 3]));
      *(uint2*)(ko + 32 + 8 * g + 4 * h) = make_uint2(pack2(acc[1][4 * g], acc[1][4 * g + 1]), pack2(acc[1][4 * g + 2], acc[1][4 * g + 3]));
      *(uint2*)(ko + 64 + 8 * g + 4 * h) = make_uint2(pack2(kpe[4 * g], kpe[4 * g + 1]), pack2(kpe[4 * g + 2], kpe[4 * g + 3]));
    }
#pragma unroll
    for (int nt = 2; nt < 4; ++nt)
#pragma unroll
      for (int i = 0; i < 16; ++i) {
        const int d = (nt - 2) * 32 + crow(i, h);
        VTB[((size_t)((b * 8 + hd) * 64 + d)) * 4096 + s] = f2bf(acc[nt][i]);
      }
  }
  {
    const u16* qp = prow + O_DSQ + hd * 64 + 32 * h;
    u16* qo = (u16*)(p.ws + WS_DSQ) + ((size_t)token * 8 + hd) * 64 + 32 * h;
    uint4 u[4];
    float f[32];
    float ss = 0.f;
#pragma unroll
    for (int i = 0; i < 4; ++i) {
      u[i] = *(const uint4*)(qp + 8 * i);
      f[8 * i] = bflo(u[i].x); f[8 * i + 1] = bfhi(u[i].x); f[8 * i + 2] = bflo(u[i].y); f[8 * i + 3] = bfhi(u[i].y);
      f[8 * i + 4] = bflo(u[i].z); f[8 * i + 5] = bfhi(u[i].z); f[8 * i + 6] = bflo(u[i].w); f[8 * i + 7] = bfhi(u[i].w);
    }
#pragma unroll
    for (int i = 0; i < 32; ++i) ss += f[i] * f[i];
    ss += xor32(ss);
    const float rr = rsqrtf(ss * (1.f / 64.f) + EPS) * C_SB;
    const float* gq = p.dsa_q_g + layer * 64 + 32 * h;
#pragma unroll
    for (int i = 0; i < 4; ++i) {
      float4 ga = *(const float4*)(gq + 8 * i), gb = *(const float4*)(gq + 8 * i + 4);
      *(uint4*)(qo + 8 * i) = make_uint4(pack2(f[8 * i] * rr * ga.x, f[8 * i + 1] * rr * ga.y), pack2(f[8 * i + 2] * rr * ga.z, f[8 * i + 3] * rr * ga.w),
                                         pack2(f[8 * i + 4] * rr * gb.x, f[8 * i + 5] * rr * gb.y), pack2(f[8 * i + 6] * rr * gb.z, f[8 * i + 7] * rr * gb.w));
    }
  }
  if (hd == 1) {
    int pm = p.pos[token];
#pragma unroll
    for (int off = 1; off < 32; off <<= 1) { const int o = __shfl_xor(pm, off); pm = pm > o ? pm : o; }
    if (lane == 0) ((int*)(p.ws + WS_PMAX))[tg] = pm;
  }
  if (hd == 0) {
    const u16* kp = prow + O_DSK + 32 * h;
    u16* ko2 = (u16*)(p.ws + WS_DSK) + (size_t)token * 64 + 32 * h;
    float f[32];
    float ss = 0.f;
#pragma unroll
    for (int i = 0; i < 4; ++i) {
      uint4 u = *(const uint4*)(kp + 8 * i);
      f[8 * i] = bflo(u.x); f[8 * i + 1] = bfhi(u.x); f[8 * i + 2] = bflo(u.y); f[8 * i + 3] = bfhi(u.y);
      f[8 * i + 4] = bflo(u.z); f[8 * i + 5] = bfhi(u.z); f[8 * i + 6] = bflo(u.w); f[8 * i + 7] = bfhi(u.w);
    }
#pragma unroll
    for (int i = 0; i < 32; ++i) ss += f[i] * f[i];
    ss += xor32(ss);
    const float rr = rsqrtf(ss * (1.f / 64.f) + EPS);
    const float* gk = p.dsa_k_g + layer * 64 + 32 * h;
#pragma unroll
    for (int i = 0; i < 4; ++i) {
      float4 ga = *(const float4*)(gk + 8 * i), gb = *(const float4*)(gk + 8 * i + 4);
      *(uint4*)(ko2 + 8 * i) = make_uint4(pack2(f[8 * i] * rr * ga.x, f[8 * i + 1] * rr * ga.y), pack2(f[8 * i + 2] * rr * ga.z, f[8 * i + 3] * rr * ga.w),
                                         pack2(f[8 * i + 4] * rr * gb.x, f[8 * i + 5] * rr * gb.y), pack2(f[8 * i + 6] * rr * gb.z, f[8 * i + 7] * rr * gb.w));
    }
  }
}

struct SelSmem { uint32_t hist[2][4096]; uint32_t pfx[4]; uint32_t need[4]; uint32_t dcut[4]; uint32_t flag; };

template <int PASS>
DI void sel_pass(SelSmem* S, const uint32_t (&sk)[32][2], int ntiles, uint32_t (&pf)[2]) {
  const int tid = opaque_tid(), lane = tid & 63, wave = __builtin_amdgcn_readfirstlane(tid >> 6), r = lane & 31, h = lane >> 5;
  {
    uint4* hz = (uint4*)&S->hist[0][0];
#pragma unroll
    for (int i = 0; i < 8; ++i) hz[tid + 256 * i] = make_uint4(0, 0, 0, 0);
  }
  __syncthreads();
#pragma unroll
  for (int i = 0; i < 32; ++i) {
    const int tile = i * 4 + wave;
    if (tile < ntiles) {
#pragma unroll
      for (int j = 0; j < 2; ++j) {
        const uint32_t k = sk[i][j];
        bool match; uint32_t digit;
        if (PASS == 0) { match = (k != 0u); digit = k >> 20; }
        else if (PASS == 1) { match = ((k >> 20) == pf[j]); digit = (k >> 10) & 1023u; }
        else if (PASS == 2) { match = ((k >> 10) == pf[j]); digit = k & 1023u; }
        else { match = (k == pf[j]); digit = 4095u - (uint32_t)(tile * 32 + r); }
        if (match) atomicAdd(&S->hist[h][digit], j ? 0x10000u : 1u);
      }
    }
  }
  __syncthreads();
  {
    constexpr int PER = (PASS == 0 || PASS == 3) ? 64 : 16;
    const int pair = wave >> 1, sh = (wave & 1) * 16;
    const uint32_t need = S->need[wave];
    const uint32_t prevp = S->pfx[wave];
    const uint32_t* hp = &S->hist[pair][lane * PER];
    uint32_t tot = 0;
    for (int c = 0; c < PER; ++c) tot += (hp[(c + lane) & (PER - 1)] >> sh) & 0xffffu;
    uint32_t incl = tot;
#pragma unroll
    for (int off = 1; off < 64; off <<= 1) {
      uint32_t v = __shfl_down(incl, off);
      if (lane + off < 64) incl += v;
    }
    const uint32_t sfx = incl - tot;
    const bool cross = (sfx < need) && (need <= sfx + tot);
    const unsigned long long cm = __ballot(cross);
    if (cm != 0ull) {
      const int L = __builtin_ctzll(cm);
      const uint32_t cumbase = (uint32_t)__shfl((int)sfx, L);
      const uint32_t cnt = (lane < PER) ? ((S->hist[pair][L * PER + lane] >> sh) & 0xffffu) : 0u;
      uint32_t inc2 = cnt;
#pragma unroll
      for (int off = 1; off < PER; off <<= 1) {
        uint32_t v = __shfl_down(inc2, off);
        if (lane + off < 64) inc2 += v;
      }
      const uint32_t cum = cumbase + (inc2 - cnt);
      if (lane < PER && cum < need && need <= cum + cnt) {
        const uint32_t bin = (uint32_t)(L * PER + lane);
        const uint32_t nn = need - cum;
        if (PASS == 0) S->pfx[wave] = bin;
        else if (PASS == 1 || PASS == 2) S->pfx[wave] = (prevp << 10) | bin;
        else S->dcut[wave] = bin;
        if (PASS == 2 && cnt != nn) atomicOr(&S->flag, 1u);
        if (PASS == 1 && cnt != nn) atomicOr(&S->flag, 2u);
        S->need[wave] = nn;
      }
    }
  }
  __syncthreads();
  if (PASS < 3) { pf[0] = S->pfx[2 * h]; pf[1] = S->pfx[2 * h + 1]; }
}

DI void select_item(const Params& p, int item, char* smem) {
  SelSmem* S = (SelSmem*)smem;
  const u16* PROJ = (const u16*)(p.ws + WS_PROJ);
  uint32_t* BM = (uint32_t*)(p.ws + WS_BM);
  const int b = item & 3, t0 = (1023 - (item >> 2)) * 4;
  const int tokbase = b * 4096;
  const int tid = opaque_tid(), lane = tid & 63, wave = __builtin_amdgcn_readfirstlane(tid >> 6), r = lane & 31, h = lane >> 5;
  if (t0 + 3 < 256) {
    if (tid < 32) {
      const int q = tid >> 3, tile = tid & 7, t = t0 + q;
      uint32_t wd = (tile < (t >> 5)) ? 0xffffffffu : (tile == (t >> 5) ? (0xffffffffu >> (31 - (t & 31))) : 0u);
      BM[(size_t)(tokbase + t) * 128 + tile] = wd;
    }
    return;
  }
  const int ntiles = 2 * (t0 >> 6) + 2;
  if (tid < 4) { S->need[tid] = 256u; S->pfx[tid] = 0u; S->dcut[tid] = 0u; }
  if (tid == 4) S->flag = 0u;
  bf16x8 a0, a1;
  {
    const int hb = (r >> 2) & 1, idx16 = (r & 3) + 4 * (r >> 3);
    const int q = 2 * hb + (idx16 >> 3), head = idx16 & 7;
    const u16* aq = PROJ + (size_t)(tokbase + t0 + q) * LDP + O_IXQ + head * 32 + 8 * h;
    a0 = *(const bf16x8*)aq;
    a1 = *(const bf16x8*)(aq + 16);
  }
  float wv[16];
#pragma unroll
  for (int j = 0; j < 2; ++j) {
    uint4 u = *(const uint4*)(PROJ + (size_t)(tokbase + t0 + 2 * h + j) * LDP + O_IXW);
    const float c = 0.35355339059327373f * 0.17677669529663687f;
    wv[8 * j] = bflo(u.x) * c; wv[8 * j + 1] = bfhi(u.x) * c; wv[8 * j + 2] = bflo(u.y) * c; wv[8 * j + 3] = bfhi(u.y) * c;
    wv[8 * j + 4] = bflo(u.z) * c; wv[8 * j + 5] = bfhi(u.z) * c; wv[8 * j + 6] = bflo(u.w) * c; wv[8 * j + 7] = bfhi(u.w) * c;
  }
  const u16* IXK = (const u16*)(p.ws + WS_IXK) + (size_t)tokbase * 32;
  uint32_t sk[32][2];
  bf16x8 ka0[4], ka1[4], kb0[4], kb1[4];
#define SEL_LOAD(S0, S1, CC)                                                          \
  _Pragma("unroll") for (int ii = 0; ii < 4; ++ii) {                                   \
    const int key_ = ((((CC) * 4 + ii) * 4 + wave) * 32) + r;                          \
    const u16* kp_ = BIS1 ? (PROJ + (size_t)(tokbase + key_) * LDP + O_KPE + 32 + 8 * h) : (IXK + (size_t)key_ * 32 + 8 * h); \
    S0[ii] = *(const bf16x8*)kp_; S1[ii] = *(const bf16x8*)(kp_ + 16);                 \
  }
#define SEL_COMP(S0, S1, CC)                                                          \
  _Pragma("unroll") for (int ii = 0; ii < 4; ++ii) {                                   \
    const int i_ = (CC) * 4 + ii;                                                      \
    const int key_ = (i_ * 4 + wave) * 32 + r;                                         \
    f32x16 acc_ = zero16();                                                            \
    acc_ = MFMA32(a0, S0[ii], acc_);                                                   \
    acc_ = MFMA32(a1, S1[ii], acc_);                                                   \
    _Pragma("unroll") for (int j = 0; j < 2; ++j) {                                    \
      float sc_ = 0.f;                                                                 \
      _Pragma("unroll") for (int hd = 0; hd < 8; ++hd) sc_ = fmaf(wv[8 * j + hd], fmaxf(acc_[8 * j + hd], 0.f), sc_); \
      sc_ += 0.0f;                                                                     \
      const uint32_t bits_ = __float_as_uint(sc_);                                     \
      const uint32_t k32_ = bits_ ^ (((uint32_t)((int32_t)bits_ >> 31)) | 0x80000000u); \
      sk[i_][j] = (key_ <= t0 + 2 * h + j) ? k32_ : 0u;                                \
    }                                                                                  \
  }
#define SEL_ZERO(CC) _Pragma("unroll") for (int ii = 0; ii < 4; ++ii) { sk[(CC) * 4 + ii][0] = 0u; sk[(CC) * 4 + ii][1] = 0u; }
  if (wave < ntiles) { SEL_LOAD(ka0, ka1, 0) }
#pragma unroll
  for (int cc = 0; cc < 8; cc += 2) {
    if (16 * (cc + 1) + wave < ntiles) { SEL_LOAD(kb0, kb1, cc + 1) }
    if (16 * cc + wave < ntiles) { SEL_COMP(ka0, ka1, cc) } else { SEL_ZERO(cc) }
    if (cc + 2 < 8) { if (16 * (cc + 2) + wave < ntiles) { SEL_LOAD(ka0, ka1, cc + 2) } }
    if (16 * (cc + 1) + wave < ntiles) { SEL_COMP(kb0, kb1, cc + 1) } else { SEL_ZERO(cc + 1) }
  }
#undef SEL_LOAD
#undef SEL_COMP
#undef SEL_ZERO
  uint32_t pf[2] = {0u, 0u};
  sel_pass<0>(S, sk, ntiles, pf);
  sel_pass<1>(S, sk, ntiles, pf);
  if (S->flag & 2u) sel_pass<2>(S, sk, ntiles, pf);
  else { pf[0] <<= 10; pf[1] <<= 10; }
  uint32_t dc[2] = {0u, 0u};
  if (S->flag & 1u) {
    sel_pass<3>(S, sk, ntiles, pf);
    dc[0] = S->dcut[2 * h]; dc[1] = S->dcut[2 * h + 1];
  }
#pragma unroll
  for (int i = 0; i < 32; ++i) {
    const int tile = i * 4 + wave;
    if (tile < ntiles) {
      const uint32_t di = 4095u - (uint32_t)(tile * 32 + r);
#pragma unroll
      for (int j = 0; j < 2; ++j) {
        const uint32_t k = sk[i][j];
        const bool sel = (k > pf[j]) || (k == pf[j] && di >= dc[j]);
        const unsigned long long m = __ballot(sel);
        if (lane == 0) {
          BM[(size_t)(tokbase + t0 + j) * 128 + tile] = (uint32_t)m;
          BM[(size_t)(tokbase + t0 + 2 + j) * 128 + tile] = (uint32_t)(m >> 32);
        }
      }
    }
  }
  __syncthreads();
}

DI bool softmax_bound_ok(const Params& p, int layer, int mode) {
  const int lane = threadIdx.x & 63;
  const float* gq = (mode == 1) ? (p.mla_q_g + layer * 96) : (p.dsa_q_g + layer * 64);
  const float* gk = (mode == 1) ? (p.mla_k_g + layer * 96) : (p.dsa_k_g + layer * 64);
  const int ng = (mode == 1) ? 96 : 64;
  float aq = 0.f, ak = 0.f, ab = 0.f;
  for (int i = lane; i < ng; i += 64) { aq = fmaxf(aq, fabsf(gq[i])); ak = fmaxf(ak, fabsf(gk[i])); }
  if (mode == 2) { for (int i = lane; i < 256; i += 64) ab = fmaxf(ab, fabsf(p.rel_bias[i])); }
#pragma unroll
  for (int off = 1; off < 64; off <<= 1) { aq = fmaxf(aq, __shfl_xor(aq, off)); ak = fmaxf(ak, __shfl_xor(ak, off)); ab = fmaxf(ab, __shfl_xor(ab, off)); }
  const float bound = ((mode == 1) ? 9.7979590f * aq * ak : 8.f * aq * ak + 2.f * ab) * LOG2E * 1.02f;
  return __builtin_amdgcn_readfirstlane((bound < 100.f) ? 1 : 0) != 0;
}

template <int MODE, bool FAST>
DI void attn_item(const Params& p, int layer, int b, int hd, int qt, char* smem) {
  constexpr int DK = (MODE == 1) ? 96 : 64;
  constexpr int KS = DK / 16;
  constexpr int KROW = DK + 8;
  constexpr int KCH = DK / 8;
  constexpr int NKL = (64 * KCH) / 256;
  typedef u16 (*kt_t)[64][KROW];
  typedef u16 (*vt_t)[64][72];
  kt_t sK = (kt_t)smem;
  vt_t sV = (vt_t)(smem + 2 * 64 * KROW * 2);
  int* sPos = (int*)(smem + 2 * 64 * KROW * 2 + 2 * 64 * 72 * 2);
  float* sBias = (float*)(smem + 2 * 64 * KROW * 2 + 2 * 64 * 72 * 2 + 512);
  int* sWd = (int*)(smem + 2 * 64 * KROW * 2 + 2 * 64 * 72 * 2 + 512 + 4096);

  const u16* PROJ = (const u16*)(p.ws + WS_PROJ);
  u16* YBR = (u16*)(p.ws + WS_YBR);
  const uint32_t* BM = (const uint32_t*)(p.ws + WS_BM);
  const int tid = opaque_tid(), lane = tid & 63, wave = __builtin_amdgcn_readfirstlane(tid >> 6), r = lane & 31, h = lane >> 5;
  const int tokbase = b * 4096;

  int tq, hdl, wmin, wmax, nt64;
  const u16* qrow;
  const u16* kbase; size_t kstride;
  const u16* vbase;
  if (MODE == 0) {
    tq = qt * 128 + wave * 32 + r; hdl = hd; wmin = qt * 128 + wave * 32; wmax = wmin + 31; nt64 = 2 * qt + 2;
    qrow = (const u16*)(p.ws + WS_QA) + ((size_t)(b * 8 + hd) * 4096 + tq) * 64;
    kbase = (const u16*)(p.ws + WS_KA) + ((size_t)(b * 8 + hd) * 4096) * 64; kstride = 64;
    vbase = (const u16*)(p.ws + WS_VTA) + (size_t)((b * 8 + hd) * 64) * 4096;
  } else if (MODE == 1) {
    tq = qt * 128 + wave * 32 + r; hdl = hd; wmin = qt * 128 + wave * 32; wmax = wmin + 31; nt64 = 2 * qt + 2;
    qrow = (const u16*)(p.ws + WS_QB) + ((size_t)(tokbase + tq) * 8 + hd) * 96;
    kbase = (const u16*)(p.ws + WS_KB) + ((size_t)tokbase * 8 + hd) * 96; kstride = 768;
    vbase = (const u16*)(p.ws + WS_VTB) + (size_t)((b * 8 + hd) * 64) * 4096;
  } else {
    tq = qt * 16 + wave * 4 + (r >> 3); hdl = r & 7; wmin = qt * 16 + wave * 4; wmax = wmin + 3; nt64 = (qt >> 2) + 1;
    qrow = (const u16*)(p.ws + WS_DSQ) + ((size_t)(tokbase + tq) * 8 + hdl) * 64;
    kbase = (const u16*)(p.ws + WS_DSK) + (size_t)tokbase * 64; kstride = 64;
    vbase = (const u16*)(p.ws + WS_VTC) + (size_t)(b * 64) * 4096;
  }
  int posq = 0, wposmin = 0;
  if (MODE == 2) {
    posq = p.pos[tokbase + tq];
    wposmin = posq;
#pragma unroll
    for (int off = 1; off < 64; off <<= 1) { const int o = __shfl_xor(wposmin, off); wposmin = wposmin < o ? wposmin : o; }
    wposmin = __builtin_amdgcn_readfirstlane(wposmin);
    for (int e = tid; e < 1024; e += 256) {
      const int n = e >> 3, hh = e & 7;
      int bk = n;
      if (n >= 16) {
        bk = 16 + (n >= 19) + (n >= 21) + (n >= 24) + (n >= 27) + (n >= 31) + (n >= 35) + (n >= 40) + (n >= 46) + (n >= 52) + (n >= 59) + (n >= 67) + (n >= 77) + (n >= 87) + (n >= 99) + (n >= 113);
      }
      sBias[e] = (p.rel_bias[bk * 8 + hh] - p.rel_bias[31 * 8 + hh]) * LOG2E;
    }
  }
  constexpr bool fastsm = FAST;
  bf16x8 qf[KS];
#pragma unroll
  for (int ks = 0; ks < KS; ++ks) qf[ks] = *(const bf16x8*)(qrow + ks * 16 + 8 * h);

  f32x16 o[2];
  o[0] = zero16(); o[1] = zero16();
  float carry = 1.f;
  float mrun = -INFINITY, lrun = 0.f;

  uint4 rk0, rk1, rk2 = make_uint4(0, 0, 0, 0), rv0, rv1;
  int rp = 0;
  const int krow0 = tid / KCH, kc0 = tid - krow0 * KCH;
  const int krow1 = (tid + 256) / KCH, kc1 = (tid + 256) - krow1 * KCH;
  const int krow2 = (tid + 512) / KCH, kc2 = (tid + 512) - krow2 * KCH;
  const int vd0 = tid >> 3, vc0 = tid & 7, vd1 = vd0 + 32;
#define ATT_GLOAD(KT)                                                                         \
  do {                                                                                        \
    const int key0_ = (KT) * 64;                                                              \
    rk0 = *(const uint4*)(kbase + (size_t)(key0_ + krow0) * kstride + kc0 * 8);               \
    rk1 = *(const uint4*)(kbase + (size_t)(key0_ + krow1) * kstride + kc1 * 8);               \
    if (NKL > 2) rk2 = *(const uint4*)(kbase + (size_t)(key0_ + krow2) * kstride + kc2 * 8);  \
    rv0 = *(const uint4*)(vbase + (size_t)vd0 * 4096 + key0_ + vc0 * 8);                      \
    rv1 = *(const uint4*)(vbase + (size_t)vd1 * 4096 + key0_ + vc0 * 8);                      \
    if (MODE == 2) {                                                                          \
      if (tid < 64) rp = p.pos[tokbase + key0_ + tid];                                        \
      else if (tid < 96) rp = (int)BM[(size_t)(tokbase + qt * 16 + ((tid - 64) >> 1)) * 128 + 2 * (KT) + (tid & 1)]; \
      else if (tid < 98) rp = ((const int*)(p.ws + WS_PMAX))[b * 128 + 2 * (KT) + (tid & 1)]; \
    }                                                                                         \
  } while (0)
#define ATT_SSTORE(BUF)                                                  \
  do {                                                                   \
    *(uint4*)&sK[(BUF)][krow0][kc0 * 8] = rk0;                           \
    *(uint4*)&sK[(BUF)][krow1][kc1 * 8] = rk1;                           \
    if (NKL > 2) *(uint4*)&sK[(BUF)][krow2][kc2 * 8] = rk2;              \
    *(uint4*)&sV[(BUF)][vd0][vc0 * 8] = rv0;                             \
    *(uint4*)&sV[(BUF)][vd1][vc0 * 8] = rv1;                             \
    if (MODE == 2) {                                                     \
      if (tid < 64) sPos[(BUF) * 64 + tid] = rp;                         \
      else if (tid < 98) sWd[(BUF) * 34 + (tid - 64)] = rp;              \
    }                                                                    \
  } while (0)

  ATT_GLOAD(MODE == 0 ? nt64 - 1 : 0);
  ATT_SSTORE(0);
  if (nt64 > 1) ATT_GLOAD(MODE == 0 ? nt64 - 2 : 1);
  __syncthreads();
  for (int step = 0; step < nt64; ++step) {
    const int kt = (MODE == 0) ? (nt64 - 1 - step) : step;
    const int buf = step & 1;
    const bool more = (step + 1 < nt64);
#pragma unroll
    for (int subi = 0; subi < 2; ++subi) {
      const int sub = (MODE == 0) ? (1 - subi) : subi;
      const int ks0 = kt * 64 + sub * 32;
      const bool skip = (MODE == 0) ? (ks0 >= wmax) : (ks0 > wmax);
      if (!skip) {
        uint32_t wd = 0;
        int pmaxk = 0;
        if (MODE == 2) { wd = (uint32_t)sWd[buf * 34 + (wave * 4 + (r >> 3)) * 2 + sub]; pmaxk = sWd[buf * 34 + 32 + sub]; }
        f32x16 s = zero16();
#pragma unroll
        for (int ks = 0; ks < KS; ++ks) {
          bf16x8 a = *(const bf16x8*)&sK[buf][sub * 32 + r][ks * 16 + 8 * h];
          s = MFMA32(a, qf[ks], s);
        }
        float pv[16];
        if (MODE == 0) {
          const bool needmask = (ks0 + 31 >= wmin);
          float e[16];
#pragma unroll
          for (int i = 0; i < 16; ++i) e[i] = frcp(1.f + fexp2(s[i]));
          if (needmask) {
#pragma unroll
            for (int i = 0; i < 16; ++i) e[i] = ((ks0 + crow(i, h)) < tq) ? e[i] : 1.f;
          }
          float tot[4], pr[4], sel[4];
#pragma unroll
          for (int g = 0; g < 4; ++g) tot[g] = (e[4 * g + 3] * e[4 * g + 2]) * (e[4 * g + 1] * e[4 * g]);
#pragma unroll
          for (int g = 0; g < 4; ++g) {
            unsigned uu = __float_as_uint(tot[g]);
            auto rr = __builtin_amdgcn_permlane32_swap(uu, uu, false, false);
            const float r0 = __uint_as_float(rr[0]), r1 = __uint_as_float(rr[1]);
            pr[g] = r0 * r1;
            sel[g] = h ? 1.f : r1;
          }
          float R[4];
          R[3] = carry; R[2] = R[3] * pr[3]; R[1] = R[2] * pr[2]; R[0] = R[1] * pr[1];
          carry = R[0] * pr[0];
#pragma unroll
          for (int g = 0; g < 4; ++g) {
            const float p4 = R[g] * sel[g];
            const float p3 = p4 * e[4 * g + 3];
            const float p2 = p3 * e[4 * g + 2];
            const float p1 = p2 * e[4 * g + 1];
            const float p0 = p1 * e[4 * g];
            pv[4 * g + 3] = p4 - p3; pv[4 * g + 2] = p3 - p2; pv[4 * g + 1] = p2 - p1; pv[4 * g] = p1 - p0;
          }
        } else {
          float u[16];
          if (MODE == 1) {
            const bool needmask = (ks0 + 31 > wmin);
#pragma unroll
            for (int i = 0; i < 16; ++i) u[i] = s[i];
            if (needmask) {
              asm volatile("" ::: "memory");
#pragma unroll
              for (int i = 0; i < 16; ++i) { if ((ks0 + crow(i, h)) > tq) u[i] = -INFINITY; }
            }
          } else if (wposmin - pmaxk >= 113) {
#pragma unroll
            for (int i = 0; i < 16; ++i) u[i] = ((wd >> crow(i, h)) & 1u) ? s[i] : -INFINITY;
          } else {
#pragma unroll
            for (int i = 0; i < 16; ++i) {
              const int kk = crow(i, h);
              const int pk = sPos[buf * 64 + sub * 32 + kk];
              int dist = posq - pk;
              dist = dist < 0 ? 0 : (dist > 127 ? 127 : dist);
              const float bias = sBias[dist * 8 + hdl];
              const float negm = ((wd >> kk) & 1u) ? 0.f : -INFINITY;
              u[i] = (s[i] + bias) + negm;
            }
          }
          if (fastsm) {
            float ls = 0.f;
#pragma unroll
            for (int i = 0; i < 16; ++i) { pv[i] = fexp2(u[i]); ls += pv[i]; }
            lrun += ls;
          } else {
          float mx = u[0];
#pragma unroll
          for (int i = 1; i < 16; ++i) mx = fmaxf(mx, u[i]);
          mx = xmax32(mx);
          const float mnew = fmaxf(mrun, mx);
          const float muse = (mnew == -INFINITY) ? 0.f : mnew;
          const float alpha = fexp2(mrun - muse);
          float ls = 0.f;
#pragma unroll
          for (int i = 0; i < 16; ++i) { pv[i] = fexp2(u[i] - muse); ls += pv[i]; }
          lrun = lrun * alpha + ls;
          mrun = mnew;
          if (__any(alpha != 1.f)) {
#pragma unroll
            for (int i = 0; i < 16; ++i) { o[0][i] *= alpha; o[1][i] *= alpha; }
          }
          }
        }
#pragma unroll
        for (int sidx = 0; sidx < 2; ++sidx) {
          uint4 pk4 = make_uint4(pack2(pv[8 * sidx], pv[8 * sidx + 1]), pack2(pv[8 * sidx + 2], pv[8 * sidx + 3]),
                                 pack2(pv[8 * sidx + 4], pv[8 * sidx + 5]), pack2(pv[8 * sidx + 6], pv[8 * sidx + 7]));
          bf16x8 pf = __builtin_bit_cast(bf16x8, pk4);
#pragma unroll
          for (int dt = 0; dt < 2; ++dt) {
            const u16* vp = &sV[buf][dt * 32 + r][sub * 32 + 16 * sidx + 4 * h];
            uint2 lo = *(const uint2*)vp;
            uint2 hi = *(const uint2*)(vp + 8);
            bf16x8 va = __builtin_bit_cast(bf16x8, make_uint4(lo.x, lo.y, hi.x, hi.y));
            o[dt] = MFMA32(va, pf, o[dt]);
          }
        }
      }
    }
    if (more) ATT_SSTORE(buf ^ 1);
    if (step + 2 < nt64) ATT_GLOAD((MODE == 0) ? kt - 2 : kt + 2);
    if (MODE == 0) {
      const int alive = __any(carry >= 5.42101086e-20f) ? 1 : 0;
      if (!__syncthreads_or(alive)) break;
    } else {
      __syncthreads();
    }
  }
  float inv = 1.f;
  if (MODE != 0) { const float lt = xsum32(lrun); inv = 1.f / lt; }
  const size_t tok = (size_t)(tokbase + tq);
  const u16* zrow = PROJ + tok * LDP + O_ZA + MODE * 512 + hdl * 64;
  u16* yrow = YBR + tok * LDY + MODE * 512 + hdl * 64;
#pragma unroll
  for (int dt = 0; dt < 2; ++dt)
#pragma unroll
    for (int g = 0; g < 4; ++g) {
      const int d4 = dt * 32 + 8 * g + 4 * h;
      uint2 zu = *(const uint2*)(zrow + d4);
      float z0 = bflo(zu.x), z1 = bfhi(zu.x), z2 = bflo(zu.y), z3 = bfhi(zu.y);
      float y0 = o[dt][4 * g] * inv, y1 = o[dt][4 * g + 1] * inv, y2 = o[dt][4 * g + 2] * inv, y3 = o[dt][4 * g + 3] * inv;
      y0 *= z0 * fsigmoid(z0); y1 *= z1 * fsigmoid(z1); y2 *= z2 * fsigmoid(z2); y3 *= z3 * fsigmoid(z3);
      *(uint2*)(yrow + d4) = make_uint2(pack2(y0, y1), pack2(y2, y3));
    }
}

DI void phase_branch(const Params& p, int layer, char* smem, int xcd, int loc, int nloc) {
  const char* wset = p.ws + WS_WT + (size_t)(layer & 1) * SZ_WSET;
  const u16* WBR = (const u16*)(wset + OFF_WT_BR);
  const u16* YBR = (const u16*)(p.ws + WS_YBR);
  const u16* PROJ = (const u16*)(p.ws + WS_PROJ);
  u16* MG = (u16*)(p.ws + WS_MERGED);
  const int tid = opaque_tid(), lane = tid & 63, wave = __builtin_amdgcn_readfirstlane(tid >> 6), r = lane & 31, h = lane >> 5;
  const int wn = wave & 1, wm = wave >> 1;
  for (int i = loc;; i += nloc) {
    int mt, nt;
    if (!tile_order<8>(i, xcd, mt, nt)) break;
    const int m0 = mt * 128, d0 = nt * 128;
    f32x16 sum[2][2];
    sum[0][0] = zero16(); sum[0][1] = zero16(); sum[1][0] = zero16(); sum[1][1] = zero16();
#pragma unroll 1
    for (int n = 0; n < 3; ++n) {
      f32x16 acc[2][2];
      acc[0][0] = zero16(); acc[0][1] = zero16(); acc[1][0] = zero16(); acc[1][1] = zero16();
      gemm128(WBR + ((size_t)n * 1024 + d0) * LDB, LDB, YBR + (size_t)m0 * LDY + n * 512, LDY, 512, acc, smem);
      const float* gb = p.gate_b + ((size_t)layer * 3 + n) * 1024;
#pragma unroll
      for (int mi = 0; mi < 2; ++mi) {
        const int m = m0 + wm * 64 + mi * 32 + r;
#pragma unroll
        for (int ni = 0; ni < 2; ++ni)
#pragma unroll
          for (int g = 0; g < 4; ++g) {
            const int d4 = d0 + wn * 64 + ni * 32 + 8 * g + 4 * h;
            uint2 gu = *(const uint2*)(PROJ + (size_t)m * LDP + O_G + n * 1024 + d4);
            float4 bb = *(const float4*)(gb + d4);
            float g0 = bflo(gu.x) + bb.x, g1 = bfhi(gu.x) + bb.y, g2 = bflo(gu.y) + bb.z, g3 = bfhi(gu.y) + bb.w;
            sum[ni][mi][4 * g] += acc[ni][mi][4 * g] * fsigmoid(g0);
            sum[ni][mi][4 * g + 1] += acc[ni][mi][4 * g + 1] * fsigmoid(g1);
            sum[ni][mi][4 * g + 2] += acc[ni][mi][4 * g + 2] * fsigmoid(g2);
            sum[ni][mi][4 * g + 3] += acc[ni][mi][4 * g + 3] * fsigmoid(g3);
          }
      }
    }
#pragma unroll
    for (int mi = 0; mi < 2; ++mi) {
      const int m = m0 + wm * 64 + mi * 32 + r;
#pragma unroll
      for (int ni = 0; ni < 2; ++ni)
#pragma unroll
        for (int g = 0; g < 4; ++g) {
          const int d4 = d0 + wn * 64 + ni * 32 + 8 * g + 4 * h;
          *(uint2*)(MG + (size_t)m * LDX + d4) = make_uint2(pack2(sum[ni][mi][4 * g], sum[ni][mi][4 * g + 1]), pack2(sum[ni][mi][4 * g + 2], sum[ni][mi][4 * g + 3]));
        }
    }
  }
}

DI void phase_out(const Params& p, int layer, char* smem, int xcd, int loc, int nloc) {
  const char* wset = p.ws + WS_WT + (size_t)(layer & 1) * SZ_WSET;
  const u16* WOUT = (const u16*)(wset + OFF_WT_OUT);
  const u16* MG = (const u16*)(p.ws + WS_MERGED);
  u16* XB = (u16*)(p.ws + WS_XB);
  float* XSS = (float*)(p.ws + WS_XSS);
  const float* xin = (layer == 0) ? p.x : p.out;
  const int tid = opaque_tid(), lane = tid & 63, wave = __builtin_amdgcn_readfirstlane(tid >> 6), r = lane & 31, h = lane >> 5;
  const int wn = wave & 1, wm = wave >> 1;
  for (int i = loc;; i += nloc) {
    int mt, nt;
    if (!tile_order<8>(i, xcd, mt, nt)) break;
    const int m0 = mt * 128, n0 = nt * 128;
    f32x16 acc[2][2];
    acc[0][0] = zero16(); acc[0][1] = zero16(); acc[1][0] = zero16(); acc[1][1] = zero16();
    gemm128(WOUT + (size_t)n0 * LDX, LDX, MG + (size_t)m0 * LDX, LDX, 1024, acc, smem);
#pragma unroll
    for (int mi = 0; mi < 2; ++mi) {
      const int m = m0 + wm * 64 + mi * 32 + r;
      float ss = 0.f;
#pragma unroll
      for (int ni = 0; ni < 2; ++ni)
#pragma unroll
        for (int g = 0; g < 4; ++g) {
          const int n4 = n0 + wn * 64 + ni * 32 + 8 * g + 4 * h;
          float4 xo = *(const float4*)(xin + (size_t)m * 1024 + n4);
          xo.x += acc[ni][mi][4 * g]; xo.y += acc[ni][mi][4 * g + 1]; xo.z += acc[ni][mi][4 * g + 2]; xo.w += acc[ni][mi][4 * g + 3];
          *(float4*)(p.out + (size_t)m * 1024 + n4) = xo;
          *(uint2*)(XB + (size_t)m * LDX + n4) = make_uint2(pack2(xo.x, xo.y), pack2(xo.z, xo.w));
          ss += xo.x * xo.x + xo.y * xo.y + xo.z * xo.z + xo.w * xo.w;
        }
      ss += xor32(ss);
      if (h == 0) XSS[(size_t)m * 16 + nt * 2 + wn] = ss;
    }
  }
}

DI void phase_init(const Params& p) {
  u16* XB = (u16*)(p.ws + WS_XB);
  float* XSS = (float*)(p.ws + WS_XSS);
  const int lane = threadIdx.x & 63;
  const int gw = blockIdx.x * 4 + (threadIdx.x >> 6), nw = gridDim.x * 4;
  for (int row = gw; row < NTOK; row += nw) {
    const float* xr = p.x + (size_t)row * 1024;
    float ss = 0.f;
#pragma unroll
    for (int i = 0; i < 4; ++i) {
      float4 v = *(const float4*)(xr + i * 256 + lane * 4);
      ss += v.x * v.x + v.y * v.y + v.z * v.z + v.w * v.w;
      *(uint2*)(XB + (size_t)row * LDX + i * 256 + lane * 4) = make_uint2(pack2(v.x, v.y), pack2(v.z, v.w));
    }
#pragma unroll
    for (int off = 32; off >= 1; off >>= 1) ss += __shfl_xor(ss, off);
    if (lane < 16) XSS[(size_t)row * 16 + lane] = (lane == 0) ? ss : 0.f;
  }
  if (blockIdx.x == 0 && threadIdx.x < 64) ((int*)(p.ws + WS_CTR))[threadIdx.x] = 0;
}


#ifndef DUP_MASK
#define DUP_MASK 0
#endif
constexpr int SMEM_BYTES = 73728;
constexpr int N_PHASES = 1 + 5 * DEPTH;

__global__ void __launch_bounds__(256, 2) hybrid_megakernel(Params p, int ph_lo, int ph_hi, int do_sync) {
  __shared__ __attribute__((aligned(16))) char smem[SMEM_BYTES];
  __shared__ int s_item;
  __shared__ uint4 xb_words;
  const int tid = threadIdx.x, bid = blockIdx.x, nb = gridDim.x;
  __shared__ int s_xinfo[4];
  if (tid == 0) { xb_words = make_uint4(0u, 0u, 0u, 0u); s_xinfo[3] = 0; }
  __syncthreads();
  XcdBarrier xb = xcd_barrier_post((unsigned*)(p.ws + WS_BAR), (volatile LAS unsigned*)&xb_words);
  if (tid == 0) s_xinfo[1] = (int)xb_add((unsigned*)(p.ws + WS_BAR) + 8 * xb.x, 1u);
  int t_cls = bid & 7, t_loc = bid >> 3, t_step = (nb - (bid & 7) + 7) >> 3;
  for (int ph = ph_lo; ph < ph_hi; ++ph) {
    if (ph == 0) {
      phase_init(p);
      for (int it = bid; it < CV_TOTAL; it += nb) convert_item(p, 0, it, (float*)smem);
    } else {
      const int layer = (ph - 1) / 5, sub = (ph - 1) % 5;
      if (sub == 0) {
        phase_proj(p, layer, smem, t_cls, t_loc, t_step);
        if (DUP_MASK & 1) { __syncthreads(); phase_proj(p, layer, smem, t_cls, t_loc, t_step); }
        if (DUP_MASK & 16) { __syncthreads(); phase_proj_probe(p, layer, smem, t_cls, t_loc, t_step); }
      } else if (sub == 1) {
        const int ncv = (layer + 1 < DEPTH) ? CV_TOTAL : 0;
        const int total = 4096 + 1024 + ncv;
        for (int rep = 0; rep < ((DUP_MASK & 4) ? 2 : 1); ++rep)
        for (int it = bid; it < total; it += nb) {
          if (it < 4096) select_item(p, it, smem);
          else if (it < 5120) prep_item(p, layer, (it - 4096) * 4 + (tid >> 6));
          else convert_item(p, layer + 1, it - 5120, (float*)smem);
        }
      } else if (sub == 2) {
        const bool fast1 = softmax_bound_ok(p, layer, 1), fast2 = softmax_bound_ok(p, layer, 2);
        const bool xq = (s_xinfo[3] == 8);
        int* ctr = (int*)(p.ws + WS_CTR) + (xq ? (16 + layer * 8 + t_cls) : layer);
        const int limit = xq ? 384 : 3072;
        while (true) {
          if (tid == 0) s_item = atomicAdd(ctr, 1);
          __syncthreads();
          const int w = s_item;
          __syncthreads();
          if (w >= limit) break;
          int type, b, hd, d, jt;
          if (xq) {
            const int level = w / 12, within = w - level * 12;
            d = 31 - level;
            type = within >> 2;
            const int pr = 4 * t_cls + (within & 3);
            b = (type == 2) ? (t_cls >> 1) : (pr >> 3);
            hd = pr & 7;
            jt = d * 8 + 2 * (within & 3) + (t_cls & 1);
          } else {
            d = 31 - w / 96;
            const int within = w % 96, idx = within & 31;
            type = within >> 5; b = idx >> 3; hd = idx & 7; jt = d * 8 + (idx & 7);
          }
          if (type == 0) attn_item<0, false>(p, layer, b, hd, d, smem);
          else if (type == 1) { if (fast1) attn_item<1, true>(p, layer, b, hd, d, smem); else attn_item<1, false>(p, layer, b, hd, d, smem); }
          else { if (fast2) attn_item<2, true>(p, layer, b, 0, jt, smem); else attn_item<2, false>(p, layer, b, 0, jt, smem); }
        }
      } else if (sub == 3) {
        phase_branch(p, layer, smem, t_cls, t_loc, t_step);
        if (DUP_MASK & 8) { __syncthreads(); phase_branch(p, layer, smem, t_cls, t_loc, t_step); }
      } else {
        phase_out(p, layer, smem, t_cls, t_loc, t_step);
      }
    }
    if (do_sync == 2) cg::this_grid().sync();
    if (do_sync && ph + 1 < ph_hi) {
      xcd_barrier(xb);
      if (ph == ph_lo) {
        if (tid == 0) {
          unsigned* bar = (unsigned*)(p.ws + WS_BAR);
          int xi = 0;
          for (unsigned j = 0; j < xb.x; ++j) xi += (xb_ld(&bar[XB_XCNT(j)]) > 0u) ? 1 : 0;
          s_xinfo[0] = xi; s_xinfo[2] = (int)xb_words.x; s_xinfo[3] = (int)xb_words.y;
        }
        __syncthreads();
        if (s_xinfo[3] == 8) { t_cls = s_xinfo[0]; t_loc = s_xinfo[1]; t_step = s_xinfo[2]; }
      }
    }
  }
}

#ifndef MK_MULTI
#define MK_MULTI 0
#endif

extern "C" void kernel_launch(void* const* d_in, const int* in_sizes, int n_in, void* d_out, int out_size, void* d_ws,
                              size_t ws_size, hipStream_t stream) {
  (void)in_sizes; (void)n_in; (void)out_size;
  if (ws_size < WS_TOTAL) { fprintf(stderr, "workspace too small: %zu < %zu\n", ws_size, (size_t)WS_TOTAL); return; }
  Params p{};
  p.x = (const float*)d_in[0]; p.pos = (const int*)d_in[1]; p.norm_g = (const float*)d_in[2]; p.w_in = (const float*)d_in[3];
  p.qn_g = (const float*)d_in[4]; p.kvn_g = (const float*)d_in[5]; p.w_uq = (const float*)d_in[6]; p.w_ukv = (const float*)d_in[7];
  p.mla_q_g = (const float*)d_in[8]; p.mla_k_g = (const float*)d_in[9]; p.dsa_q_g = (const float*)d_in[10]; p.dsa_k_g = (const float*)d_in[11];
  p.rel_bias = (const float*)d_in[12]; p.gate_b = (const float*)d_in[13]; p.w_branch = (const float*)d_in[14]; p.w_out = (const float*)d_in[15];
  p.out = (float*)d_out; p.ws = (char*)d_ws;
  static int grid_blocks = 0;
  if (!grid_blocks) {
    int dev = 0, cus = 0, per_cu = 0;
    hipGetDevice(&dev);
    hipDeviceGetAttribute(&cus, hipDeviceAttributeMultiprocessorCount, dev);
    hipOccupancyMaxActiveBlocksPerMultiprocessor(&per_cu, hybrid_megakernel, 256, 0);
    if (per_cu > 2) per_cu = 2;
    grid_blocks = cus * per_cu;
    if (grid_blocks < 8) grid_blocks = 8;
  }
#if MK_MULTI
  for (int ph = 0; ph < N_PHASES; ++ph) {
    hipLaunchKernelGGL(hybrid_megakernel, dim3(grid_blocks), dim3(256), 0, stream, p, ph, ph + 1, 0);
  }
#else
  hipMemsetAsync((char*)d_ws + WS_BAR, 0, 32768, stream);
  int lo = 0, hi = N_PHASES, sy = 1;
  void* args[] = {&p, &lo, &hi, &sy};
  hipError_t e = hipLaunchCooperativeKernel((void*)hybrid_megakernel, dim3(grid_blocks), dim3(256), args, 0, stream);
  if (e != hipSuccess) fprintf(stderr, "cooperative launch failed: %s (grid %d)\n", hipGetErrorString(e), grid_blocks);
#endif
}
```

```cpp
#include <hip/hip_runtime.h>
#include <hip/hip_cooperative_groups.h>
#include <stdint.h>
#include <stdio.h>
namespace cg = cooperative_groups;

typedef unsigned short u16;
typedef __attribute__((ext_vector_type(8))) short bf16x8;
typedef __attribute__((ext_vector_type(16))) float f32x16;
typedef __attribute__((ext_vector_type(2))) float f2_t;
typedef __attribute__((ext_vector_type(2))) __bf16 bf2_t;

#define DI __device__ __forceinline__
#ifndef STAGE_LDS
#define STAGE_LDS 1
#endif
#ifndef BIS1
#define BIS1 0
#endif
#ifndef SEL_NOGUARD
#define SEL_NOGUARD 0
#endif
#define MFMA32(a, b, c) __builtin_amdgcn_mfma_f32_32x32x16_bf16((a), (b), (c), 0, 0, 0)

constexpr int SEQ = 4096, NTOK = 16384, DEPTH = 4;
constexpr int D_IN = 7496, NP = 7552;
constexpr int N_DSV = 2496, N_KPEIXK = 2816;
constexpr int LDP = 6016;
constexpr int LDX = 1088, LDB = 576, LDY = 1600;
constexpr int O_CQ = 0, O_CKV = 256, O_DSQ = 384, O_DSK = 896, O_IXQ = 1024, O_KPE = 1280, O_ZA = 1344, O_G = 2880, O_IXW = 5952;
constexpr float LOG2E = 1.4426950408889634f;
constexpr float C_SB = 0.125f * LOG2E;
constexpr float C_MLA = 0.10206207261596577f * LOG2E;
constexpr float EPS = 1e-6f;

constexpr size_t SZ_WT_IN = (size_t)NP * LDX * 2, SZ_WT_UQ = 768 * 256 * 2, SZ_WT_UKV = 1024 * 128 * 2,
                 SZ_WT_BR = 3 * 1024 * LDB * 2, SZ_WT_OUT = 1024 * LDX * 2;
constexpr size_t OFF_WT_UQ = SZ_WT_IN, OFF_WT_UKV = OFF_WT_UQ + SZ_WT_UQ, OFF_WT_BR = OFF_WT_UKV + SZ_WT_UKV,
                 OFF_WT_OUT = OFF_WT_BR + SZ_WT_BR, SZ_WSET = OFF_WT_OUT + SZ_WT_OUT;
constexpr size_t WS_WT = 0;
constexpr size_t WS_XB = WS_WT + 2 * SZ_WSET;
constexpr size_t WS_XSS = WS_XB + (size_t)NTOK * LDX * 2;
constexpr size_t WS_PROJ = WS_XSS + (size_t)NTOK * 16 * 4;
constexpr size_t WS_QB = WS_PROJ + (size_t)NTOK * LDP * 2;
constexpr size_t WS_KB = WS_QB + (size_t)NTOK * 768 * 2;
constexpr size_t WS_VTA = WS_KB + (size_t)NTOK * 768 * 2;
constexpr size_t WS_VTB = WS_VTA + (size_t)NTOK * 512 * 2;
constexpr size_t WS_VTC = WS_VTB + (size_t)NTOK * 512 * 2;
constexpr size_t WS_YBR = WS_VTC + (size_t)NTOK * 64 * 2;
constexpr size_t WS_BM = WS_YBR + (size_t)NTOK * LDY * 2;
constexpr size_t WS_QA = WS_BM + (size_t)NTOK * 128 * 4;
constexpr size_t WS_KA = WS_QA + (size_t)NTOK * 512 * 2;
constexpr size_t WS_DSQ = WS_KA + (size_t)NTOK * 512 * 2;
constexpr size_t WS_DSK = WS_DSQ + (size_t)NTOK * 512 * 2;
constexpr size_t WS_IXK = WS_DSK + (size_t)NTOK * 64 * 2;
constexpr size_t WS_CTR = WS_IXK + (size_t)NTOK * 32 * 2;
constexpr size_t WS_BAR = WS_CTR + 256;
constexpr size_t WS_PMAX = WS_BAR + 32768;
constexpr size_t WS_TOTAL = WS_PMAX + 4096;
constexpr size_t WS_MERGED = WS_QB;

struct Params {
  const float* x; const int* pos; const float* norm_g; const float* w_in; const float* qn_g; const float* kvn_g;
  const float* w_uq; const float* w_ukv; const float* mla_q_g; const float* mla_k_g; const float* dsa_q_g;
  const float* dsa_k_g; const float* rel_bias; const float* gate_b; const float* w_branch; const float* w_out;
  float* out; char* ws;
};

DI uint32_t pack2(float a, float b) { f2_t v = {a, b}; bf2_t r = __builtin_convertvector(v, bf2_t); return __builtin_bit_cast(uint32_t, r); }
DI float bflo(uint32_t u) { return __uint_as_float(u << 16); }
DI float bfhi(uint32_t u) { return __uint_as_float(u & 0xffff0000u); }
DI float bf1(u16 u) { return __uint_as_float(((uint32_t)u) << 16); }
DI u16 f2bf(float x) { return (u16)(pack2(x, 0.f) & 0xffffu); }
DI float xor32(float v) { return __shfl_xor(v, 32); }
DI float xsum32(float v) { unsigned u = __float_as_uint(v); auto r = __builtin_amdgcn_permlane32_swap(u, u, false, false); return __uint_as_float(r[0]) + __uint_as_float(r[1]); }
DI float xmax32(float v) { unsigned u = __float_as_uint(v); auto r = __builtin_amdgcn_permlane32_swap(u, u, false, false); return fmaxf(__uint_as_float(r[0]), __uint_as_float(r[1])); }
DI int crow(int reg, int h) { return (reg & 3) + 8 * (reg >> 2) + 4 * h; }
DI float fexp2(float x) { return __builtin_amdgcn_exp2f(x); }
DI float frcp(float x) { return __builtin_amdgcn_rcpf(x); }
DI int opaque_tid() { int t = threadIdx.x; asm volatile("" : "+v"(t)); return t; }
DI float fsigmoid(float x) { return frcp(1.f + fexp2(-LOG2E * x)); }
DI f32x16 zero16() { f32x16 z; _Pragma("unroll") for (int i = 0; i < 16; ++i) z[i] = 0.f; return z; }

#define XB_TMO      128
#define XB_XCNT(j)  (256  + 64 * (j))
#define XB_XSUB(j)  (1280 + 64 * (j))
#define XB_XGEN(j)  (2304 + 64 * (j))
#define XB_TOP      3328
#define XB_TOPGEN   3392
#define XCD_BAR_WORDS 3456
#define XB_SPIN_CAP (1u << 22)
#define LAS __attribute__((address_space(3)))
DI unsigned xb_ld(unsigned* p) { return __hip_atomic_load(p, __ATOMIC_RELAXED, __HIP_MEMORY_SCOPE_AGENT); }
DI unsigned xb_add(unsigned* p, unsigned v) { return __hip_atomic_fetch_add(p, v, __ATOMIC_RELAXED, __HIP_MEMORY_SCOPE_AGENT); }
DI unsigned xb_xcc_id() { return (unsigned)__builtin_amdgcn_s_getreg((3 << 11) | 20) & 0xFu; }
#define XB_SPIN(cond, bar) do { unsigned _sp = 0; while (cond) { __builtin_amdgcn_s_sleep(1); \
    if ((++_sp & 255u) == 0u) { if (xb_ld(&(bar)[XB_TMO])) break; if (_sp > XB_SPIN_CAP) { atomicAdd(&(bar)[XB_TMO], 1u); break; } } } } while (0)
struct XcdBarrier { unsigned* bar; unsigned x; volatile LAS unsigned* st; };
DI XcdBarrier xcd_barrier_post(unsigned* bar, volatile LAS unsigned* st) {
  XcdBarrier b; b.bar = bar; b.x = xb_xcc_id(); b.st = st;
  if (threadIdx.x == 0) (void)xb_add(&bar[XB_XCNT(b.x)], 1u);
  return b;
}
DI void xcd_barrier_complete(unsigned* bar, unsigned x, unsigned& nloc, unsigned& nx) {
  const unsigned G = gridDim.x * gridDim.y * gridDim.z;
  unsigned sum, cnt, mine, sp = 0u;
  for (;;) {
    sum = 0u; cnt = 0u; mine = 0u;
#pragma unroll
    for (unsigned j = 0; j < 16; ++j) { const unsigned c = xb_ld(&bar[XB_XCNT(j)]); sum += c; cnt += (c > 0u) ? 1u : 0u; mine = (j == x) ? c : mine; }
    if (sum == G) break;
    __builtin_amdgcn_s_sleep(1);
    if ((++sp & 255u) == 0u) { if (xb_ld(&bar[XB_TMO])) break; if (sp > XB_SPIN_CAP) { atomicAdd(&bar[XB_TMO], 1u); break; } }
  }
  nloc = mine > 0u ? mine : 1u; nx = cnt > 0u ? cnt : 1u;
}
DI void xcd_barrier(const XcdBarrier& b) {
  asm volatile("s_waitcnt vmcnt(0)" ::: "memory");
  __syncthreads();
  if (threadIdx.x == 0) {
    unsigned* bar = b.bar;
    __builtin_amdgcn_s_waitcnt(0);
    unsigned nloc = b.st[0], nx = b.st[1];
    if (nloc == 0u) { xcd_barrier_complete(bar, b.x, nloc, nx); b.st[0] = nloc; b.st[1] = nx; }
    const unsigned old = xb_add(&bar[XB_XSUB(b.x)], 1u);
    const unsigned gen = old / nloc;
    if (old + 1u == (gen + 1u) * nloc) {
      __builtin_amdgcn_fence(__ATOMIC_RELEASE, "agent");
      asm volatile("s_waitcnt vmcnt(0)" ::: "memory");
      const unsigned og = xb_add(&bar[XB_TOP], 1u);
      const unsigned tg = og / nx;
      if (og + 1u == (tg + 1u) * nx) xb_add(&bar[XB_TOPGEN], 1u);
      else XB_SPIN(xb_ld(&bar[XB_TOPGEN]) == tg, bar);
      __builtin_amdgcn_fence(__ATOMIC_ACQUIRE, "agent");
      xb_add(&bar[XB_XGEN(b.x)], 1u);
      asm volatile("s_waitcnt vmcnt(0)" ::: "memory");
    } else {
      XB_SPIN(xb_ld(&bar[XB_XGEN(b.x)]) == gen, bar);
      __builtin_amdgcn_fence(__ATOMIC_ACQUIRE, "agent");
      asm volatile("s_waitcnt vmcnt(0)" ::: "memory");
    }
  }
  __syncthreads();
}

#define XB_RND(j) (3456 + 64 * (j))
DI void class_round_sync(unsigned* bar, int cls, int members) {
  __syncthreads();
  if (threadIdx.x == 0) {
    const unsigned t = xb_add(&bar[XB_RND(cls)], 1u);
    const unsigned target = (t / (unsigned)members + 1u) * (unsigned)members;
    unsigned sp = 0;
    while (xb_ld(&bar[XB_RND(cls)]) < target) { __builtin_amdgcn_s_sleep(1); if (++sp > (1u << 16)) break; }
  }
  __syncthreads();
}

DI int src_col(int n) {
  if (n < 1920) return n;
  if (n < 2816) return n + 32;
  if (n < 2848) return n - 896;
  if (n < 2880) return n;
  if (n < 7488) return n + 8;
  if (n < 7496) return n - 4608;
  return -1;
}
template <bool MAP>
DI void transpose_tile(const float* __restrict__ src, int N, int K, int Nvalid, const float* __restrict__ g,
                       u16* __restrict__ dst, int ldd, int k0, int n0, float* sT) {
  const int tid = opaque_tid();
  const int cg = (tid & 15) * 4, kq = tid >> 4;
  const int sc = MAP ? src_col(n0 + cg) : ((n0 + cg < Nvalid) ? n0 + cg : -1);
#pragma unroll
  for (int i = 0; i < 4; ++i) {
    const int kk = i * 16 + kq;
    float4 v = make_float4(0.f, 0.f, 0.f, 0.f);
    if (sc >= 0) {
      v = *(const float4*)(src + (size_t)(k0 + kk) * N + sc);
      if (g) { const float gg = g[k0 + kk]; v.x *= gg; v.y *= gg; v.z *= gg; v.w *= gg; }
    }
    float* d = sT + kk * 65 + cg;
    d[0] = v.x; d[1] = v.y; d[2] = v.z; d[3] = v.w;
  }
  __syncthreads();
  const int n = tid >> 2, kc = (tid & 3) * 16;
  uint32_t o[8];
#pragma unroll
  for (int j = 0; j < 8; ++j) o[j] = pack2(sT[(kc + 2 * j) * 65 + n], sT[(kc + 2 * j + 1) * 65 + n]);
  uint4* d = (uint4*)(dst + (size_t)(n0 + n) * ldd + k0 + kc);
  d[0] = make_uint4(o[0], o[1], o[2], o[3]);
  d[1] = make_uint4(o[4], o[5], o[6], o[7]);
  __syncthreads();
}

constexpr int CV_IN = 16 * 118, CV_UQ = 4 * 12, CV_UKV = 2 * 16, CV_BR = 3 * 8 * 16, CV_OUT = 16 * 16;
constexpr int CV_TOTAL = CV_IN + CV_UQ + CV_UKV + CV_BR + CV_OUT;

DI void convert_item(const Params& p, int layer, int item, float* sT) {
  char* wset = p.ws + WS_WT + (size_t)(layer & 1) * SZ_WSET;
  if (item < CV_IN) {
    int kt = item & 15, nt = item >> 4;
    transpose_tile<true>(p.w_in + (size_t)layer * 1024 * D_IN, D_IN, 1024, D_IN, p.norm_g + layer * 1024, (u16*)wset, LDX, kt * 64, nt * 64, sT);
    return;
  }
  item -= CV_IN;
  if (item < CV_UQ) {
    int kt = item & 3, nt = item >> 2;
    transpose_tile<false>(p.w_uq + (size_t)layer * 256 * 768, 768, 256, 768, p.qn_g + layer * 256, (u16*)(wset + OFF_WT_UQ), 256, kt * 64, nt * 64, sT);
    return;
  }
  item -= CV_UQ;
  if (item < CV_UKV) {
    int kt = item & 1, nt = item >> 1;
    transpose_tile<false>(p.w_ukv + (size_t)layer * 128 * 1024, 1024, 128, 1024, p.kvn_g + layer * 128, (u16*)(wset + OFF_WT_UKV), 128, kt * 64, nt * 64, sT);
    return;
  }
  item -= CV_UKV;
  if (item < CV_BR) {
    int br = item >> 7, rem = item & 127, kt = rem & 7, nt = rem >> 3;
    transpose_tile<false>(p.w_branch + ((size_t)layer * 3 + br) * 512 * 1024, 1024, 512, 1024, nullptr,
                   (u16*)(wset + OFF_WT_BR) + (size_t)br * 1024 * LDB, LDB, kt * 64, nt * 64, sT);
    return;
  }
  item -= CV_BR;
  {
    int kt = item & 15, nt = item >> 4;
    transpose_tile<false>(p.w_out + (size_t)layer * 1024 * 1024, 1024, 1024, 1024, nullptr, (u16*)(wset + OFF_WT_OUT), LDX, kt * 64, nt * 64, sT);
  }
}

DI void gemm128(const u16* __restrict__ W, int ldw, const u16* __restrict__ X, int ldx, int K, f32x16 (&acc)[2][2], char* smem) {
  typedef u16 (*tile_t)[128][72];
  tile_t sw = (tile_t)smem;
  tile_t sx = (tile_t)(smem + 2 * 128 * 72 * 2);
  const int tid = opaque_tid(), lane = tid & 63, wave = __builtin_amdgcn_readfirstlane(tid >> 6), r = lane & 31, h = lane >> 5;
  const int wn = wave & 1, wm = wave >> 1;
  const int lc = tid & 7, lr = tid >> 3;
  const u16* gw = W + (size_t)lr * ldw + lc * 8;
  const u16* gx = X + (size_t)lr * ldx + lc * 8;
  const u16* gw1 = gw + (size_t)32 * ldw; const u16* gw2 = gw + (size_t)64 * ldw; const u16* gw3 = gw + (size_t)96 * ldw;
  const u16* gx1 = gx + (size_t)32 * ldx; const u16* gx2 = gx + (size_t)64 * ldx; const u16* gx3 = gx + (size_t)96 * ldx;
  uint4 rw0, rw1, rw2, rw3, rx0, rx1, rx2, rx3;
#define G_LOAD(KOFF) do { rw0 = *(const uint4*)(gw + (KOFF)); rw1 = *(const uint4*)(gw1 + (KOFF)); rw2 = *(const uint4*)(gw2 + (KOFF)); rw3 = *(const uint4*)(gw3 + (KOFF)); \
                          rx0 = *(const uint4*)(gx + (KOFF)); rx1 = *(const uint4*)(gx1 + (KOFF)); rx2 = *(const uint4*)(gx2 + (KOFF)); rx3 = *(const uint4*)(gx3 + (KOFF)); } while (0)
#define G_STORE(BUF) do { *(uint4*)&sw[(BUF)][lr][lc * 8] = rw0; *(uint4*)&sw[(BUF)][lr + 32][lc * 8] = rw1; *(uint4*)&sw[(BUF)][lr + 64][lc * 8] = rw2; *(uint4*)&sw[(BUF)][lr + 96][lc * 8] = rw3; \
                          *(uint4*)&sx[(BUF)][lr][lc * 8] = rx0; *(uint4*)&sx[(BUF)][lr + 32][lc * 8] = rx1; *(uint4*)&sx[(BUF)][lr + 64][lc * 8] = rx2; *(uint4*)&sx[(BUF)][lr + 96][lc * 8] = rx3; } while (0)
  G_LOAD(0);
  G_STORE(0);
  const int nk = K >> 6;
  G_LOAD(64);
  __syncthreads();
  for (int kt = 0; kt < nk; ++kt) {
    const int buf = kt & 1;
#pragma unroll
    for (int ks = 0; ks < 4; ++ks) {
      bf16x8 a0 = *(const bf16x8*)&sw[buf][wn * 64 + r][ks * 16 + h * 8];
      bf16x8 a1 = *(const bf16x8*)&sw[buf][wn * 64 + 32 + r][ks * 16 + h * 8];
      bf16x8 b0 = *(const bf16x8*)&sx[buf][wm * 64 + r][ks * 16 + h * 8];
      bf16x8 b1 = *(const bf16x8*)&sx[buf][wm * 64 + 32 + r][ks * 16 + h * 8];
      acc[0][0] = MFMA32(a0, b0, acc[0][0]);
      acc[0][1] = MFMA32(a0, b1, acc[0][1]);
      acc[1][0] = MFMA32(a1, b0, acc[1][0]);
      acc[1][1] = MFMA32(a1, b1, acc[1][1]);
    }
    if (kt + 1 < nk) G_STORE(buf ^ 1);
    if (kt + 2 < nk) G_LOAD((kt + 2) * 64);
    __syncthreads();
  }
#undef G_LOAD
#undef G_STORE
}

template <int NT>
DI bool tile_order(int i, int xcd, int& mt, int& nt) {
  constexpr int PER = 8 * NT;
  if (i >= 2 * PER) return false;
  int mh = i / PER, j = i - mh * PER;
  int ng = j >> 6, w = j & 63;
  mt = xcd * 16 + mh * 8 + (w & 7);
  nt = ng * 8 + (w >> 3);
  return true;
}

DI void phase_proj(const Params& p, int layer, char* smem, int xcd, int loc, int nloc) {
  const u16* WT = (const u16*)(p.ws + WS_WT + (size_t)(layer & 1) * SZ_WSET);
  const u16* XB = (const u16*)(p.ws + WS_XB);
  const float* XSS = (const float*)(p.ws + WS_XSS);
  u16* PROJ = (u16*)(p.ws + WS_PROJ);
  u16* VTA = (u16*)(p.ws + WS_VTA);
  u16* VTC = (u16*)(p.ws + WS_VTC);
  const int tid = opaque_tid(), lane = tid & 63, wave = __builtin_amdgcn_readfirstlane(tid >> 6), r = lane & 31, h = lane >> 5;
  const int wn = wave & 1, wm = wave >> 1;
  for (int i = loc;; i += nloc) {
    int mt, nt;
    if (!tile_order<59>(i, xcd, mt, nt)) break;
    const int m0 = mt * 128, n0 = nt * 128;
    f32x16 acc[2][2];
    acc[0][0] = zero16(); acc[0][1] = zero16(); acc[1][0] = zero16(); acc[1][1] = zero16();
    float rinv2[2];
#pragma unroll
    for (int mi = 0; mi < 2; ++mi) {
      const float4* sp = (const float4*)(XSS + (size_t)(m0 + wm * 64 + mi * 32 + r) * 16);
      float4 q0 = sp[0], q1 = sp[1], q2 = sp[2], q3 = sp[3];
      float ss = ((q0.x + q0.y) + (q0.z + q0.w)) + ((q1.x + q1.y) + (q1.z + q1.w)) + ((q2.x + q2.y) + (q2.z + q2.w)) + ((q3.x + q3.y) + (q3.z + q3.w));
      rinv2[mi] = rsqrtf(ss * (1.f / 1024.f) + EPS);
    }
    gemm128(WT + (size_t)n0 * LDX, LDX, XB + (size_t)m0 * LDX, LDX, 1024, acc, smem);
    {
      const int nb = n0 + wn * 64;
      const int mb = m0 + wm * 64;
      const int b = mb >> 12, s0 = mb & 4095;
      u16 (*st)[72] = (u16 (*)[72])(smem + ((wave & 2) ? 55296 : 18432) + (wave & 1) * 9216);
      const bool transposed = (nb >= 1024 && nb < 1536) || (nb == N_DSV);
      const float cs = (nb < 512) ? C_SB : 1.f;
      u16* dst; size_t rstride;
      if (nb < 512) { dst = (u16*)(p.ws + WS_QA) + ((size_t)(b * 8 + (nb >> 6)) * 4096 + s0) * 64; rstride = 64; }
      else if (nb < 1024) { dst = (u16*)(p.ws + WS_KA) + ((size_t)(b * 8 + ((nb - 512) >> 6)) * 4096 + s0) * 64; rstride = 64; }
      else if (nb < 1536) { dst = VTA + ((size_t)(b * 8 + ((nb - 1024) >> 6)) * 64) * 4096 + s0; rstride = 4096; }
      else if (nb == N_DSV) { dst = VTC + ((size_t)b * 64) * 4096 + s0; rstride = 4096; }
      else { dst = PROJ + (size_t)mb * LDP + (nb - 1536); rstride = LDP; }
#pragma unroll
      for (int mi = 0; mi < 2; ++mi) {
        const int m = mb + mi * 32 + r;
        const float rinv = rinv2[mi] * cs;
#pragma unroll
        for (int ni = 0; ni < 2; ++ni) {
          if (transposed) {
#pragma unroll
            for (int i = 0; i < 16; ++i) {
              if (STAGE_LDS) st[ni * 32 + crow(i, h)][mi * 32 + r] = f2bf(acc[ni][mi][i] * rinv);
              else dst[(size_t)(ni * 32 + crow(i, h)) * rstride + mi * 32 + r] = f2bf(acc[ni][mi][i] * rinv);
            }
          } else {
#pragma unroll
            for (int g = 0; g < 4; ++g) {
              const uint2 v = make_uint2(pack2(acc[ni][mi][4 * g] * rinv, acc[ni][mi][4 * g + 1] * rinv), pack2(acc[ni][mi][4 * g + 2] * rinv, acc[ni][mi][4 * g + 3] * rinv));
              if (STAGE_LDS) *(uint2*)&st[mi * 32 + r][ni * 32 + 8 * g + 4 * h] = v;
              else {
                *(uint2*)(dst + (size_t)(mi * 32 + r) * rstride + ni * 32 + 8 * g + 4 * h) = v;
                if (nb == N_KPEIXK && ni == 1) *(uint2*)((u16*)(p.ws + WS_IXK) + (size_t)m * 32 + 8 * g + 4 * h) = v;
              }
            }
          }
        }
      }
      if (STAGE_LDS) {
        __builtin_amdgcn_wave_barrier();
        asm volatile("s_waitcnt lgkmcnt(0)" ::: "memory");
        const int rr = lane >> 3, cc = lane & 7;
#pragma unroll
        for (int it = 0; it < 8; ++it) {
          const int row = it * 8 + rr;
          uint4 v = *(const uint4*)&st[row][cc * 8];
          *(uint4*)(dst + (size_t)row * rstride + cc * 8) = v;
          if (nb == N_KPEIXK && cc >= 4) *(uint4*)((u16*)(p.ws + WS_IXK) + (size_t)(mb + row) * 32 + (cc - 4) * 8) = v;
        }
      }
    }
  }
}

DI void phase_proj_probe(const Params& p, int layer, char* smem, int xcd, int loc, int nloc) {
  const u16* WT = (const u16*)(p.ws + WS_WT + (size_t)(layer & 1) * SZ_WSET);
  const u16* XB = (const u16*)(p.ws + WS_XB);
  float tot = 0.f;
  for (int i = loc;; i += nloc) {
    int mt, nt;
    if (!tile_order<59>(i, xcd, mt, nt)) break;
    f32x16 acc[2][2];
    acc[0][0] = zero16(); acc[0][1] = zero16(); acc[1][0] = zero16(); acc[1][1] = zero16();
    gemm128(WT, LDX, XB, LDX, 1024, acc, smem);
    tot += acc[0][0][0] + acc[0][1][3] + acc[1][0][5] + acc[1][1][7];
  }
  if (tot == 12345.678f) ((float*)(p.ws + WS_CTR))[32] = tot;
}

DI void prep_item(const Params& p, int layer, int item) {
  const char* wset = p.ws + WS_WT + (size_t)(layer & 1) * SZ_WSET;
  const u16* WUQ = (const u16*)(wset + OFF_WT_UQ);
  const u16* WUKV = (const u16*)(wset + OFF_WT_UKV);
  u16* PROJ = (u16*)(p.ws + WS_PROJ);
  u16* QB = (u16*)(p.ws + WS_QB);
  u16* KB = (u16*)(p.ws + WS_KB);
  u16* VTB = (u16*)(p.ws + WS_VTB);
  const int lane = opaque_tid() & 63, r = lane & 31, h = lane >> 5;
  const int tg = item >> 3, hd = item & 7;
  const int token = tg * 32 + r, b = token >> 12, s = token & 4095;
  u16* prow = PROJ + (size_t)token * LDP;

  const float posf = (float)p.pos[token];
  float cs[8], sn[8];
  {
    const float IF0[8] = {1.0f, 0.5623413251903491f, 0.31622776601683794f, 0.1778279410038923f, 0.01f, 0.005623413251903491f, 0.0031622776601683794f, 0.0017782794100389228f};
    const float IF1[8] = {0.1f, 0.05623413251903491f, 0.03162277660168379f, 0.01778279410038923f, 0.001f, 0.0005623413251903491f, 0.00031622776601683794f, 0.00017782794100389227f};
#pragma unroll
    for (int reg = 0; reg < 8; ++reg) {
      const float inv = h ? IF1[reg] : IF0[reg];
      const float ang = posf * inv;
      double rv = (double)ang * 0.15915494309189535;
      rv -= rint(rv);
      const float fr = (float)rv;
      sn[reg] = __builtin_amdgcn_sinf(fr);
      cs[reg] = __builtin_amdgcn_cosf(fr);
    }
  }

  {
    bf16x8 bq[16];
    float ss = 0.f;
#pragma unroll
    for (int ks = 0; ks < 16; ++ks) {
      uint4 u = *(const uint4*)(prow + O_CQ + ks * 16 + 8 * h);
      bq[ks] = __builtin_bit_cast(bf16x8, u);
      float f;
      f = bflo(u.x); ss += f * f; f = bfhi(u.x); ss += f * f; f = bflo(u.y); ss += f * f; f = bfhi(u.y); ss += f * f;
      f = bflo(u.z); ss += f * f; f = bfhi(u.z); ss += f * f; f = bflo(u.w); ss += f * f; f = bfhi(u.w); ss += f * f;
    }
    ss += xor32(ss);
    const float rq = rsqrtf(ss * (1.f / 256.f) + EPS);
    f32x16 acc[3];
    acc[0] = zero16(); acc[1] = zero16(); acc[2] = zero16();
    const u16* wq = WUQ + (size_t)(hd * 96 + r) * 256 + 8 * h;
#pragma unroll
    for (int ks = 0; ks < 16; ++ks) {
#pragma unroll
      for (int nt = 0; nt < 3; ++nt) {
        bf16x8 a = *(const bf16x8*)(wq + (size_t)nt * 32 * 256 + ks * 16);
        acc[nt] = MFMA32(a, bq[ks], acc[nt]);
      }
    }
    float ss2 = 0.f;
#pragma unroll
    for (int nt = 0; nt < 3; ++nt)
#pragma unroll
      for (int i = 0; i < 16; ++i) { acc[nt][i] *= rq; ss2 += acc[nt][i] * acc[nt][i]; }
    ss2 += xor32(ss2);
    const float r2 = rsqrtf(ss2 * (1.f / 96.f) + EPS);
    const float* gq = p.mla_q_g + layer * 96;
#pragma unroll
    for (int nt = 0; nt < 3; ++nt)
#pragma unroll
      for (int g = 0; g < 4; ++g) {
        float4 gg = *(const float4*)(gq + nt * 32 + 8 * g + 4 * h);
        acc[nt][4 * g] *= r2 * gg.x; acc[nt][4 * g + 1] *= r2 * gg.y; acc[nt][4 * g + 2] *= r2 * gg.z; acc[nt][4 * g + 3] *= r2 * gg.w;
      }
#pragma unroll
    for (int reg = 0; reg < 8; ++reg) {
      float x1 = acc[2][reg], x2 = acc[2][reg + 8];
      acc[2][reg] = x1 * cs[reg] - x2 * sn[reg];
      acc[2][reg + 8] = x2 * cs[reg] + x1 * sn[reg];
    }
    u16* qo = QB + ((size_t)(b * 8 + hd) * 4096 + s) * 96;
#pragma unroll
    for (int nt = 0; nt < 3; ++nt)
#pragma unroll
      for (int g = 0; g < 4; ++g)
        *(uint2*)(qo + nt * 32 + 8 * g + 4 * h) = make_uint2(pack2(acc[nt][4 * g] * C_MLA, acc[nt][4 * g + 1] * C_MLA), pack2(acc[nt][4 * g + 2] * C_MLA, acc[nt][4 * g + 3] * C_MLA));
  }
  {
    bf16x8 bk[8];
    float ss = 0.f;
#pragma unroll
    for (int ks = 0; ks < 8; ++ks) {
      uint4 u = *(const uint4*)(prow + O_CKV + ks * 16 + 8 * h);
      bk[ks] = __builtin_bit_cast(bf16x8, u);
      float f;
      f = bflo(u.x); ss += f * f; f = bfhi(u.x); ss += f * f; f = bflo(u.y); ss += f * f; f = bfhi(u.y); ss += f * f;
      f = bflo(u.z); ss += f * f; f = bfhi(u.z); ss += f * f; f = bflo(u.w); ss += f * f; f = bfhi(u.w); ss += f * f;
    }
    ss += xor32(ss);
    const float rkv = rsqrtf(ss * (1.f / 128.f) + EPS);
    f32x16 acc[4];
    acc[0] = zero16(); acc[1] = zero16(); acc[2] = zero16(); acc[3] = zero16();
    const u16* wk = WUKV + (size_t)(hd * 128 + r) * 128 + 8 * h;
#pragma unroll
    for (int ks = 0; ks < 8; ++ks) {
#pragma unroll
      for (int nt = 0; nt < 4; ++nt) {
        bf16x8 a = *(const bf16x8*)(wk + (size_t)nt * 32 * 128 + ks * 16);
        acc[nt] = MFMA32(a, bk[ks], acc[nt]);
      }
    }
    float kpe[16];
#pragma unroll
    for (int g = 0; g < 4; ++g) {
      uint2 u = *(const uint2*)(prow + O_KPE + 8 * g + 4 * h);
      kpe[4 * g] = bflo(u.x); kpe[4 * g + 1] = bfhi(u.x); kpe[4 * g + 2] = bflo(u.y); kpe[4 * g + 3] = bfhi(u.y);
    }
    float ss2 = 0.f;
#pragma unroll
    for (int nt = 0; nt < 4; ++nt)
#pragma unroll
      for (int i = 0; i < 16; ++i) acc[nt][i] *= rkv;
#pragma unroll
    for (int i = 0; i < 16; ++i) ss2 += acc[0][i] * acc[0][i] + acc[1][i] * acc[1][i] + kpe[i] * kpe[i];
    ss2 += xor32(ss2);
    const float r2 = rsqrtf(ss2 * (1.f / 96.f) + EPS);
    const float* gk = p.mla_k_g + layer * 96;
#pragma unroll
    for (int g = 0; g < 4; ++g) {
      float4 g0 = *(const float4*)(gk + 8 * g + 4 * h);
      float4 g1 = *(const float4*)(gk + 32 + 8 * g + 4 * h);
      float4 g2 = *(const float4*)(gk + 64 + 8 * g + 4 * h);
      acc[0][4 * g] *= r2 * g0.x; acc[0][4 * g + 1] *= r2 * g0.y; acc[0][4 * g + 2] *= r2 * g0.z; acc[0][4 * g + 3] *= r2 * g0.w;
      acc[1][4 * g] *= r2 * g1.x; acc[1][4 * g + 1] *= r2 * g1.y; acc[1][4 * g + 2] *= r2 * g1.z; acc[1][4 * g + 3] *= r2 * g1.w;
      kpe[4 * g] *= r2 * g2.x; kpe[4 * g + 1] *= r2 * g2.y; kpe[4 * g + 2] *= r2 * g2.z; kpe[4 * g + 3] *= r2 * g2.w;
    }
#pragma unroll
    for (int reg = 0; reg < 8; ++reg) {
      float x1 = kpe[reg], x2 = kpe[reg + 8];
      kpe[reg] = x1 * cs[reg] - x2 * sn[reg];
      kpe[reg + 8] = x2 * cs[reg] + x1 * sn[reg];
    }
    u16* ko = KB + ((size_t)(b * 8 + hd) * 4096 + s) * 96;
#pragma unroll
    for (int g = 0; g < 4; ++g) {
      *(uint2*)(ko + 8 * g + 4 * h) = make_uint2(pack2(acc[0][4 * g], acc[0][4 * g + 1]), pack2(acc[0][4 * g + 2], acc[0][4 * g + 3]));
      *(uint2*)(ko + 32 + 8 * g + 4 * h) = make_uint2(pack2(acc[1][4 * g], acc[1][4 * g + 1]), pack2(acc[1][4 * g + 2], acc[1][4 * g + 3]));
      *(uint2*)(ko + 64 + 8 * g + 4 * h) = make_uint2(pack2(kpe[4 * g], kpe[4 * g + 1]), pack2(kpe[4 * g + 2], kpe[4 * g + 3]));
    }
#pragma unroll
    for (int nt = 2; nt < 4; ++nt)
#pragma unroll
      for (int i = 0; i < 16; ++i) {
        const int d = (nt - 2) * 32 + crow(i, h);
        VTB[((size_t)((b * 8 + hd) * 64 + d)) * 4096 + s] = f2bf(acc[nt][i]);
      }
  }
  {
    const u16* qp = prow + O_DSQ + hd * 64 + 32 * h;
    u16* qo = (u16*)(p.ws + WS_DSQ) + ((size_t)token * 8 + hd) * 64 + 32 * h;
    uint4 u[4];
    float f[32];
    float ss = 0.f;
#pragma unroll
    for (int i = 0; i < 4; ++i) {
      u[i] = *(const uint4*)(qp + 8 * i);
      f[8 * i] = bflo(u[i].x); f[8 * i + 1] = bfhi(u[i].x); f[8 * i + 2] = bflo(u[i].y); f[8 * i + 3] = bfhi(u[i].y);
      f[8 * i + 4] = bflo(u[i].z); f[8 * i + 5] = bfhi(u[i].z); f[8 * i + 6] = bflo(u[i].w); f[8 * i + 7] = bfhi(u[i].w);
    }
#pragma unroll
    for (int i = 0; i < 32; ++i) ss += f[i] * f[i];
    ss += xor32(ss);
    const float rr = rsqrtf(ss * (1.f / 64.f) + EPS) * C_SB;
    const float* gq = p.dsa_q_g + layer * 64 + 32 * h;
#pragma unroll
    for (int i = 0; i < 4; ++i) {
      float4 ga = *(const float4*)(gq + 8 * i), gb = *(const float4*)(gq + 8 * i + 4);
      *(uint4*)(qo + 8 * i) = make_uint4(pack2(f[8 * i] * rr * ga.x, f[8 * i + 1] * rr * ga.y), pack2(f[8 * i + 2] * rr * ga.z, f[8 * i + 3] * rr * ga.w),
                                         pack2(f[8 * i + 4] * rr * gb.x, f[8 * i + 5] * rr * gb.y), pack2(f[8 * i + 6] * rr * gb.z, f[8 * i + 7] * rr * gb.w));
    }
  }
  if (hd == 1) {
    int pm = p.pos[token];
#pragma unroll
    for (int off = 1; off < 32; off <<= 1) { const int o = __shfl_xor(pm, off); pm = pm > o ? pm : o; }
    if (lane == 0) ((int*)(p.ws + WS_PMAX))[tg] = pm;
  }
  if (hd == 0) {
    const u16* kp = prow + O_DSK + 32 * h;
    u16* ko2 = (u16*)(p.ws + WS_DSK) + (size_t)token * 64 + 32 * h;
    float f[32];
    float ss = 0.f;
#pragma unroll
    for (int i = 0; i < 4; ++i) {
      uint4 u = *(const uint4*)(kp + 8 * i);
      f[8 * i] = bflo(u.x); f[8 * i + 1] = bfhi(u.x); f[8 * i + 2] = bflo(u.y); f[8 * i + 3] = bfhi(u.y);
      f[8 * i + 4] = bflo(u.z); f[8 * i + 5] = bfhi(u.z); f[8 * i + 6] = bflo(u.w); f[8 * i + 7] = bfhi(u.w);
    }
#pragma unroll
    for (int i = 0; i < 32; ++i) ss += f[i] * f[i];
    ss += xor32(ss);
    const float rr = rsqrtf(ss * (1.f / 64.f) + EPS);
    const float* gk = p.dsa_k_g + layer * 64 + 32 * h;
#pragma unroll
    for (int i = 0; i < 4; ++i) {
      float4 ga = *(const float4*)(gk + 8 * i), gb = *(const float4*)(gk + 8 * i + 4);
      *(uint4*)(ko2 + 8 * i) = make_uint4(pack2(f[8 * i] * rr * ga.x, f[8 * i + 1] * rr * ga.y), pack2(f[8 * i + 2] * rr * ga.z, f[8 * i + 3] * rr * ga.w),
                                         pack2(f[8 * i + 4] * rr * gb.x, f[8 * i + 5] * rr * gb.y), pack2(f[8 * i + 6] * rr * gb.z, f[8 * i + 7] * rr * gb.w));
    }
  }
}

struct SelSmem { uint32_t hist[2][4096]; uint32_t pfx[4]; uint32_t need[4]; uint32_t dcut[4]; uint32_t flag; };

template <int PASS>
DI void sel_pass(SelSmem* S, const uint32_t (&sk)[32][2], int ntiles, uint32_t (&pf)[2]) {
  const int tid = opaque_tid(), lane = tid & 63, wave = __builtin_amdgcn_readfirstlane(tid >> 6), r = lane & 31, h = lane >> 5;
  {
    uint4* hz = (uint4*)&S->hist[0][0];
#pragma unroll
    for (int i = 0; i < 8; ++i) hz[tid + 256 * i] = make_uint4(0, 0, 0, 0);
  }
  __syncthreads();
#pragma unroll
  for (int i = 0; i < 32; ++i) {
    const int tile = i * 4 + wave;
    if (tile < ntiles) {
#pragma unroll
      for (int j = 0; j < 2; ++j) {
        const uint32_t k = sk[i][j];
        bool match; uint32_t digit;
        if (PASS == 0) { match = (k != 0u); digit = k >> 20; }
        else if (PASS == 1) { match = ((k >> 20) == pf[j]); digit = (k >> 10) & 1023u; }
        else if (PASS == 2) { match = ((k >> 10) == pf[j]); digit = k & 1023u; }
        else { match = (k == pf[j]); digit = 4095u - (uint32_t)(tile * 32 + r); }
        if (match) atomicAdd(&S->hist[h][digit], j ? 0x10000u : 1u);
      }
    }
  }
  __syncthreads();
  {
    constexpr int PER = (PASS == 0 || PASS == 3) ? 64 : 16;
    const int pair = wave >> 1, sh = (wave & 1) * 16;
    const uint32_t need = S->need[wave];
    const uint32_t prevp = S->pfx[wave];
    const uint32_t* hp = &S->hist[pair][lane * PER];
    uint32_t tot = 0;
    for (int c = 0; c < PER; ++c) tot += (hp[(c + lane) & (PER - 1)] >> sh) & 0xffffu;
    uint32_t incl = tot;
#pragma unroll
    for (int off = 1; off < 64; off <<= 1) {
      uint32_t v = __shfl_down(incl, off);
      if (lane + off < 64) incl += v;
    }
    const uint32_t sfx = incl - tot;
    const bool cross = (sfx < need) && (need <= sfx + tot);
    const unsigned long long cm = __ballot(cross);
    if (cm != 0ull) {
      const int L = __builtin_ctzll(cm);
      const uint32_t cumbase = (uint32_t)__shfl((int)sfx, L);
      const uint32_t cnt = (lane < PER) ? ((S->hist[pair][L * PER + lane] >> sh) & 0xffffu) : 0u;
      uint32_t inc2 = cnt;
#pragma unroll
      for (int off = 1; off < PER; off <<= 1) {
        uint32_t v = __shfl_down(inc2, off);
        if (lane + off < 64) inc2 += v;
      }
      const uint32_t cum = cumbase + (inc2 - cnt);
      if (lane < PER && cum < need && need <= cum + cnt) {
        const uint32_t bin = (uint32_t)(L * PER + lane);
        const uint32_t nn = need - cum;
        if (PASS == 0) S->pfx[wave] = bin;
        else if (PASS == 1 || PASS == 2) S->pfx[wave] = (prevp << 10) | bin;
        else S->dcut[wave] = bin;
        if (PASS == 2 && cnt != nn) atomicOr(&S->flag, 1u);
        if (PASS == 1 && cnt != nn) atomicOr(&S->flag, 2u);
        S->need[wave] = nn;
      }
    }
  }
  __syncthreads();
  if (PASS < 3) { pf[0] = S->pfx[2 * h]; pf[1] = S->pfx[2 * h + 1]; }
}

DI void select_item(const Params& p, int item, char* smem) {
  SelSmem* S = (SelSmem*)smem;
  const u16* PROJ = (const u16*)(p.ws + WS_PROJ);
  uint32_t* BM = (uint32_t*)(p.ws + WS_BM);
  const int b = item & 3, t0 = (1023 - (item >> 2)) * 4;
  const int tokbase = b * 4096;
  const int tid = opaque_tid(), lane = tid & 63, wave = __builtin_amdgcn_readfirstlane(tid >> 6), r = lane & 31, h = lane >> 5;
  if (t0 + 3 < 256) {
    if (tid < 32) {
      const int q = tid >> 3, tile = tid & 7, t = t0 + q;
      uint32_t wd = (tile < (t >> 5)) ? 0xffffffffu : (tile == (t >> 5) ? (0xffffffffu >> (31 - (t & 31))) : 0u);
      BM[(size_t)(tokbase + t) * 128 + tile] = wd;
    }
    return;
  }
  const int ntiles = 2 * (t0 >> 6) + 2;
  if (tid < 4) { S->need[tid] = 256u; S->pfx[tid] = 0u; S->dcut[tid] = 0u; }
  if (tid == 4) S->flag = 0u;
  bf16x8 a0, a1;
  {
    const int hb = (r >> 2) & 1, idx16 = (r & 3) + 4 * (r >> 3);
    const int q = 2 * hb + (idx16 >> 3), head = idx16 & 7;
    const u16* aq = PROJ + (size_t)(tokbase + t0 + q) * LDP + O_IXQ + head * 32 + 8 * h;
    a0 = *(const bf16x8*)aq;
    a1 = *(const bf16x8*)(aq + 16);
  }
  float wv[16];
#pragma unroll
  for (int j = 0; j < 2; ++j) {
    uint4 u = *(const uint4*)(PROJ + (size_t)(tokbase + t0 + 2 * h + j) * LDP + O_IXW);
    const float c = 0.35355339059327373f * 0.17677669529663687f;
    wv[8 * j] = bflo(u.x) * c; wv[8 * j + 1] = bfhi(u.x) * c; wv[8 * j + 2] = bflo(u.y) * c; wv[8 * j + 3] = bfhi(u.y) * c;
    wv[8 * j + 4] = bflo(u.z) * c; wv[8 * j + 5] = bfhi(u.z) * c; wv[8 * j + 6] = bflo(u.w) * c; wv[8 * j + 7] = bfhi(u.w) * c;
  }
  const u16* IXK = (const u16*)(p.ws + WS_IXK) + (size_t)tokbase * 32;
  uint32_t sk[32][2];
  bf16x8 ka0[4], ka1[4], kb0[4], kb1[4];
#define SEL_LOAD(S0, S1, CC)                                                          \
  _Pragma("unroll") for (int ii = 0; ii < 4; ++ii) {                                   \
    const int key_ = ((((CC) * 4 + ii) * 4 + wave) * 32) + r;                          \
    const u16* kp_ = BIS1 ? (PROJ + (size_t)(tokbase + key_) * LDP + O_KPE + 32 + 8 * h) : (IXK + (size_t)key_ * 32 + 8 * h); \
    S0[ii] = *(const bf16x8*)kp_; S1[ii] = *(const bf16x8*)(kp_ + 16);                 \
  }
#define SEL_COMP(S0, S1, CC)                                                          \
  _Pragma("unroll") for (int ii = 0; ii < 4; ++ii) {                                   \
    const int i_ = (CC) * 4 + ii;                                                      \
    const int key_ = (i_ * 4 + wave) * 32 + r;                                         \
    f32x16 acc_ = zero16();                                                            \
    acc_ = MFMA32(a0, S0[ii], acc_);                                                   \
    acc_ = MFMA32(a1, S1[ii], acc_);                                                   \
    _Pragma("unroll") for (int j = 0; j < 2; ++j) {                                    \
      float sc_ = 0.f;                                                                 \
      _Pragma("unroll") for (int hd = 0; hd < 8; ++hd) sc_ = fmaf(wv[8 * j + hd], fmaxf(acc_[8 * j + hd], 0.f), sc_); \
      sc_ += 0.0f;                                                                     \
      const uint32_t bits_ = __float_as_uint(sc_);                                     \
      const uint32_t k32_ = bits_ ^ (((uint32_t)((int32_t)bits_ >> 31)) | 0x80000000u); \
      sk[i_][j] = (key_ <= t0 + 2 * h + j) ? k32_ : 0u;                                \
    }                                                                                  \
  }
#define SEL_ZERO(CC) _Pragma("unroll") for (int ii = 0; ii < 4; ++ii) { sk[(CC) * 4 + ii][0] = 0u; sk[(CC) * 4 + ii][1] = 0u; }
  if (wave < ntiles) { SEL_LOAD(ka0, ka1, 0) }
#pragma unroll
  for (int cc = 0; cc < 8; cc += 2) {
    if (16 * (cc + 1) + wave < ntiles) { SEL_LOAD(kb0, kb1, cc + 1) }
    if (16 * cc + wave < ntiles) { SEL_COMP(ka0, ka1, cc) } else { SEL_ZERO(cc) }
    if (cc + 2 < 8) { if (16 * (cc + 2) + wave < ntiles) { SEL_LOAD(ka0, ka1, cc + 2) } }
    if (16 * (cc + 1) + wave < ntiles) { SEL_COMP(kb0, kb1, cc + 1) } else { SEL_ZERO(cc + 1) }
  }
#undef SEL_LOAD
#undef SEL_COMP
#undef SEL_ZERO
  uint32_t pf[2] = {0u, 0u};
  sel_pass<0>(S, sk, ntiles, pf);
  sel_pass<1>(S, sk, ntiles, pf);
  if (S->flag & 2u) sel_pass<2>(S, sk, ntiles, pf);
  else { pf[0] <<= 10; pf[1] <<= 10; }
  uint32_t dc[2] = {0u, 0u};
  if (S->flag & 1u) {
    sel_pass<3>(S, sk, ntiles, pf);
    dc[0] = S->dcut[2 * h]; dc[1] = S->dcut[2 * h + 1];
  }
#pragma unroll
  for (int i = 0; i < 32; ++i) {
    const int tile = i * 4 + wave;
    if (tile < ntiles) {
      const uint32_t di = 4095u - (uint32_t)(tile * 32 + r);
#pragma unroll
      for (int j = 0; j < 2; ++j) {
        const uint32_t k = sk[i][j];
        const bool sel = (k > pf[j]) || (k == pf[j] && di >= dc[j]);
        const unsigned long long m = __ballot(sel);
        if (lane == 0) {
          BM[(size_t)(tokbase + t0 + j) * 128 + tile] = (uint32_t)m;
          BM[(size_t)(tokbase + t0 + 2 + j) * 128 + tile] = (uint32_t)(m >> 32);
        }
      }
    }
  }
  __syncthreads();
}

DI bool softmax_bound_ok(const Params& p, int layer, int mode) {
  const int lane = threadIdx.x & 63;
  const float* gq = (mode == 1) ? (p.mla_q_g + layer * 96) : (p.dsa_q_g + layer * 64);
  const float* gk = (mode == 1) ? (p.mla_k_g + layer * 96) : (p.dsa_k_g + layer * 64);
  const int ng = (mode == 1) ? 96 : 64;
  float aq = 0.f, ak = 0.f, ab = 0.f;
  for (int i = lane; i < ng; i += 64) { aq = fmaxf(aq, fabsf(gq[i])); ak = fmaxf(ak, fabsf(gk[i])); }
  if (mode == 2) { for (int i = lane; i < 256; i += 64) ab = fmaxf(ab, fabsf(p.rel_bias[i])); }
#pragma unroll
  for (int off = 1; off < 64; off <<= 1) { aq = fmaxf(aq, __shfl_xor(aq, off)); ak = fmaxf(ak, __shfl_xor(ak, off)); ab = fmaxf(ab, __shfl_xor(ab, off)); }
  const float bound = ((mode == 1) ? 9.7979590f * aq * ak : 8.f * aq * ak + 2.f * ab) * LOG2E * 1.02f;
  return __builtin_amdgcn_readfirstlane((bound < 100.f) ? 1 : 0) != 0;
}

template <int MODE, bool FAST>
DI void attn_item(const Params& p, int layer, int b, int hd, int qt, char* smem) {
  constexpr int DK = (MODE == 1) ? 96 : 64;
  constexpr int KS = DK / 16;
  constexpr int KROW = DK + 8;
  constexpr int KCH = DK / 8;
  constexpr int NKL = (64 * KCH) / 256;
  typedef u16 (*kt_t)[64][KROW];
  typedef u16 (*vt_t)[64][72];
  kt_t sK = (kt_t)smem;
  vt_t sV = (vt_t)(smem + 2 * 64 * KROW * 2);
  int* sPos = (int*)(smem + 2 * 64 * KROW * 2 + 2 * 64 * 72 * 2);
  float* sBias = (float*)(smem + 2 * 64 * KROW * 2 + 2 * 64 * 72 * 2 + 512);
  int* sWd = (int*)(smem + 2 * 64 * KROW * 2 + 2 * 64 * 72 * 2 + 512 + 4096);

  const u16* PROJ = (const u16*)(p.ws + WS_PROJ);
  u16* YBR = (u16*)(p.ws + WS_YBR);
  const uint32_t* BM = (const uint32_t*)(p.ws + WS_BM);
  const int tid = opaque_tid(), lane = tid & 63, wave = __builtin_amdgcn_readfirstlane(tid >> 6), r = lane & 31, h = lane >> 5;
  const int tokbase = b * 4096;

  int tq, hdl, wmin, wmax, nt64;
  const u16* qrow;
  const u16* kbase; size_t kstride;
  const u16* vbase;
  if (MODE == 0) {
    tq = qt * 128 + wave * 32 + r; hdl = hd; wmin = qt * 128 + wave * 32; wmax = wmin + 31; nt64 = 2 * qt + 2;
    qrow = (const u16*)(p.ws + WS_QA) + ((size_t)(b * 8 + hd) * 4096 + tq) * 64;
    kbase = (const u16*)(p.ws + WS_KA) + ((size_t)(b * 8 + hd) * 4096) * 64; kstride = 64;
    vbase = (const u16*)(p.ws + WS_VTA) + (size_t)((b * 8 + hd) * 64) * 4096;
  } else if (MODE == 1) {
    tq = qt * 128 + wave * 32 + r; hdl = hd; wmin = qt * 128 + wave * 32; wmax = wmin + 31; nt64 = 2 * qt + 2;
    qrow = (const u16*)(p.ws + WS_QB) + ((size_t)(b * 8 + hd) * 4096 + tq) * 96;
    kbase = (const u16*)(p.ws + WS_KB) + ((size_t)(b * 8 + hd) * 4096) * 96; kstride = 96;
    vbase = (const u16*)(p.ws + WS_VTB) + (size_t)((b * 8 + hd) * 64) * 4096;
  } else {
    tq = qt * 16 + wave * 4 + (r >> 3); hdl = r & 7; wmin = qt * 16 + wave * 4; wmax = wmin + 3; nt64 = (qt >> 2) + 1;
    qrow = (const u16*)(p.ws + WS_DSQ) + ((size_t)(tokbase + tq) * 8 + hdl) * 64;
    kbase = (const u16*)(p.ws + WS_DSK) + (size_t)tokbase * 64; kstride = 64;
    vbase = (const u16*)(p.ws + WS_VTC) + (size_t)(b * 64) * 4096;
  }
  int posq = 0, wposmin = 0;
  if (MODE == 2) {
    posq = p.pos[tokbase + tq];
    wposmin = posq;
#pragma unroll
    for (int off = 1; off < 64; off <<= 1) { const int o = __shfl_xor(wposmin, off); wposmin = wposmin < o ? wposmin : o; }
    wposmin = __builtin_amdgcn_readfirstlane(wposmin);
    for (int e = tid; e < 1024; e += 256) {
      const int n = e >> 3, hh = e & 7;
      int bk = n;
      if (n >= 16) {
        bk = 16 + (n >= 19) + (n >= 21) + (n >= 24) + (n >= 27) + (n >= 31) + (n >= 35) + (n >= 40) + (n >= 46) + (n >= 52) + (n >= 59) + (n >= 67) + (n >= 77) + (n >= 87) + (n >= 99) + (n >= 113);
      }
      sBias[e] = (p.rel_bias[bk * 8 + hh] - p.rel_bias[31 * 8 + hh]) * LOG2E;
    }
  }
  constexpr bool fastsm = FAST;
  bf16x8 qf[KS];
#pragma unroll
  for (int ks = 0; ks < KS; ++ks) qf[ks] = *(const bf16x8*)(qrow + ks * 16 + 8 * h);

  f32x16 o[2];
  o[0] = zero16(); o[1] = zero16();
  float carry = 1.f;
  float mrun = -INFINITY, lrun = 0.f;

  uint4 rk0, rk1, rk2 = make_uint4(0, 0, 0, 0), rv0, rv1;
  int rp = 0;
  const int krow0 = tid / KCH, kc0 = tid - krow0 * KCH;
  const int krow1 = (tid + 256) / KCH, kc1 = (tid + 256) - krow1 * KCH;
  const int krow2 = (tid + 512) / KCH, kc2 = (tid + 512) - krow2 * KCH;
  const int vd0 = tid >> 3, vc0 = tid & 7, vd1 = vd0 + 32;
#define ATT_GLOAD(KT)                                                                         \
  do {                                                                                        \
    const int key0_ = (KT) * 64;                                                              \
    rk0 = *(const uint4*)(kbase + (size_t)(key0_ + krow0) * kstride + kc0 * 8);               \
    rk1 = *(const uint4*)(kbase + (size_t)(key0_ + krow1) * kstride + kc1 * 8);               \
    if (NKL > 2) rk2 = *(const uint4*)(kbase + (size_t)(key0_ + krow2) * kstride + kc2 * 8);  \
    rv0 = *(const uint4*)(vbase + (size_t)vd0 * 4096 + key0_ + vc0 * 8);                      \
    rv1 = *(const uint4*)(vbase + (size_t)vd1 * 4096 + key0_ + vc0 * 8);                      \
    if (MODE == 2) {                                                                          \
      if (tid < 64) rp = p.pos[tokbase + key0_ + tid];                                        \
      else if (tid < 96) rp = (int)BM[(size_t)(tokbase + qt * 16 + ((tid - 64) >> 1)) * 128 + 2 * (KT) + (tid & 1)]; \
      else if (tid < 98) rp = ((const int*)(p.ws + WS_PMAX))[b * 128 + 2 * (KT) + (tid & 1)]; \
    }                                                                                         \
  } while (0)
#define ATT_SSTORE(BUF)                                                  \
  do {                                                                   \
    *(uint4*)&sK[(BUF)][krow0][kc0 * 8] = rk0;                           \
    *(uint4*)&sK[(BUF)][krow1][kc1 * 8] = rk1;                           \
    if (NKL > 2) *(uint4*)&sK[(BUF)][krow2][kc2 * 8] = rk2;              \
    *(uint4*)&sV[(BUF)][vd0][vc0 * 8] = rv0;                             \
    *(uint4*)&sV[(BUF)][vd1][vc0 * 8] = rv1;                             \
    if (MODE == 2) {                                                     \
      if (tid < 64) sPos[(BUF) * 64 + tid] = rp;                         \
      else if (tid < 98) sWd[(BUF) * 34 + (tid - 64)] = rp;              \
    }                                                                    \
  } while (0)

  ATT_GLOAD(MODE == 0 ? nt64 - 1 : 0);
  ATT_SSTORE(0);
  if (nt64 > 1) ATT_GLOAD(MODE == 0 ? nt64 - 2 : 1);
  __syncthreads();
  for (int step = 0; step < nt64; ++step) {
    const int kt = (MODE == 0) ? (nt64 - 1 - step) : step;
    const int buf = step & 1;
    const bool more = (step + 1 < nt64);
#pragma unroll
    for (int subi = 0; subi < 2; ++subi) {
      const int sub = (MODE == 0) ? (1 - subi) : subi;
      const int ks0 = kt * 64 + sub * 32;
      const bool skip = (MODE == 0) ? (ks0 >= wmax) : (ks0 > wmax);
      if (!skip) {
        uint32_t wd = 0;
        int pmaxk = 0;
        if (MODE == 2) { wd = (uint32_t)sWd[buf * 34 + (wave * 4 + (r >> 3)) * 2 + sub]; pmaxk = sWd[buf * 34 + 32 + sub]; }
        f32x16 s = zero16();
#pragma unroll
        for (int ks = 0; ks < KS; ++ks) {
          bf16x8 a = *(const bf16x8*)&sK[buf][sub * 32 + r][ks * 16 + 8 * h];
          s = MFMA32(a, qf[ks], s);
        }
        float pv[16];
        if (MODE == 0) {
          const bool needmask = (ks0 + 31 >= wmin);
          float e[16];
#pragma unroll
          for (int i = 0; i < 16; ++i) e[i] = frcp(1.f + fexp2(s[i]));
          if (needmask) {
#pragma unroll
            for (int i = 0; i < 16; ++i) e[i] = ((ks0 + crow(i, h)) < tq) ? e[i] : 1.f;
          }
          float tot[4], pr[4], sel[4];
#pragma unroll
          for (int g = 0; g < 4; ++g) tot[g] = (e[4 * g + 3] * e[4 * g + 2]) * (e[4 * g + 1] * e[4 * g]);
#pragma unroll
          for (int g = 0; g < 4; ++g) {
            unsigned uu = __float_as_uint(tot[g]);
            auto rr = __builtin_amdgcn_permlane32_swap(uu, uu, false, false);
            const float r0 = __uint_as_float(rr[0]), r1 = __uint_as_float(rr[1]);
            pr[g] = r0 * r1;
            sel[g] = h ? 1.f : r1;
          }
          float R[4];
          R[3] = carry; R[2] = R[3] * pr[3]; R[1] = R[2] * pr[2]; R[0] = R[1] * pr[1];
          carry = R[0] * pr[0];
#pragma unroll
          for (int g = 0; g < 4; ++g) {
            const float p4 = R[g] * sel[g];
            const float p3 = p4 * e[4 * g + 3];
            const float p2 = p3 * e[4 * g + 2];
            const float p1 = p2 * e[4 * g + 1];
            const float p0 = p1 * e[4 * g];
            pv[4 * g + 3] = p4 - p3; pv[4 * g + 2] = p3 - p2; pv[4 * g + 1] = p2 - p1; pv[4 * g] = p1 - p0;
          }
        } else {
          float u[16];
          if (MODE == 1) {
            const bool needmask = (ks0 + 31 > wmin);
#pragma unroll
            for (int i = 0; i < 16; ++i) u[i] = s[i];
            if (needmask) {
              asm volatile("" ::: "memory");
#pragma unroll
              for (int i = 0; i < 16; ++i) { if ((ks0 + crow(i, h)) > tq) u[i] = -INFINITY; }
            }
          } else if (wposmin - pmaxk >= 113) {
#pragma unroll
            for (int i = 0; i < 16; ++i) u[i] = ((wd >> crow(i, h)) & 1u) ? s[i] : -INFINITY;
          } else {
#pragma unroll
            for (int i = 0; i < 16; ++i) {
              const int kk = crow(i, h);
              const int pk = sPos[buf * 64 + sub * 32 + kk];
              int dist = posq - pk;
              dist = dist < 0 ? 0 : (dist > 127 ? 127 : dist);
              const float bias = sBias[dist * 8 + hdl];
              const float negm = ((wd >> kk) & 1u) ? 0.f : -INFINITY;
              u[i] = (s[i] + bias) + negm;
            }
          }
          if (fastsm) {
            float ls = 0.f;
#pragma unroll
            for (int i = 0; i < 16; ++i) { pv[i] = fexp2(u[i]); ls += pv[i]; }
            lrun += ls;
          } else {
          float mx = u[0];
#pragma unroll
          for (int i = 1; i < 16; ++i) mx = fmaxf(mx, u[i]);
          mx = xmax32(mx);
          const float mnew = fmaxf(mrun, mx);
          const float muse = (mnew == -INFINITY) ? 0.f : mnew;
          const float alpha = fexp2(mrun - muse);
          float ls = 0.f;
#pragma unroll
          for (int i = 0; i < 16; ++i) { pv[i] = fexp2(u[i] - muse); ls += pv[i]; }
          lrun = lrun * alpha + ls;
          mrun = mnew;
          if (__any(alpha != 1.f)) {
#pragma unroll
            for (int i = 0; i < 16; ++i) { o[0][i] *= alpha; o[1][i] *= alpha; }
          }
          }
        }
#pragma unroll
        for (int sidx = 0; sidx < 2; ++sidx) {
          uint4 pk4 = make_uint4(pack2(pv[8 * sidx], pv[8 * sidx + 1]), pack2(pv[8 * sidx + 2], pv[8 * sidx + 3]),
                                 pack2(pv[8 * sidx + 4], pv[8 * sidx + 5]), pack2(pv[8 * sidx + 6], pv[8 * sidx + 7]));
          bf16x8 pf = __builtin_bit_cast(bf16x8, pk4);
#pragma unroll
          for (int dt = 0; dt < 2; ++dt) {
            const u16* vp = &sV[buf][dt * 32 + r][sub * 32 + 16 * sidx + 4 * h];
            uint2 lo = *(const uint2*)vp;
            uint2 hi = *(const uint2*)(vp + 8);
            bf16x8 va = __builtin_bit_cast(bf16x8, make_uint4(lo.x, lo.y, hi.x, hi.y));
            o[dt] = MFMA32(va, pf, o[dt]);
          }
        }
      }
    }
    if (more) ATT_SSTORE(buf ^ 1);
    if (step + 2 < nt64) ATT_GLOAD((MODE == 0) ? kt - 2 : kt + 2);
    if (MODE == 0) {
      const int alive = __any(carry >= 5.42101086e-20f) ? 1 : 0;
      if (!__syncthreads_or(alive)) break;
    } else {
      __syncthreads();
    }
  }
  float inv = 1.f;
  if (MODE != 0) { const float lt = xsum32(lrun); inv = 1.f / lt; }
  const size_t tok = (size_t)(tokbase + tq);
  const u16* zrow = PROJ + tok * LDP + O_ZA + MODE * 512 + hdl * 64;
  u16* yrow = YBR + tok * LDY + MODE * 512 + hdl * 64;
#pragma unroll
  for (int dt = 0; dt < 2; ++dt)
#pragma unroll
    for (int g = 0; g < 4; ++g) {
      const int d4 = dt * 32 + 8 * g + 4 * h;
      uint2 zu = *(const uint2*)(zrow + d4);
      float z0 = bflo(zu.x), z1 = bfhi(zu.x), z2 = bflo(zu.y), z3 = bfhi(zu.y);
      float y0 = o[dt][4 * g] * inv, y1 = o[dt][4 * g + 1] * inv, y2 = o[dt][4 * g + 2] * inv, y3 = o[dt][4 * g + 3] * inv;
      y0 *= z0 * fsigmoid(z0); y1 *= z1 * fsigmoid(z1); y2 *= z2 * fsigmoid(z2); y3 *= z3 * fsigmoid(z3);
      *(uint2*)(yrow + d4) = make_uint2(pack2(y0, y1), pack2(y2, y3));
    }
}

DI void phase_branch(const Params& p, int layer, char* smem, int xcd, int loc, int nloc) {
  const char* wset = p.ws + WS_WT + (size_t)(layer & 1) * SZ_WSET;
  const u16* WBR = (const u16*)(wset + OFF_WT_BR);
  const u16* YBR = (const u16*)(p.ws + WS_YBR);
  const u16* PROJ = (const u16*)(p.ws + WS_PROJ);
  u16* MG = (u16*)(p.ws + WS_MERGED);
  const int tid = opaque_tid(), lane = tid & 63, wave = __builtin_amdgcn_readfirstlane(tid >> 6), r = lane & 31, h = lane >> 5;
  const int wn = wave & 1, wm = wave >> 1;
  for (int i = loc;; i += nloc) {
    int mt, nt;
    if (!tile_order<8>(i, xcd, mt, nt)) break;
    const int m0 = mt * 128, d0 = nt * 128;
    f32x16 sum[2][2];
    sum[0][0] = zero16(); sum[0][1] = zero16(); sum[1][0] = zero16(); sum[1][1] = zero16();
#pragma unroll 1
    for (int n = 0; n < 3; ++n) {
      f32x16 acc[2][2];
      acc[0][0] = zero16(); acc[0][1] = zero16(); acc[1][0] = zero16(); acc[1][1] = zero16();
      gemm128(WBR + ((size_t)n * 1024 + d0) * LDB, LDB, YBR + (size_t)m0 * LDY + n * 512, LDY, 512, acc, smem);
      const float* gb = p.gate_b + ((size_t)layer * 3 + n) * 1024;
#pragma unroll
      for (int mi = 0; mi < 2; ++mi) {
        const int m = m0 + wm * 64 + mi * 32 + r;
#pragma unroll
        for (int ni = 0; ni < 2; ++ni)
#pragma unroll
          for (int g = 0; g < 4; ++g) {
            const int d4 = d0 + wn * 64 + ni * 32 + 8 * g + 4 * h;
            uint2 gu = *(const uint2*)(PROJ + (size_t)m * LDP + O_G + n * 1024 + d4);
            float4 bb = *(const float4*)(gb + d4);
            float g0 = bflo(gu.x) + bb.x, g1 = bfhi(gu.x) + bb.y, g2 = bflo(gu.y) + bb.z, g3 = bfhi(gu.y) + bb.w;
            sum[ni][mi][4 * g] += acc[ni][mi][4 * g] * fsigmoid(g0);
            sum[ni][mi][4 * g + 1] += acc[ni][mi][4 * g + 1] * fsigmoid(g1);
            sum[ni][mi][4 * g + 2] += acc[ni][mi][4 * g + 2] * fsigmoid(g2);
            sum[ni][mi][4 * g + 3] += acc[ni][mi][4 * g + 3] * fsigmoid(g3);
          }
      }
    }
#pragma unroll
    for (int mi = 0; mi < 2; ++mi) {
      const int m = m0 + wm * 64 + mi * 32 + r;
#pragma unroll
      for (int ni = 0; ni < 2; ++ni)
#pragma unroll
        for (int g = 0; g < 4; ++g) {
          const int d4 = d0 + wn * 64 + ni * 32 + 8 * g + 4 * h;
          *(uint2*)(MG + (size_t)m * LDX + d4) = make_uint2(pack2(sum[ni][mi][4 * g], sum[ni][mi][4 * g + 1]), pack2(sum[ni][mi][4 * g + 2], sum[ni][mi][4 * g + 3]));
        }
    }
  }
}

DI void phase_out(const Params& p, int layer, char* smem, int xcd, int loc, int nloc) {
  const char* wset = p.ws + WS_WT + (size_t)(layer & 1) * SZ_WSET;
  const u16* WOUT = (const u16*)(wset + OFF_WT_OUT);
  const u16* MG = (const u16*)(p.ws + WS_MERGED);
  u16* XB = (u16*)(p.ws + WS_XB);
  float* XSS = (float*)(p.ws + WS_XSS);
  const float* xin = (layer == 0) ? p.x : p.out;
  const int tid = opaque_tid(), lane = tid & 63, wave = __builtin_amdgcn_readfirstlane(tid >> 6), r = lane & 31, h = lane >> 5;
  const int wn = wave & 1, wm = wave >> 1;
  for (int i = loc;; i += nloc) {
    int mt, nt;
    if (!tile_order<8>(i, xcd, mt, nt)) break;
    const int m0 = mt * 128, n0 = nt * 128;
    f32x16 acc[2][2];
    acc[0][0] = zero16(); acc[0][1] = zero16(); acc[1][0] = zero16(); acc[1][1] = zero16();
    gemm128(WOUT + (size_t)n0 * LDX, LDX, MG + (size_t)m0 * LDX, LDX, 1024, acc, smem);
#pragma unroll
    for (int mi = 0; mi < 2; ++mi) {
      const int m = m0 + wm * 64 + mi * 32 + r;
      float ss = 0.f;
#pragma unroll
      for (int ni = 0; ni < 2; ++ni)
#pragma unroll
        for (int g = 0; g < 4; ++g) {
          const int n4 = n0 + wn * 64 + ni * 32 + 8 * g + 4 * h;
          float4 xo = *(const float4*)(xin + (size_t)m * 1024 + n4);
          xo.x += acc[ni][mi][4 * g]; xo.y += acc[ni][mi][4 * g + 1]; xo.z += acc[ni][mi][4 * g + 2]; xo.w += acc[ni][mi][4 * g + 3];
          *(float4*)(p.out + (size_t)m * 1024 + n4) = xo;
          *(uint2*)(XB + (size_t)m * LDX + n4) = make_uint2(pack2(xo.x, xo.y), pack2(xo.z, xo.w));
          ss += xo.x * xo.x + xo.y * xo.y + xo.z * xo.z + xo.w * xo.w;
        }
      ss += xor32(ss);
      if (h == 0) XSS[(size_t)m * 16 + nt * 2 + wn] = ss;
    }
  }
}

DI void phase_init(const Params& p) {
  u16* XB = (u16*)(p.ws + WS_XB);
  float* XSS = (float*)(p.ws + WS_XSS);
  const int lane = threadIdx.x & 63;
  const int gw = blockIdx.x * 4 + (threadIdx.x >> 6), nw = gridDim.x * 4;
  for (int row = gw; row < NTOK; row += nw) {
    const float* xr = p.x + (size_t)row * 1024;
    float ss = 0.f;
#pragma unroll
    for (int i = 0; i < 4; ++i) {
      float4 v = *(const float4*)(xr + i * 256 + lane * 4);
      ss += v.x * v.x + v.y * v.y + v.z * v.z + v.w * v.w;
      *(uint2*)(XB + (size_t)row * LDX + i * 256 + lane * 4) = make_uint2(pack2(v.x, v.y), pack2(v.z, v.w));
    }
#pragma unroll
    for (int off = 32; off >= 1; off >>= 1) ss += __shfl_xor(ss, off);
    if (lane < 16) XSS[(size_t)row * 16 + lane] = (lane == 0) ? ss : 0.f;
  }
  if (blockIdx.x == 0 && threadIdx.x < 64) ((int*)(p.ws + WS_CTR))[threadIdx.x] = 0;
}


#ifndef DUP_MASK
#define DUP_MASK 0
#endif
constexpr int SMEM_BYTES = 73728;
constexpr int N_PHASES = 1 + 5 * DEPTH;

__global__ void __launch_bounds__(256, 2) hybrid_megakernel(Params p, int ph_lo, int ph_hi, int do_sync) {
  __shared__ __attribute__((aligned(16))) char smem[SMEM_BYTES];
  __shared__ int s_item;
  __shared__ uint4 xb_words;
  const int tid = threadIdx.x, bid = blockIdx.x, nb = gridDim.x;
  __shared__ int s_xinfo[4];
  if (tid == 0) { xb_words = make_uint4(0u, 0u, 0u, 0u); s_xinfo[3] = 0; }
  __syncthreads();
  XcdBarrier xb = xcd_barrier_post((unsigned*)(p.ws + WS_BAR), (volatile LAS unsigned*)&xb_words);
  if (tid == 0) s_xinfo[1] = (int)xb_add((unsigned*)(p.ws + WS_BAR) + 8 * xb.x, 1u);
  int t_cls = bid & 7, t_loc = bid >> 3, t_step = (nb - (bid & 7) + 7) >> 3;
  for (int ph = ph_lo; ph < ph_hi; ++ph) {
    if (ph == 0) {
      phase_init(p);
      for (int it = bid; it < CV_TOTAL; it += nb) convert_item(p, 0, it, (float*)smem);
    } else {
      const int layer = (ph - 1) / 5, sub = (ph - 1) % 5;
      if (sub == 0) {
        phase_proj(p, layer, smem, t_cls, t_loc, t_step);
        if (DUP_MASK & 1) { __syncthreads(); phase_proj(p, layer, smem, t_cls, t_loc, t_step); }
        if (DUP_MASK & 16) { __syncthreads(); phase_proj_probe(p, layer, smem, t_cls, t_loc, t_step); }
      } else if (sub == 1) {
        const int ncv = (layer + 1 < DEPTH) ? CV_TOTAL : 0;
        const int total = 4096 + 1024 + ncv;
        for (int rep = 0; rep < ((DUP_MASK & 4) ? 2 : 1); ++rep)
        for (int it = bid; it < total; it += nb) {
          if (it < 4096) select_item(p, it, smem);
          else if (it < 5120) prep_item(p, layer, (it - 4096) * 4 + (tid >> 6));
          else convert_item(p, layer + 1, it - 5120, (float*)smem);
        }
      } else if (sub == 2) {
        const bool fast1 = softmax_bound_ok(p, layer, 1), fast2 = softmax_bound_ok(p, layer, 2);
        const bool xq = (s_xinfo[3] == 8);
        int* ctr = (int*)(p.ws + WS_CTR) + (xq ? (16 + layer * 8 + t_cls) : layer);
        const int limit = xq ? 384 : 3072;
        while (true) {
          if (tid == 0) s_item = atomicAdd(ctr, 1);
          __syncthreads();
          const int w = s_item;
          __syncthreads();
          if (w >= limit) break;
          int type, b, hd, d, jt;
          if (xq) {
            const int level = w / 12, within = w - level * 12;
            d = 31 - level;
            type = within >> 2;
            const int pr = 4 * t_cls + (within & 3);
            b = (type == 2) ? (t_cls >> 1) : (pr >> 3);
            hd = pr & 7;
            jt = d * 8 + 2 * (within & 3) + (t_cls & 1);
          } else {
            d = 31 - w / 96;
            const int within = w % 96, idx = within & 31;
            type = within >> 5; b = idx >> 3; hd = idx & 7; jt = d * 8 + (idx & 7);
          }
          if (type == 0) attn_item<0, false>(p, layer, b, hd, d, smem);
          else if (type == 1) { if (fast1) attn_item<1, true>(p, layer, b, hd, d, smem); else attn_item<1, false>(p, layer, b, hd, d, smem); }
          else { if (fast2) attn_item<2, true>(p, layer, b, 0, jt, smem); else attn_item<2, false>(p, layer, b, 0, jt, smem); }
        }
      } else if (sub == 3) {
        phase_branch(p, layer, smem, t_cls, t_loc, t_step);
        if (DUP_MASK & 8) { __syncthreads(); phase_branch(p, layer, smem, t_cls, t_loc, t_step); }
      } else {
        phase_out(p, layer, smem, t_cls, t_loc, t_step);
      }
    }
    if (do_sync == 2) cg::this_grid().sync();
    if (do_sync && ph + 1 < ph_hi) {
      xcd_barrier(xb);
      if (ph == ph_lo) {
        if (tid == 0) {
          unsigned* bar = (unsigned*)(p.ws + WS_BAR);
          int xi = 0;
          for (unsigned j = 0; j < xb.x; ++j) xi += (xb_ld(&bar[XB_XCNT(j)]) > 0u) ? 1 : 0;
          s_xinfo[0] = xi; s_xinfo[2] = (int)xb_words.x; s_xinfo[3] = (int)xb_words.y;
        }
        __syncthreads();
        if (s_xinfo[3] == 8) { t_cls = s_xinfo[0]; t_loc = s_xinfo[1]; t_step = s_xinfo[2]; }
      }
    }
  }
}

#ifndef MK_MULTI
#define MK_MULTI 0
#endif

extern "C" void kernel_launch(void* const* d_in, const int* in_sizes, int n_in, void* d_out, int out_size, void* d_ws,
                              size_t ws_size, hipStream_t stream) {
  (void)in_sizes; (void)n_in; (void)out_size;
  if (ws_size < WS_TOTAL) { fprintf(stderr, "workspace too small: %zu < %zu\n", ws_size, (size_t)WS_TOTAL); return; }
  Params p{};
  p.x = (const float*)d_in[0]; p.pos = (const int*)d_in[1]; p.norm_g = (const float*)d_in[2]; p.w_in = (const float*)d_in[3];
  p.qn_g = (const float*)d_in[4]; p.kvn_g = (const float*)d_in[5]; p.w_uq = (const float*)d_in[6]; p.w_ukv = (const float*)d_in[7];
  p.mla_q_g = (const float*)d_in[8]; p.mla_k_g = (const float*)d_in[9]; p.dsa_q_g = (const float*)d_in[10]; p.dsa_k_g = (const float*)d_in[11];
  p.rel_bias = (const float*)d_in[12]; p.gate_b = (const float*)d_in[13]; p.w_branch = (const float*)d_in[14]; p.w_out = (const float*)d_in[15];
  p.out = (float*)d_out; p.ws = (char*)d_ws;
  static int grid_blocks = 0;
  if (!grid_blocks) {
    int dev = 0, cus = 0, per_cu = 0;
    hipGetDevice(&dev);
    hipDeviceGetAttribute(&cus, hipDeviceAttributeMultiprocessorCount, dev);
    hipOccupancyMaxActiveBlocksPerMultiprocessor(&per_cu, hybrid_megakernel, 256, 0);
    if (per_cu > 2) per_cu = 2;
    grid_blocks = cus * per_cu;
    if (grid_blocks < 8) grid_blocks = 8;
  }
#if MK_MULTI
  for (int ph = 0; ph < N_PHASES; ++ph) {
    hipLaunchKernelGGL(hybrid_megakernel, dim3(grid_blocks), dim3(256), 0, stream, p, ph, ph + 1, 0);
  }
#else
  hipMemsetAsync((char*)d_ws + WS_BAR, 0, 32768, stream);
  int lo = 0, hi = N_PHASES, sy = 1;
  void* args[] = {&p, &lo, &hi, &sy};
  hipError_t e = hipLaunchCooperativeKernel((void*)hybrid_megakernel, dim3(grid_blocks), dim3(256), args, 0, stream);
  if (e != hipSuccess) fprintf(stderr, "cooperative launch failed: %s (grid %d)\n", hipGetErrorString(e), grid_blocks);
#endif
}
```

```cpp
#include <hip/hip_runtime.h>
#include <hip/hip_cooperative_groups.h>
#include <stdint.h>
#include <stdio.h>
namespace cg = cooperative_groups;

typedef unsigned short u16;
typedef __attribute__((ext_vector_type(8))) short bf16x8;
typedef __attribute__((ext_vector_type(16))) float f32x16;
typedef __attribute__((ext_vector_type(2))) float f2_t;
typedef __attribute__((ext_vector_type(2))) __bf16 bf2_t;

#define DI __device__ __forceinline__
#ifndef STAGE_LDS
#define STAGE_LDS 1
#endif
#ifndef BIS1
#define BIS1 0
#endif
#ifndef SEL_NOGUARD
#define SEL_NOGUARD 0
#endif
#define MFMA32(a, b, c) __builtin_amdgcn_mfma_f32_32x32x16_bf16((a), (b), (c), 0, 0, 0)

constexpr int SEQ = 4096, NTOK = 16384, DEPTH = 4;
constexpr int D_IN = 7496, NP = 7552;
constexpr int N_DSV = 2496, N_KPEIXK = 2816;
constexpr int LDP = 6016;
constexpr int LDX = 1088, LDB = 576, LDY = 1600;
constexpr int O_CQ = 0, O_CKV = 256, O_DSQ = 384, O_DSK = 896, O_IXQ = 1024, O_KPE = 1280, O_ZA = 1344, O_G = 2880, O_IXW = 5952;
constexpr float LOG2E = 1.4426950408889634f;
constexpr float C_SB = 0.125f * LOG2E;
constexpr float C_MLA = 0.10206207261596577f * LOG2E;
constexpr float EPS = 1e-6f;

constexpr size_t SZ_WT_IN = (size_t)NP * LDX * 2, SZ_WT_UQ = 768 * 256 * 2, SZ_WT_UKV = 1024 * 128 * 2,
                 SZ_WT_BR = 3 * 1024 * LDB * 2, SZ_WT_OUT = 1024 * LDX * 2;
constexpr size_t OFF_WT_UQ = SZ_WT_IN, OFF_WT_UKV = OFF_WT_UQ + SZ_WT_UQ, OFF_WT_BR = OFF_WT_UKV + SZ_WT_UKV,
                 OFF_WT_OUT = OFF_WT_BR + SZ_WT_BR, SZ_WSET = OFF_WT_OUT + SZ_WT_OUT;
constexpr size_t WS_WT = 0;
constexpr size_t WS_XB = WS_WT + 2 * SZ_WSET;
constexpr size_t WS_XSS = WS_XB + (size_t)NTOK * LDX * 2;
constexpr size_t WS_PROJ = WS_XSS + (size_t)NTOK * 16 * 4;
constexpr size_t WS_QB = WS_PROJ + (size_t)NTOK * LDP * 2;
constexpr size_t WS_KB = WS_QB + (size_t)NTOK * 768 * 2;
constexpr size_t WS_VTA = WS_KB + (size_t)NTOK * 768 * 2;
constexpr size_t WS_VTB = WS_VTA + (size_t)NTOK * 512 * 2;
constexpr size_t WS_VTC = WS_VTB + (size_t)NTOK * 512 * 2;
constexpr size_t WS_YBR = WS_VTC + (size_t)NTOK * 64 * 2;
constexpr size_t WS_BM = WS_YBR + (size_t)NTOK * LDY * 2;
constexpr size_t WS_QA = WS_BM + (size_t)NTOK * 128 * 4;
constexpr size_t WS_KA = WS_QA + (size_t)NTOK * 512 * 2;
constexpr size_t WS_DSQ = WS_KA + (size_t)NTOK * 512 * 2;
constexpr size_t WS_DSK = WS_DSQ + (size_t)NTOK * 512 * 2;
constexpr size_t WS_IXK = WS_DSK + (size_t)NTOK * 64 * 2;
constexpr size_t WS_CTR = WS_IXK + (size_t)NTOK * 32 * 2;
constexpr size_t WS_BAR = WS_CTR + 256;
constexpr size_t WS_PMAX = WS_BAR + 32768;
constexpr size_t WS_TOTAL = WS_PMAX + 4096;
constexpr size_t WS_MERGED = WS_QB;

struct Params {
  const float* x; const int* pos; const float* norm_g; const float* w_in; const float* qn_g; const float* kvn_g;
  const float* w_uq; const float* w_ukv; const float* mla_q_g; const float* mla_k_g; const float* dsa_q_g;
  const float* dsa_k_g; const float* rel_bias; const float* gate_b; const float* w_branch; const float* w_out;
  float* out; char* ws;
};

DI uint32_t pack2(float a, float b) { f2_t v = {a, b}; bf2_t r = __builtin_convertvector(v, bf2_t); return __builtin_bit_cast(uint32_t, r); }
DI float bflo(uint32_t u) { return __uint_as_float(u << 16); }
DI float bfhi(uint32_t u) { return __uint_as_float(u & 0xffff0000u); }
DI float bf1(u16 u) { return __uint_as_float(((uint32_t)u) << 16); }
DI u16 f2bf(float x) { return (u16)(pack2(x, 0.f) & 0xffffu); }
DI float xor32(float v) { return __shfl_xor(v, 32); }
DI float xsum32(float v) { unsigned u = __float_as_uint(v); auto r = __builtin_amdgcn_permlane32_swap(u, u, false, false); return __uint_as_float(r[0]) + __uint_as_float(r[1]); }
DI float xmax32(float v) { unsigned u = __float_as_uint(v); auto r = __builtin_amdgcn_permlane32_swap(u, u, false, false); return fmaxf(__uint_as_float(r[0]), __uint_as_float(r[1])); }
DI int crow(int reg, int h) { return (reg & 3) + 8 * (reg >> 2) + 4 * h; }
DI float fexp2(float x) { return __builtin_amdgcn_exp2f(x); }
DI float frcp(float x) { return __builtin_amdgcn_rcpf(x); }
DI int opaque_tid() { int t = threadIdx.x; asm volatile("" : "+v"(t)); return t; }
DI float fsigmoid(float x) { return frcp(1.f + fexp2(-LOG2E * x)); }
DI f32x16 zero16() { f32x16 z; _Pragma("unroll") for (int i = 0; i < 16; ++i) z[i] = 0.f; return z; }

#define XB_TMO      128
#define XB_XCNT(j)  (256  + 64 * (j))
#define XB_XSUB(j)  (1280 + 64 * (j))
#define XB_XGEN(j)  (2304 + 64 * (j))
#define XB_TOP      3328
#define XB_TOPGEN   3392
#define XCD_BAR_WORDS 3456
#define XB_SPIN_CAP (1u << 22)
#define LAS __attribute__((address_space(3)))
DI unsigned xb_ld(unsigned* p) { return __hip_atomic_load(p, __ATOMIC_RELAXED, __HIP_MEMORY_SCOPE_AGENT); }
DI unsigned xb_add(unsigned* p, unsigned v) { return __hip_atomic_fetch_add(p, v, __ATOMIC_RELAXED, __HIP_MEMORY_SCOPE_AGENT); }
DI unsigned xb_xcc_id() { return (unsigned)__builtin_amdgcn_s_getreg((3 << 11) | 20) & 0xFu; }
#define XB_SPIN(cond, bar) do { unsigned _sp = 0; while (cond) { __builtin_amdgcn_s_sleep(1); \
    if ((++_sp & 255u) == 0u) { if (xb_ld(&(bar)[XB_TMO])) break; if (_sp > XB_SPIN_CAP) { atomicAdd(&(bar)[XB_TMO], 1u); break; } } } } while (0)
struct XcdBarrier { unsigned* bar; unsigned x; volatile LAS unsigned* st; };
DI XcdBarrier xcd_barrier_post(unsigned* bar, volatile LAS unsigned* st) {
  XcdBarrier b; b.bar = bar; b.x = xb_xcc_id(); b.st = st;
  if (threadIdx.x == 0) (void)xb_add(&bar[XB_XCNT(b.x)], 1u);
  return b;
}
DI void xcd_barrier_complete(unsigned* bar, unsigned x, unsigned& nloc, unsigned& nx) {
  const unsigned G = gridDim.x * gridDim.y * gridDim.z;
  unsigned sum, cnt, mine, sp = 0u;
  for (;;) {
    sum = 0u; cnt = 0u; mine = 0u;
#pragma unroll
    for (unsigned j = 0; j < 16; ++j) { const unsigned c = xb_ld(&bar[XB_XCNT(j)]); sum += c; cnt += (c > 0u) ? 1u : 0u; mine = (j == x) ? c : mine; }
    if (sum == G) break;
    __builtin_amdgcn_s_sleep(1);
    if ((++sp & 255u) == 0u) { if (xb_ld(&bar[XB_TMO])) break; if (sp > XB_SPIN_CAP) { atomicAdd(&bar[XB_TMO], 1u); break; } }
  }
  nloc = mine > 0u ? mine : 1u; nx = cnt > 0u ? cnt : 1u;
}
DI void xcd_barrier(const XcdBarrier& b) {
  asm volatile("s_waitcnt vmcnt(0)" ::: "memory");
  __syncthreads();
  if (threadIdx.x == 0) {
    unsigned* bar = b.bar;
    __builtin_amdgcn_s_waitcnt(0);
    unsigned nloc = b.st[0], nx = b.st[1];
    if (nloc == 0u) { xcd_barrier_complete(bar, b.x, nloc, nx); b.st[0] = nloc; b.st[1] = nx; }
    const unsigned old = xb_add(&bar[XB_XSUB(b.x)], 1u);
    const unsigned gen = old / nloc;
    if (old + 1u == (gen + 1u) * nloc) {
      __builtin_amdgcn_fence(__ATOMIC_RELEASE, "agent");
      asm volatile("s_waitcnt vmcnt(0)" ::: "memory");
      const unsigned og = xb_add(&bar[XB_TOP], 1u);
      const unsigned tg = og / nx;
      if (og + 1u == (tg + 1u) * nx) xb_add(&bar[XB_TOPGEN], 1u);
      else XB_SPIN(xb_ld(&bar[XB_TOPGEN]) == tg, bar);
      __builtin_amdgcn_fence(__ATOMIC_ACQUIRE, "agent");
      xb_add(&bar[XB_XGEN(b.x)], 1u);
      asm volatile("s_waitcnt vmcnt(0)" ::: "memory");
    } else {
      XB_SPIN(xb_ld(&bar[XB_XGEN(b.x)]) == gen, bar);
      __builtin_amdgcn_fence(__ATOMIC_ACQUIRE, "agent");
      asm volatile("s_waitcnt vmcnt(0)" ::: "memory");
    }
  }
  __syncthreads();
}

#define XB_RND(j) (3456 + 64 * (j))
DI void class_round_sync(unsigned* bar, int cls, int members) {
  __syncthreads();
  if (threadIdx.x == 0) {
    const unsigned t = xb_add(&bar[XB_RND(cls)], 1u);
    const unsigned target = (t / (unsigned)members + 1u) * (unsigned)members;
    unsigned sp = 0;
    while (xb_ld(&bar[XB_RND(cls)]) < target) { __builtin_amdgcn_s_sleep(1); if (++sp > (1u << 16)) break; }
  }
  __syncthreads();
}

DI int src_col(int n) {
  if (n < 1920) return n;
  if (n < 2816) return n + 32;
  if (n < 2848) return n - 896;
  if (n < 2880) return n;
  if (n < 7488) return n + 8;
  if (n < 7496) return n - 4608;
  return -1;
}
template <bool MAP>
DI void transpose_tile(const float* __restrict__ src, int N, int K, int Nvalid, const float* __restrict__ g,
                       u16* __restrict__ dst, int ldd, int k0, int n0, float* sT) {
  const int tid = opaque_tid();
  const int cg = (tid & 15) * 4, kq = tid >> 4;
  const int sc = MAP ? src_col(n0 + cg) : ((n0 + cg < Nvalid) ? n0 + cg : -1);
#pragma unroll
  for (int i = 0; i < 4; ++i) {
    const int kk = i * 16 + kq;
    float4 v = make_float4(0.f, 0.f, 0.f, 0.f);
    if (sc >= 0) {
      v = *(const float4*)(src + (size_t)(k0 + kk) * N + sc);
      if (g) { const float gg = g[k0 + kk]; v.x *= gg; v.y *= gg; v.z *= gg; v.w *= gg; }
    }
    float* d = sT + kk * 65 + cg;
    d[0] = v.x; d[1] = v.y; d[2] = v.z; d[3] = v.w;
  }
  __syncthreads();
  const int n = tid >> 2, kc = (tid & 3) * 16;
  uint32_t o[8];
#pragma unroll
  for (int j = 0; j < 8; ++j) o[j] = pack2(sT[(kc + 2 * j) * 65 + n], sT[(kc + 2 * j + 1) * 65 + n]);
  uint4* d = (uint4*)(dst + (size_t)(n0 + n) * ldd + k0 + kc);
  d[0] = make_uint4(o[0], o[1], o[2], o[3]);
  d[1] = make_uint4(o[4], o[5], o[6], o[7]);
  __syncthreads();
}

constexpr int CV_IN = 16 * 118, CV_UQ = 4 * 12, CV_UKV = 2 * 16, CV_BR = 3 * 8 * 16, CV_OUT = 16 * 16;
constexpr int CV_TOTAL = CV_IN + CV_UQ + CV_UKV + CV_BR + CV_OUT;

DI void convert_item(const Params& p, int layer, int item, float* sT) {
  char* wset = p.ws + WS_WT + (size_t)(layer & 1) * SZ_WSET;
  if (item < CV_IN) {
    int kt = item & 15, nt = item >> 4;
    transpose_tile<true>(p.w_in + (size_t)layer * 1024 * D_IN, D_IN, 1024, D_IN, p.norm_g + layer * 1024, (u16*)wset, LDX, kt * 64, nt * 64, sT);
    return;
  }
  item -= CV_IN;
  if (item < CV_UQ) {
    int kt = item & 3, nt = item >> 2;
    transpose_tile<false>(p.w_uq + (size_t)layer * 256 * 768, 768, 256, 768, p.qn_g + layer * 256, (u16*)(wset + OFF_WT_UQ), 256, kt * 64, nt * 64, sT);
    return;
  }
  item -= CV_UQ;
  if (item < CV_UKV) {
    int kt = item & 1, nt = item >> 1;
    transpose_tile<false>(p.w_ukv + (size_t)layer * 128 * 1024, 1024, 128, 1024, p.kvn_g + layer * 128, (u16*)(wset + OFF_WT_UKV), 128, kt * 64, nt * 64, sT);
    return;
  }
  item -= CV_UKV;
  if (item < CV_BR) {
    int br = item >> 7, rem = item & 127, kt = rem & 7, nt = rem >> 3;
    transpose_tile<false>(p.w_branch + ((size_t)layer * 3 + br) * 512 * 1024, 1024, 512, 1024, nullptr,
                   (u16*)(wset + OFF_WT_BR) + (size_t)br * 1024 * LDB, LDB, kt * 64, nt * 64, sT);
    return;
  }
  item -= CV_BR;
  {
    int kt = item & 15, nt = item >> 4;
    transpose_tile<false>(p.w_out + (size_t)layer * 1024 * 1024, 1024, 1024, 1024, nullptr, (u16*)(wset + OFF_WT_OUT), LDX, kt * 64, nt * 64, sT);
  }
}

DI void gemm128(const u16* __restrict__ W, int ldw, const u16* __restrict__ X, int ldx, int K, f32x16 (&acc)[2][2], char* smem) {
  typedef u16 (*tile_t)[128][72];
  tile_t sw = (tile_t)smem;
  tile_t sx = (tile_t)(smem + 2 * 128 * 72 * 2);
  const int tid = opaque_tid(), lane = tid & 63, wave = __builtin_amdgcn_readfirstlane(tid >> 6), r = lane & 31, h = lane >> 5;
  const int wn = wave & 1, wm = wave >> 1;
  const int lc = tid & 7, lr = tid >> 3;
  const u16* gw = W + (size_t)lr * ldw + lc * 8;
  const u16* gx = X + (size_t)lr * ldx + lc * 8;
  const u16* gw1 = gw + (size_t)32 * ldw; const u16* gw2 = gw + (size_t)64 * ldw; const u16* gw3 = gw + (size_t)96 * ldw;
  const u16* gx1 = gx + (size_t)32 * ldx; const u16* gx2 = gx + (size_t)64 * ldx; const u16* gx3 = gx + (size_t)96 * ldx;
  uint4 rw0, rw1, rw2, rw3, rx0, rx1, rx2, rx3;
#define G_LOAD(KOFF) do { rw0 = *(const uint4*)(gw + (KOFF)); rw1 = *(const uint4*)(gw1 + (KOFF)); rw2 = *(const uint4*)(gw2 + (KOFF)); rw3 = *(const uint4*)(gw3 + (KOFF)); \
                          rx0 = *(const uint4*)(gx + (KOFF)); rx1 = *(const uint4*)(gx1 + (KOFF)); rx2 = *(const uint4*)(gx2 + (KOFF)); rx3 = *(const uint4*)(gx3 + (KOFF)); } while (0)
#define G_STORE(BUF) do { *(uint4*)&sw[(BUF)][lr][lc * 8] = rw0; *(uint4*)&sw[(BUF)][lr + 32][lc * 8] = rw1; *(uint4*)&sw[(BUF)][lr + 64][lc * 8] = rw2; *(uint4*)&sw[(BUF)][lr + 96][lc * 8] = rw3; \
                          *(uint4*)&sx[(BUF)][lr][lc * 8] = rx0; *(uint4*)&sx[(BUF)][lr + 32][lc * 8] = rx1; *(uint4*)&sx[(BUF)][lr + 64][lc * 8] = rx2; *(uint4*)&sx[(BUF)][lr + 96][lc * 8] = rx3; } while (0)
  G_LOAD(0);
  G_STORE(0);
  const int nk = K >> 6;
  G_LOAD(64);
  __syncthreads();
  for (int kt = 0; kt < nk; ++kt) {
    const int buf = kt & 1;
#pragma unroll
    for (int ks = 0; ks < 4; ++ks) {
      bf16x8 a0 = *(const bf16x8*)&sw[buf][wn * 64 + r][ks * 16 + h * 8];
      bf16x8 a1 = *(const bf16x8*)&sw[buf][wn * 64 + 32 + r][ks * 16 + h * 8];
      bf16x8 b0 = *(const bf16x8*)&sx[buf][wm * 64 + r][ks * 16 + h * 8];
      bf16x8 b1 = *(const bf16x8*)&sx[buf][wm * 64 + 32 + r][ks * 16 + h * 8];
      acc[0][0] = MFMA32(a0, b0, acc[0][0]);
      acc[0][1] = MFMA32(a0, b1, acc[0][1]);
      acc[1][0] = MFMA32(a1, b0, acc[1][0]);
      acc[1][1] = MFMA32(a1, b1, acc[1][1]);
    }
    if (kt + 1 < nk) G_STORE(buf ^ 1);
    if (kt + 2 < nk) G_LOAD((kt + 2) * 64);
    __syncthreads();
  }
#undef G_LOAD
#undef G_STORE
}

template <int NT>
DI bool tile_order(int i, int xcd, int& mt, int& nt) {
  constexpr int PER = 8 * NT;
  if (i >= 2 * PER) return false;
  int mh = i / PER, j = i - mh * PER;
  int ng = j >> 6, w = j & 63;
  mt = xcd * 16 + mh * 8 + (w & 7);
  nt = ng * 8 + (w >> 3);
  return true;
}

DI void phase_proj(const Params& p, int layer, char* smem, int xcd, int loc, int nloc) {
  const u16* WT = (const u16*)(p.ws + WS_WT + (size_t)(layer & 1) * SZ_WSET);
  const u16* XB = (const u16*)(p.ws + WS_XB);
  const float* XSS = (const float*)(p.ws + WS_XSS);
  u16* PROJ = (u16*)(p.ws + WS_PROJ);
  u16* VTA = (u16*)(p.ws + WS_VTA);
  u16* VTC = (u16*)(p.ws + WS_VTC);
  const int tid = opaque_tid(), lane = tid & 63, wave = __builtin_amdgcn_readfirstlane(tid >> 6), r = lane & 31, h = lane >> 5;
  const int wn = wave & 1, wm = wave >> 1;
  for (int i = loc;; i += nloc) {
    int mt, nt;
    if (!tile_order<59>(i, xcd, mt, nt)) break;
    const int m0 = mt * 128, n0 = nt * 128;
    f32x16 acc[2][2];
    acc[0][0] = zero16(); acc[0][1] = zero16(); acc[1][0] = zero16(); acc[1][1] = zero16();
    float rinv2[2];
#pragma unroll
    for (int mi = 0; mi < 2; ++mi) {
      const float4* sp = (const float4*)(XSS + (size_t)(m0 + wm * 64 + mi * 32 + r) * 16);
      float4 q0 = sp[0], q1 = sp[1], q2 = sp[2], q3 = sp[3];
      float ss = ((q0.x + q0.y) + (q0.z + q0.w)) + ((q1.x + q1.y) + (q1.z + q1.w)) + ((q2.x + q2.y) + (q2.z + q2.w)) + ((q3.x + q3.y) + (q3.z + q3.w));
      rinv2[mi] = rsqrtf(ss * (1.f / 1024.f) + EPS);
    }
    gemm128(WT + (size_t)n0 * LDX, LDX, XB + (size_t)m0 * LDX, LDX, 1024, acc, smem);
    {
      const int nb = n0 + wn * 64;
      const int mb = m0 + wm * 64;
      const int b = mb >> 12, s0 = mb & 4095;
      u16 (*st)[72] = (u16 (*)[72])(smem + ((wave & 2) ? 55296 : 18432) + (wave & 1) * 9216);
      const bool transposed = (nb >= 1024 && nb < 1536) || (nb == N_DSV);
      const float cs = (nb < 512) ? C_SB : 1.f;
      u16* dst; size_t rstride;
      if (nb < 512) { dst = (u16*)(p.ws + WS_QA) + ((size_t)(b * 8 + (nb >> 6)) * 4096 + s0) * 64; rstride = 64; }
      else if (nb < 1024) { dst = (u16*)(p.ws + WS_KA) + ((size_t)(b * 8 + ((nb - 512) >> 6)) * 4096 + s0) * 64; rstride = 64; }
      else if (nb < 1536) { dst = VTA + ((size_t)(b * 8 + ((nb - 1024) >> 6)) * 64) * 4096 + s0; rstride = 4096; }
      else if (nb == N_DSV) { dst = VTC + ((size_t)b * 64) * 4096 + s0; rstride = 4096; }
      else { dst = PROJ + (size_t)mb * LDP + (nb - 1536); rstride = LDP; }
#pragma unroll
      for (int mi = 0; mi < 2; ++mi) {
        const int m = mb + mi * 32 + r;
        const float rinv = rinv2[mi] * cs;
#pragma unroll
        for (int ni = 0; ni < 2; ++ni) {
          if (transposed) {
#pragma unroll
            for (int i = 0; i < 16; ++i) {
              if (STAGE_LDS) st[ni * 32 + crow(i, h)][mi * 32 + r] = f2bf(acc[ni][mi][i] * rinv);
              else dst[(size_t)(ni * 32 + crow(i, h)) * rstride + mi * 32 + r] = f2bf(acc[ni][mi][i] * rinv);
            }
          } else {
#pragma unroll
            for (int g = 0; g < 4; ++g) {
              const uint2 v = make_uint2(pack2(acc[ni][mi][4 * g] * rinv, acc[ni][mi][4 * g + 1] * rinv), pack2(acc[ni][mi][4 * g + 2] * rinv, acc[ni][mi][4 * g + 3] * rinv));
              if (STAGE_LDS) *(uint2*)&st[mi * 32 + r][ni * 32 + 8 * g + 4 * h] = v;
              else {
                *(uint2*)(dst + (size_t)(mi * 32 + r) * rstride + ni * 32 + 8 * g + 4 * h) = v;
                if (nb == N_KPEIXK && ni == 1) *(uint2*)((u16*)(p.ws + WS_IXK) + (size_t)m * 32 + 8 * g + 4 * h) = v;
              }
            }
          }
        }
      }
      if (STAGE_LDS) {
        __builtin_amdgcn_wave_barrier();
        asm volatile("s_waitcnt lgkmcnt(0)" ::: "memory");
        const int rr = lane >> 3, cc = lane & 7;
#pragma unroll
        for (int it = 0; it < 8; ++it) {
          const int row = it * 8 + rr;
          uint4 v = *(const uint4*)&st[row][cc * 8];
          *(uint4*)(dst + (size_t)row * rstride + cc * 8) = v;
          if (nb == N_KPEIXK && cc >= 4) *(uint4*)((u16*)(p.ws + WS_IXK) + (size_t)(mb + row) * 32 + (cc - 4) * 8) = v;
        }
      }
    }
  }
}

DI void phase_proj_probe(const Params& p, int layer, char* smem, int xcd, int loc, int nloc) {
  const u16* WT = (const u16*)(p.ws + WS_WT + (size_t)(layer & 1) * SZ_WSET);
  const u16* XB = (const u16*)(p.ws + WS_XB);
  float tot = 0.f;
  for (int i = loc;; i += nloc) {
    int mt, nt;
    if (!tile_order<59>(i, xcd, mt, nt)) break;
    f32x16 acc[2][2];
    acc[0][0] = zero16(); acc[0][1] = zero16(); acc[1][0] = zero16(); acc[1][1] = zero16();
    gemm128(WT, LDX, XB, LDX, 1024, acc, smem);
    tot += acc[0][0][0] + acc[0][1][3] + acc[1][0][5] + acc[1][1][7];
  }
  if (tot == 12345.678f) ((float*)(p.ws + WS_CTR))[32] = tot;
}

DI void prep_item(const Params& p, int layer, int item, char* smem) {
  const char* wset = p.ws + WS_WT + (size_t)(layer & 1) * SZ_WSET;
  const u16* WUQ = (const u16*)(wset + OFF_WT_UQ);
  const u16* WUKV = (const u16*)(wset + OFF_WT_UKV);
  u16* PROJ = (u16*)(p.ws + WS_PROJ);
  u16* QB = (u16*)(p.ws + WS_QB);
  u16* KB = (u16*)(p.ws + WS_KB);
  u16* VTB = (u16*)(p.ws + WS_VTB);
  const int tid = opaque_tid(), lane = tid & 63, wave = __builtin_amdgcn_readfirstlane(tid >> 6), r = lane & 31, h = lane >> 5;
  const int tg = (item >> 3) * 4 + wave, hd = item & 7;
  const int token = tg * 32 + r, b = token >> 12, s = token & 4095;
  u16 (*sWq)[264] = (u16 (*)[264])smem;
  u16 (*sWk)[136] = (u16 (*)[136])smem;
  {
    const u16* src = WUQ + (size_t)(hd * 96) * 256;
#pragma unroll
    for (int i = 0; i < 12; ++i) {
      const int idx = tid + 256 * i, row = idx >> 5, c = idx & 31;
      *(uint4*)&sWq[row][c * 8] = *(const uint4*)(src + (size_t)row * 256 + c * 8);
    }
  }
  __syncthreads();
  u16* prow = PROJ + (size_t)token * LDP;

  const float posf = (float)p.pos[token];
  float cs[8], sn[8];
  {
    const float IF0[8] = {1.0f, 0.5623413251903491f, 0.31622776601683794f, 0.1778279410038923f, 0.01f, 0.005623413251903491f, 0.0031622776601683794f, 0.0017782794100389228f};
    const float IF1[8] = {0.1f, 0.05623413251903491f, 0.03162277660168379f, 0.01778279410038923f, 0.001f, 0.0005623413251903491f, 0.00031622776601683794f, 0.00017782794100389227f};
#pragma unroll
    for (int reg = 0; reg < 8; ++reg) {
      const float inv = h ? IF1[reg] : IF0[reg];
      const float ang = posf * inv;
      double rv = (double)ang * 0.15915494309189535;
      rv -= rint(rv);
      const float fr = (float)rv;
      sn[reg] = __builtin_amdgcn_sinf(fr);
      cs[reg] = __builtin_amdgcn_cosf(fr);
    }
  }

  {
    bf16x8 bq[16];
    float ss = 0.f;
#pragma unroll
    for (int ks = 0; ks < 16; ++ks) {
      uint4 u = *(const uint4*)(prow + O_CQ + ks * 16 + 8 * h);
      bq[ks] = __builtin_bit_cast(bf16x8, u);
      float f;
      f = bflo(u.x); ss += f * f; f = bfhi(u.x); ss += f * f; f = bflo(u.y); ss += f * f; f = bfhi(u.y); ss += f * f;
      f = bflo(u.z); ss += f * f; f = bfhi(u.z); ss += f * f; f = bflo(u.w); ss += f * f; f = bfhi(u.w); ss += f * f;
    }
    ss += xor32(ss);
    const float rq = rsqrtf(ss * (1.f / 256.f) + EPS);
    f32x16 acc[3];
    acc[0] = zero16(); acc[1] = zero16(); acc[2] = zero16();

#pragma unroll
    for (int ks = 0; ks < 16; ++ks) {
#pragma unroll
      for (int nt = 0; nt < 3; ++nt) {
        bf16x8 a = *(const bf16x8*)&sWq[nt * 32 + r][ks * 16 + 8 * h];
        acc[nt] = MFMA32(a, bq[ks], acc[nt]);
      }
    }
    float ss2 = 0.f;
#pragma unroll
    for (int nt = 0; nt < 3; ++nt)
#pragma unroll
      for (int i = 0; i < 16; ++i) { acc[nt][i] *= rq; ss2 += acc[nt][i] * acc[nt][i]; }
    ss2 += xor32(ss2);
    const float r2 = rsqrtf(ss2 * (1.f / 96.f) + EPS);
    const float* gq = p.mla_q_g + layer * 96;
#pragma unroll
    for (int nt = 0; nt < 3; ++nt)
#pragma unroll
      for (int g = 0; g < 4; ++g) {
        float4 gg = *(const float4*)(gq + nt * 32 + 8 * g + 4 * h);
        acc[nt][4 * g] *= r2 * gg.x; acc[nt][4 * g + 1] *= r2 * gg.y; acc[nt][4 * g + 2] *= r2 * gg.z; acc[nt][4 * g + 3] *= r2 * gg.w;
      }
#pragma unroll
    for (int reg = 0; reg < 8; ++reg) {
      float x1 = acc[2][reg], x2 = acc[2][reg + 8];
      acc[2][reg] = x1 * cs[reg] - x2 * sn[reg];
      acc[2][reg + 8] = x2 * cs[reg] + x1 * sn[reg];
    }
    u16* qo = QB + ((size_t)(b * 8 + hd) * 4096 + s) * 96;
#pragma unroll
    for (int nt = 0; nt < 3; ++nt)
#pragma unroll
      for (int g = 0; g < 4; ++g)
        *(uint2*)(qo + nt * 32 + 8 * g + 4 * h) = make_uint2(pack2(acc[nt][4 * g] * C_MLA, acc[nt][4 * g + 1] * C_MLA), pack2(acc[nt][4 * g + 2] * C_MLA, acc[nt][4 * g + 3] * C_MLA));
  }
  __syncthreads();
  {
    const u16* src = WUKV + (size_t)(hd * 128) * 128;
#pragma unroll
    for (int i = 0; i < 8; ++i) {
      const int idx = tid + 256 * i, row = idx >> 4, c = idx & 15;
      *(uint4*)&sWk[row][c * 8] = *(const uint4*)(src + (size_t)row * 128 + c * 8);
    }
  }
  __syncthreads();
  {
    bf16x8 bk[8];
    float ss = 0.f;
#pragma unroll
    for (int ks = 0; ks < 8; ++ks) {
      uint4 u = *(const uint4*)(prow + O_CKV + ks * 16 + 8 * h);
      bk[ks] = __builtin_bit_cast(bf16x8, u);
      float f;
      f = bflo(u.x); ss += f * f; f = bfhi(u.x); ss += f * f; f = bflo(u.y); ss += f * f; f = bfhi(u.y); ss += f * f;
      f = bflo(u.z); ss += f * f; f = bfhi(u.z); ss += f * f; f = bflo(u.w); ss += f * f; f = bfhi(u.w); ss += f * f;
    }
    ss += xor32(ss);
    const float rkv = rsqrtf(ss * (1.f / 128.f) + EPS);
    f32x16 acc[4];
    acc[0] = zero16(); acc[1] = zero16(); acc[2] = zero16(); acc[3] = zero16();

#pragma unroll
    for (int ks = 0; ks < 8; ++ks) {
#pragma unroll
      for (int nt = 0; nt < 4; ++nt) {
        bf16x8 a = *(const bf16x8*)&sWk[nt * 32 + r][ks * 16 + 8 * h];
        acc[nt] = MFMA32(a, bk[ks], acc[nt]);
      }
    }
    float kpe[16];
#pragma unroll
    for (int g = 0; g < 4; ++g) {
      uint2 u = *(const uint2*)(prow + O_KPE + 8 * g + 4 * h);
      kpe[4 * g] = bflo(u.x); kpe[4 * g + 1] = bfhi(u.x); kpe[4 * g + 2] = bflo(u.y); kpe[4 * g + 3] = bfhi(u.y);
    }
    float ss2 = 0.f;
#pragma unroll
    for (int nt = 0; nt < 4; ++nt)
#pragma unroll
      for (int i = 0; i < 16; ++i) acc[nt][i] *= rkv;
#pragma unroll
    for (int i = 0; i < 16; ++i) ss2 += acc[0][i] * acc[0][i] + acc[1][i] * acc[1][i] + kpe[i] * kpe[i];
    ss2 += xor32(ss2);
    const float r2 = rsqrtf(ss2 * (1.f / 96.f) + EPS);
    const float* gk = p.mla_k_g + layer * 96;
#pragma unroll
    for (int g = 0; g < 4; ++g) {
      float4 g0 = *(const float4*)(gk + 8 * g + 4 * h);
      float4 g1 = *(const float4*)(gk + 32 + 8 * g + 4 * h);
      float4 g2 = *(const float4*)(gk + 64 + 8 * g + 4 * h);
      acc[0][4 * g] *= r2 * g0.x; acc[0][4 * g + 1] *= r2 * g0.y; acc[0][4 * g + 2] *= r2 * g0.z; acc[0][4 * g + 3] *= r2 * g0.w;
      acc[1][4 * g] *= r2 * g1.x; acc[1][4 * g + 1] *= r2 * g1.y; acc[1][4 * g + 2] *= r2 * g1.z; acc[1][4 * g + 3] *= r2 * g1.w;
      kpe[4 * g] *= r2 * g2.x; kpe[4 * g + 1] *= r2 * g2.y; kpe[4 * g + 2] *= r2 * g2.z; kpe[4 * g + 3] *= r2 * g2.w;
    }
#pragma unroll
    for (int reg = 0; reg < 8; ++reg) {
      float x1 = kpe[reg], x2 = kpe[reg + 8];
      kpe[reg] = x1 * cs[reg] - x2 * sn[reg];
      kpe[reg + 8] = x2 * cs[reg] + x1 * sn[reg];
    }
    u16* ko = KB + ((size_t)(b * 8 + hd) * 4096 + s) * 96;
#pragma unroll
    for (int g = 0; g < 4; ++g) {
      *(uint2*)(ko + 8 * g + 4 * h) = make_uint2(pack2(acc[0][4 * g], acc[0][4 * g + 1]), pack2(acc[0][4 * g + 2], acc[0][4 * g + 3]));
      *(uint2*)(ko + 32 + 8 * g + 4 * h) = make_uint2(pack2(acc[1][4 * g], acc[1][4 * g + 1]), pack2(acc[1][4 * g + 2], acc[1][4 * g + 3]));
      *(uint2*)(ko + 64 + 8 * g + 4 * h) = make_uint2(pack2(kpe[4 * g], kpe[4 * g + 1]), pack2(kpe[4 * g + 2], kpe[4 * g + 3]));
    }
#pragma unroll
    for (int nt = 2; nt < 4; ++nt)
#pragma unroll
      for (int i = 0; i < 16; ++i) {
        const int d = (nt - 2) * 32 + crow(i, h);
        VTB[((size_t)((b * 8 + hd) * 64 + d)) * 4096 + s] = f2bf(acc[nt][i]);
      }
  }
  __syncthreads();
  {
    const u16* qp = prow + O_DSQ + hd * 64 + 32 * h;
    u16* qo = (u16*)(p.ws + WS_DSQ) + ((size_t)token * 8 + hd) * 64 + 32 * h;
    uint4 u[4];
    float f[32];
    float ss = 0.f;
#pragma unroll
    for (int i = 0; i < 4; ++i) {
      u[i] = *(const uint4*)(qp + 8 * i);
      f[8 * i] = bflo(u[i].x); f[8 * i + 1] = bfhi(u[i].x); f[8 * i + 2] = bflo(u[i].y); f[8 * i + 3] = bfhi(u[i].y);
      f[8 * i + 4] = bflo(u[i].z); f[8 * i + 5] = bfhi(u[i].z); f[8 * i + 6] = bflo(u[i].w); f[8 * i + 7] = bfhi(u[i].w);
    }
#pragma unroll
    for (int i = 0; i < 32; ++i) ss += f[i] * f[i];
    ss += xor32(ss);
    const float rr = rsqrtf(ss * (1.f / 64.f) + EPS) * C_SB;
    const float* gq = p.dsa_q_g + layer * 64 + 32 * h;
#pragma unroll
    for (int i = 0; i < 4; ++i) {
      float4 ga = *(const float4*)(gq + 8 * i), gb = *(const float4*)(gq + 8 * i + 4);
      *(uint4*)(qo + 8 * i) = make_uint4(pack2(f[8 * i] * rr * ga.x, f[8 * i + 1] * rr * ga.y), pack2(f[8 * i + 2] * rr * ga.z, f[8 * i + 3] * rr * ga.w),
                                         pack2(f[8 * i + 4] * rr * gb.x, f[8 * i + 5] * rr * gb.y), pack2(f[8 * i + 6] * rr * gb.z, f[8 * i + 7] * rr * gb.w));
    }
  }
  if (hd == 1) {
    int pm = p.pos[token];
#pragma unroll
    for (int off = 1; off < 32; off <<= 1) { const int o = __shfl_xor(pm, off); pm = pm > o ? pm : o; }
    if (lane == 0) ((int*)(p.ws + WS_PMAX))[tg] = pm;
  }
  if (hd == 0) {
    const u16* kp = prow + O_DSK + 32 * h;
    u16* ko2 = (u16*)(p.ws + WS_DSK) + (size_t)token * 64 + 32 * h;
    float f[32];
    float ss = 0.f;
#pragma unroll
    for (int i = 0; i < 4; ++i) {
      uint4 u = *(const uint4*)(kp + 8 * i);
      f[8 * i] = bflo(u.x); f[8 * i + 1] = bfhi(u.x); f[8 * i + 2] = bflo(u.y); f[8 * i + 3] = bfhi(u.y);
      f[8 * i + 4] = bflo(u.z); f[8 * i + 5] = bfhi(u.z); f[8 * i + 6] = bflo(u.w); f[8 * i + 7] = bfhi(u.w);
    }
#pragma unroll
    for (int i = 0; i < 32; ++i) ss += f[i] * f[i];
    ss += xor32(ss);
    const float rr = rsqrtf(ss * (1.f / 64.f) + EPS);
    const float* gk = p.dsa_k_g + layer * 64 + 32 * h;
#pragma unroll
    for (int i = 0; i < 4; ++i) {
      float4 ga = *(const float4*)(gk + 8 * i), gb = *(const float4*)(gk + 8 * i + 4);
      *(uint4*)(ko2 + 8 * i) = make_uint4(pack2(f[8 * i] * rr * ga.x, f[8 * i + 1] * rr * ga.y), pack2(f[8 * i + 2] * rr * ga.z, f[8 * i + 3] * rr * ga.w),
                                         pack2(f[8 * i + 4] * rr * gb.x, f[8 * i + 5] * rr * gb.y), pack2(f[8 * i + 6] * rr * gb.z, f[8 * i + 7] * rr * gb.w));
    }
  }
}

struct SelSmem { uint32_t hist[2][4096]; uint32_t pfx[4]; uint32_t need[4]; uint32_t dcut[4]; uint32_t flag; };

template <int PASS>
DI void sel_pass(SelSmem* S, const uint32_t (&sk)[32][2], int ntiles, uint32_t (&pf)[2]) {
  const int tid = opaque_tid(), lane = tid & 63, wave = __builtin_amdgcn_readfirstlane(tid >> 6), r = lane & 31, h = lane >> 5;
  {
    uint4* hz = (uint4*)&S->hist[0][0];
#pragma unroll
    for (int i = 0; i < 8; ++i) hz[tid + 256 * i] = make_uint4(0, 0, 0, 0);
  }
  __syncthreads();
#pragma unroll
  for (int i = 0; i < 32; ++i) {
    const int tile = i * 4 + wave;
    if (tile < ntiles) {
#pragma unroll
      for (int j = 0; j < 2; ++j) {
        const uint32_t k = sk[i][j];
        bool match; uint32_t digit;
        if (PASS == 0) { match = (k != 0u); digit = k >> 20; }
        else if (PASS == 1) { match = ((k >> 20) == pf[j]); digit = (k >> 10) & 1023u; }
        else if (PASS == 2) { match = ((k >> 10) == pf[j]); digit = k & 1023u; }
        else { match = (k == pf[j]); digit = 4095u - (uint32_t)(tile * 32 + r); }
        if (match) atomicAdd(&S->hist[h][digit], j ? 0x10000u : 1u);
      }
    }
  }
  __syncthreads();
  {
    constexpr int PER = (PASS == 0 || PASS == 3) ? 64 : 16;
    const int pair = wave >> 1, sh = (wave & 1) * 16;
    const uint32_t need = S->need[wave];
    const uint32_t prevp = S->pfx[wave];
    const uint32_t* hp = &S->hist[pair][lane * PER];
    uint32_t tot = 0;
    for (int c = 0; c < PER; ++c) tot += (hp[(c + lane) & (PER - 1)] >> sh) & 0xffffu;
    uint32_t incl = tot;
#pragma unroll
    for (int off = 1; off < 64; off <<= 1) {
      uint32_t v = __shfl_down(incl, off);
      if (lane + off < 64) incl += v;
    }
    const uint32_t sfx = incl - tot;
    const bool cross = (sfx < need) && (need <= sfx + tot);
    const unsigned long long cm = __ballot(cross);
    if (cm != 0ull) {
      const int L = __builtin_ctzll(cm);
      const uint32_t cumbase = (uint32_t)__shfl((int)sfx, L);
      const uint32_t cnt = (lane < PER) ? ((S->hist[pair][L * PER + lane] >> sh) & 0xffffu) : 0u;
      uint32_t inc2 = cnt;
#pragma unroll
      for (int off = 1; off < PER; off <<= 1) {
        uint32_t v = __shfl_down(inc2, off);
        if (lane + off < 64) inc2 += v;
      }
      const uint32_t cum = cumbase + (inc2 - cnt);
      if (lane < PER && cum < need && need <= cum + cnt) {
        const uint32_t bin = (uint32_t)(L * PER + lane);
        const uint32_t nn = need - cum;
        if (PASS == 0) S->pfx[wave] = bin;
        else if (PASS == 1 || PASS == 2) S->pfx[wave] = (prevp << 10) | bin;
        else S->dcut[wave] = bin;
        if (PASS == 2 && cnt != nn) atomicOr(&S->flag, 1u);
        if (PASS == 1 && cnt != nn) atomicOr(&S->flag, 2u);
        S->need[wave] = nn;
      }
    }
  }
  __syncthreads();
  if (PASS < 3) { pf[0] = S->pfx[2 * h]; pf[1] = S->pfx[2 * h + 1]; }
}

DI void select_item(const Params& p, int item, char* smem) {
  SelSmem* S = (SelSmem*)smem;
  const u16* PROJ = (const u16*)(p.ws + WS_PROJ);
  uint32_t* BM = (uint32_t*)(p.ws + WS_BM);
  const int b = item & 3, t0 = (1023 - (item >> 2)) * 4;
  const int tokbase = b * 4096;
  const int tid = opaque_tid(), lane = tid & 63, wave = __builtin_amdgcn_readfirstlane(tid >> 6), r = lane & 31, h = lane >> 5;
  if (t0 + 3 < 256) {
    if (tid < 32) {
      const int q = tid >> 3, tile = tid & 7, t = t0 + q;
      uint32_t wd = (tile < (t >> 5)) ? 0xffffffffu : (tile == (t >> 5) ? (0xffffffffu >> (31 - (t & 31))) : 0u);
      BM[(size_t)(tokbase + t) * 128 + tile] = wd;
    }
    return;
  }
  const int ntiles = 2 * (t0 >> 6) + 2;
  if (tid < 4) { S->need[tid] = 256u; S->pfx[tid] = 0u; S->dcut[tid] = 0u; }
  if (tid == 4) S->flag = 0u;
  bf16x8 a0, a1;
  {
    const int hb = (r >> 2) & 1, idx16 = (r & 3) + 4 * (r >> 3);
    const int q = 2 * hb + (idx16 >> 3), head = idx16 & 7;
    const u16* aq = PROJ + (size_t)(tokbase + t0 + q) * LDP + O_IXQ + head * 32 + 8 * h;
    a0 = *(const bf16x8*)aq;
    a1 = *(const bf16x8*)(aq + 16);
  }
  float wv[16];
#pragma unroll
  for (int j = 0; j < 2; ++j) {
    uint4 u = *(const uint4*)(PROJ + (size_t)(tokbase + t0 + 2 * h + j) * LDP + O_IXW);
    const float c = 0.35355339059327373f * 0.17677669529663687f;
    wv[8 * j] = bflo(u.x) * c; wv[8 * j + 1] = bfhi(u.x) * c; wv[8 * j + 2] = bflo(u.y) * c; wv[8 * j + 3] = bfhi(u.y) * c;
    wv[8 * j + 4] = bflo(u.z) * c; wv[8 * j + 5] = bfhi(u.z) * c; wv[8 * j + 6] = bflo(u.w) * c; wv[8 * j + 7] = bfhi(u.w) * c;
  }
  const u16* IXK = (const u16*)(p.ws + WS_IXK) + (size_t)tokbase * 32;
  uint32_t sk[32][2];
  bf16x8 ka0[4], ka1[4], kb0[4], kb1[4];
#define SEL_LOAD(S0, S1, CC)                                                          \
  _Pragma("unroll") for (int ii = 0; ii < 4; ++ii) {                                   \
    const int key_ = ((((CC) * 4 + ii) * 4 + wave) * 32) + r;                          \
    const u16* kp_ = BIS1 ? (PROJ + (size_t)(tokbase + key_) * LDP + O_KPE + 32 + 8 * h) : (IXK + (size_t)key_ * 32 + 8 * h); \
    S0[ii] = *(const bf16x8*)kp_; S1[ii] = *(const bf16x8*)(kp_ + 16);                 \
  }
#define SEL_COMP(S0, S1, CC)                                                          \
  _Pragma("unroll") for (int ii = 0; ii < 4; ++ii) {                                   \
    const int i_ = (CC) * 4 + ii;                                                      \
    const int key_ = (i_ * 4 + wave) * 32 + r;                                         \
    f32x16 acc_ = zero16();                                                            \
    acc_ = MFMA32(a0, S0[ii], acc_);                                                   \
    acc_ = MFMA32(a1, S1[ii], acc_);                                                   \
    _Pragma("unroll") for (int j = 0; j < 2; ++j) {                                    \
      float sc_ = 0.f;                                                                 \
      _Pragma("unroll") for (int hd = 0; hd < 8; ++hd) sc_ = fmaf(wv[8 * j + hd], fmaxf(acc_[8 * j + hd], 0.f), sc_); \
      sc_ += 0.0f;                                                                     \
      const uint32_t bits_ = __float_as_uint(sc_);                                     \
      const uint32_t k32_ = bits_ ^ (((uint32_t)((int32_t)bits_ >> 31)) | 0x80000000u); \
      sk[i_][j] = (key_ <= t0 + 2 * h + j) ? k32_ : 0u;                                \
    }                                                                                  \
  }
#define SEL_ZERO(CC) _Pragma("unroll") for (int ii = 0; ii < 4; ++ii) { sk[(CC) * 4 + ii][0] = 0u; sk[(CC) * 4 + ii][1] = 0u; }
  if (wave < ntiles) { SEL_LOAD(ka0, ka1, 0) }
#pragma unroll
  for (int cc = 0; cc < 8; cc += 2) {
    if (16 * (cc + 1) + wave < ntiles) { SEL_LOAD(kb0, kb1, cc + 1) }
    if (16 * cc + wave < ntiles) { SEL_COMP(ka0, ka1, cc) } else { SEL_ZERO(cc) }
    if (cc + 2 < 8) { if (16 * (cc + 2) + wave < ntiles) { SEL_LOAD(ka0, ka1, cc + 2) } }
    if (16 * (cc + 1) + wave < ntiles) { SEL_COMP(kb0, kb1, cc + 1) } else { SEL_ZERO(cc + 1) }
  }
#undef SEL_LOAD
#undef SEL_COMP
#undef SEL_ZERO
  uint32_t pf[2] = {0u, 0u};
  sel_pass<0>(S, sk, ntiles, pf);
  sel_pass<1>(S, sk, ntiles, pf);
  if (S->flag & 2u) sel_pass<2>(S, sk, ntiles, pf);
  else { pf[0] <<= 10; pf[1] <<= 10; }
  uint32_t dc[2] = {0u, 0u};
  if (S->flag & 1u) {
    sel_pass<3>(S, sk, ntiles, pf);
    dc[0] = S->dcut[2 * h]; dc[1] = S->dcut[2 * h + 1];
  }
#pragma unroll
  for (int i = 0; i < 32; ++i) {
    const int tile = i * 4 + wave;
    if (tile < ntiles) {
      const uint32_t di = 4095u - (uint32_t)(tile * 32 + r);
#pragma unroll
      for (int j = 0; j < 2; ++j) {
        const uint32_t k = sk[i][j];
        const bool sel = (k > pf[j]) || (k == pf[j] && di >= dc[j]);
        const unsigned long long m = __ballot(sel);
        if (lane == 0) {
          BM[(size_t)(tokbase + t0 + j) * 128 + tile] = (uint32_t)m;
          BM[(size_t)(tokbase + t0 + 2 + j) * 128 + tile] = (uint32_t)(m >> 32);
        }
      }
    }
  }
  __syncthreads();
}

DI bool softmax_bound_ok(const Params& p, int layer, int mode) {
  const int lane = threadIdx.x & 63;
  const float* gq = (mode == 1) ? (p.mla_q_g + layer * 96) : (p.dsa_q_g + layer * 64);
  const float* gk = (mode == 1) ? (p.mla_k_g + layer * 96) : (p.dsa_k_g + layer * 64);
  const int ng = (mode == 1) ? 96 : 64;
  float aq = 0.f, ak = 0.f, ab = 0.f;
  for (int i = lane; i < ng; i += 64) { aq = fmaxf(aq, fabsf(gq[i])); ak = fmaxf(ak, fabsf(gk[i])); }
  if (mode == 2) { for (int i = lane; i < 256; i += 64) ab = fmaxf(ab, fabsf(p.rel_bias[i])); }
#pragma unroll
  for (int off = 1; off < 64; off <<= 1) { aq = fmaxf(aq, __shfl_xor(aq, off)); ak = fmaxf(ak, __shfl_xor(ak, off)); ab = fmaxf(ab, __shfl_xor(ab, off)); }
  const float bound = ((mode == 1) ? 9.7979590f * aq * ak : 8.f * aq * ak + 2.f * ab) * LOG2E * 1.02f;
  return __builtin_amdgcn_readfirstlane((bound < 100.f) ? 1 : 0) != 0;
}

template <int MODE, bool FAST>
DI void attn_item(const Params& p, int layer, int b, int hd, int qt, char* smem) {
  constexpr int DK = (MODE == 1) ? 96 : 64;
  constexpr int KS = DK / 16;
  constexpr int KROW = DK + 8;
  constexpr int KCH = DK / 8;
  constexpr int NKL = (64 * KCH) / 256;
  typedef u16 (*kt_t)[64][KROW];
  typedef u16 (*vt_t)[64][72];
  kt_t sK = (kt_t)smem;
  vt_t sV = (vt_t)(smem + 2 * 64 * KROW * 2);
  int* sPos = (int*)(smem + 2 * 64 * KROW * 2 + 2 * 64 * 72 * 2);
  float* sBias = (float*)(smem + 2 * 64 * KROW * 2 + 2 * 64 * 72 * 2 + 512);
  int* sWd = (int*)(smem + 2 * 64 * KROW * 2 + 2 * 64 * 72 * 2 + 512 + 4096);

  const u16* PROJ = (const u16*)(p.ws + WS_PROJ);
  u16* YBR = (u16*)(p.ws + WS_YBR);
  const uint32_t* BM = (const uint32_t*)(p.ws + WS_BM);
  const int tid = opaque_tid(), lane = tid & 63, wave = __builtin_amdgcn_readfirstlane(tid >> 6), r = lane & 31, h = lane >> 5;
  const int tokbase = b * 4096;

  int tq, hdl, wmin, wmax, nt64;
  const u16* qrow;
  const u16* kbase; size_t kstride;
  const u16* vbase;
  if (MODE == 0) {
    tq = qt * 128 + wave * 32 + r; hdl = hd; wmin = qt * 128 + wave * 32; wmax = wmin + 31; nt64 = 2 * qt + 2;
    qrow = (const u16*)(p.ws + WS_QA) + ((size_t)(b * 8 + hd) * 4096 + tq) * 64;
    kbase = (const u16*)(p.ws + WS_KA) + ((size_t)(b * 8 + hd) * 4096) * 64; kstride = 64;
    vbase = (const u16*)(p.ws + WS_VTA) + (size_t)((b * 8 + hd) * 64) * 4096;
  } else if (MODE == 1) {
    tq = qt * 128 + wave * 32 + r; hdl = hd; wmin = qt * 128 + wave * 32; wmax = wmin + 31; nt64 = 2 * qt + 2;
    qrow = (const u16*)(p.ws + WS_QB) + ((size_t)(b * 8 + hd) * 4096 + tq) * 96;
    kbase = (const u16*)(p.ws + WS_KB) + ((size_t)(b * 8 + hd) * 4096) * 96; kstride = 96;
    vbase = (const u16*)(p.ws + WS_VTB) + (size_t)((b * 8 + hd) * 64) * 4096;
  } else {
    tq = qt * 16 + wave * 4 + (r >> 3); hdl = r & 7; wmin = qt * 16 + wave * 4; wmax = wmin + 3; nt64 = (qt >> 2) + 1;
    qrow = (const u16*)(p.ws + WS_DSQ) + ((size_t)(tokbase + tq) * 8 + hdl) * 64;
    kbase = (const u16*)(p.ws + WS_DSK) + (size_t)tokbase * 64; kstride = 64;
    vbase = (const u16*)(p.ws + WS_VTC) + (size_t)(b * 64) * 4096;
  }
  int posq = 0, wposmin = 0;
  if (MODE == 2) {
    posq = p.pos[tokbase + tq];
    wposmin = posq;
#pragma unroll
    for (int off = 1; off < 64; off <<= 1) { const int o = __shfl_xor(wposmin, off); wposmin = wposmin < o ? wposmin : o; }
    wposmin = __builtin_amdgcn_readfirstlane(wposmin);
    for (int e = tid; e < 1024; e += 256) {
      const int n = e >> 3, hh = e & 7;
      int bk = n;
      if (n >= 16) {
        bk = 16 + (n >= 19) + (n >= 21) + (n >= 24) + (n >= 27) + (n >= 31) + (n >= 35) + (n >= 40) + (n >= 46) + (n >= 52) + (n >= 59) + (n >= 67) + (n >= 77) + (n >= 87) + (n >= 99) + (n >= 113);
      }
      sBias[e] = (p.rel_bias[bk * 8 + hh] - p.rel_bias[31 * 8 + hh]) * LOG2E;
    }
  }
  constexpr bool fastsm = FAST;
  bf16x8 qf[KS];
#pragma unroll
  for (int ks = 0; ks < KS; ++ks) qf[ks] = *(const bf16x8*)(qrow + ks * 16 + 8 * h);

  f32x16 o[2];
  o[0] = zero16(); o[1] = zero16();
  float carry = 1.f;
  float mrun = -INFINITY, lrun = 0.f;

  uint4 rk0, rk1, rk2 = make_uint4(0, 0, 0, 0), rv0, rv1;
  int rp = 0;
  const int krow0 = tid / KCH, kc0 = tid - krow0 * KCH;
  const int krow1 = (tid + 256) / KCH, kc1 = (tid + 256) - krow1 * KCH;
  const int krow2 = (tid + 512) / KCH, kc2 = (tid + 512) - krow2 * KCH;
  const int vd0 = tid >> 3, vc0 = tid & 7, vd1 = vd0 + 32;
#define ATT_GLOAD(KT)                                                                         \
  do {                                                                                        \
    const int key0_ = (KT) * 64;                                                              \
    rk0 = *(const uint4*)(kbase + (size_t)(key0_ + krow0) * kstride + kc0 * 8);               \
    rk1 = *(const uint4*)(kbase + (size_t)(key0_ + krow1) * kstride + kc1 * 8);               \
    if (NKL > 2) rk2 = *(const uint4*)(kbase + (size_t)(key0_ + krow2) * kstride + kc2 * 8);  \
    rv0 = *(const uint4*)(vbase + (size_t)vd0 * 4096 + key0_ + vc0 * 8);                      \
    rv1 = *(const uint4*)(vbase + (size_t)vd1 * 4096 + key0_ + vc0 * 8);                      \
    if (MODE == 2) {                                                                          \
      if (tid < 64) rp = p.pos[tokbase + key0_ + tid];                                        \
      else if (tid < 96) rp = (int)BM[(size_t)(tokbase + qt * 16 + ((tid - 64) >> 1)) * 128 + 2 * (KT) + (tid & 1)]; \
      else if (tid < 98) rp = ((const int*)(p.ws + WS_PMAX))[b * 128 + 2 * (KT) + (tid & 1)]; \
    }                                                                                         \
  } while (0)
#define ATT_SSTORE(BUF)                                                  \
  do {                                                                   \
    *(uint4*)&sK[(BUF)][krow0][kc0 * 8] = rk0;                           \
    *(uint4*)&sK[(BUF)][krow1][kc1 * 8] = rk1;                           \
    if (NKL > 2) *(uint4*)&sK[(BUF)][krow2][kc2 * 8] = rk2;              \
    *(uint4*)&sV[(BUF)][vd0][vc0 * 8] = rv0;                             \
    *(uint4*)&sV[(BUF)][vd1][vc0 * 8] = rv1;                             \
    if (MODE == 2) {                                                     \
      if (tid < 64) sPos[(BUF) * 64 + tid] = rp;                         \
      else if (tid < 98) sWd[(BUF) * 34 + (tid - 64)] = rp;              \
    }                                                                    \
  } while (0)

  ATT_GLOAD(MODE == 0 ? nt64 - 1 : 0);
  ATT_SSTORE(0);
  if (nt64 > 1) ATT_GLOAD(MODE == 0 ? nt64 - 2 : 1);
  __syncthreads();
  for (int step = 0; step < nt64; ++step) {
    const int kt = (MODE == 0) ? (nt64 - 1 - step) : step;
    const int buf = step & 1;
    const bool more = (step + 1 < nt64);
#pragma unroll
    for (int subi = 0; subi < 2; ++subi) {
      const int sub = (MODE == 0) ? (1 - subi) : subi;
      const int ks0 = kt * 64 + sub * 32;
      const bool skip = (MODE == 0) ? (ks0 >= wmax) : (ks0 > wmax);
      if (!skip) {
        uint32_t wd = 0;
        int pmaxk = 0;
        if (MODE == 2) { wd = (uint32_t)sWd[buf * 34 + (wave * 4 + (r >> 3)) * 2 + sub]; pmaxk = sWd[buf * 34 + 32 + sub]; }
        f32x16 s = zero16();
#pragma unroll
        for (int ks = 0; ks < KS; ++ks) {
          bf16x8 a = *(const bf16x8*)&sK[buf][sub * 32 + r][ks * 16 + 8 * h];
          s = MFMA32(a, qf[ks], s);
        }
        float pv[16];
        if (MODE == 0) {
          const bool needmask = (ks0 + 31 >= wmin);
          float e[16];
#pragma unroll
          for (int i = 0; i < 16; ++i) e[i] = frcp(1.f + fexp2(s[i]));
          if (needmask) {
#pragma unroll
            for (int i = 0; i < 16; ++i) e[i] = ((ks0 + crow(i, h)) < tq) ? e[i] : 1.f;
          }
          float tot[4], pr[4], sel[4];
#pragma unroll
          for (int g = 0; g < 4; ++g) tot[g] = (e[4 * g + 3] * e[4 * g + 2]) * (e[4 * g + 1] * e[4 * g]);
#pragma unroll
          for (int g = 0; g < 4; ++g) {
            unsigned uu = __float_as_uint(tot[g]);
            auto rr = __builtin_amdgcn_permlane32_swap(uu, uu, false, false);
            const float r0 = __uint_as_float(rr[0]), r1 = __uint_as_float(rr[1]);
            pr[g] = r0 * r1;
            sel[g] = h ? 1.f : r1;
          }
          float R[4];
          R[3] = carry; R[2] = R[3] * pr[3]; R[1] = R[2] * pr[2]; R[0] = R[1] * pr[1];
          carry = R[0] * pr[0];
#pragma unroll
          for (int g = 0; g < 4; ++g) {
            const float p4 = R[g] * sel[g];
            const float p3 = p4 * e[4 * g + 3];
            const float p2 = p3 * e[4 * g + 2];
            const float p1 = p2 * e[4 * g + 1];
            const float p0 = p1 * e[4 * g];
            pv[4 * g + 3] = p4 - p3; pv[4 * g + 2] = p3 - p2; pv[4 * g + 1] = p2 - p1; pv[4 * g] = p1 - p0;
          }
        } else {
          float u[16];
          if (MODE == 1) {
            const bool needmask = (ks0 + 31 > wmin);
#pragma unroll
            for (int i = 0; i < 16; ++i) u[i] = s[i];
            if (needmask) {
              asm volatile("" ::: "memory");
#pragma unroll
              for (int i = 0; i < 16; ++i) { if ((ks0 + crow(i, h)) > tq) u[i] = -INFINITY; }
            }
          } else if (wposmin - pmaxk >= 113) {
#pragma unroll
            for (int i = 0; i < 16; ++i) u[i] = ((wd >> crow(i, h)) & 1u) ? s[i] : -INFINITY;
          } else {
#pragma unroll
            for (int i = 0; i < 16; ++i) {
              const int kk = crow(i, h);
              const int pk = sPos[buf * 64 + sub * 32 + kk];
              int dist = posq - pk;
              dist = dist < 0 ? 0 : (dist > 127 ? 127 : dist);
              const float bias = sBias[dist * 8 + hdl];
              const float negm = ((wd >> kk) & 1u) ? 0.f : -INFINITY;
              u[i] = (s[i] + bias) + negm;
            }
          }
          if (fastsm) {
            float ls = 0.f;
#pragma unroll
            for (int i = 0; i < 16; ++i) { pv[i] = fexp2(u[i]); ls += pv[i]; }
            lrun += ls;
          } else {
          float mx = u[0];
#pragma unroll
          for (int i = 1; i < 16; ++i) mx = fmaxf(mx, u[i]);
          mx = xmax32(mx);
          const float mnew = fmaxf(mrun, mx);
          const float muse = (mnew == -INFINITY) ? 0.f : mnew;
          const float alpha = fexp2(mrun - muse);
          float ls = 0.f;
#pragma unroll
          for (int i = 0; i < 16; ++i) { pv[i] = fexp2(u[i] - muse); ls += pv[i]; }
          lrun = lrun * alpha + ls;
          mrun = mnew;
          if (__any(alpha != 1.f)) {
#pragma unroll
            for (int i = 0; i < 16; ++i) { o[0][i] *= alpha; o[1][i] *= alpha; }
          }
          }
        }
#pragma unroll
        for (int sidx = 0; sidx < 2; ++sidx) {
          uint4 pk4 = make_uint4(pack2(pv[8 * sidx], pv[8 * sidx + 1]), pack2(pv[8 * sidx + 2], pv[8 * sidx + 3]),
                                 pack2(pv[8 * sidx + 4], pv[8 * sidx + 5]), pack2(pv[8 * sidx + 6], pv[8 * sidx + 7]));
          bf16x8 pf = __builtin_bit_cast(bf16x8, pk4);
#pragma unroll
          for (int dt = 0; dt < 2; ++dt) {
            const u16* vp = &sV[buf][dt * 32 + r][sub * 32 + 16 * sidx + 4 * h];
            uint2 lo = *(const uint2*)vp;
            uint2 hi = *(const uint2*)(vp + 8);
            bf16x8 va = __builtin_bit_cast(bf16x8, make_uint4(lo.x, lo.y, hi.x, hi.y));
            o[dt] = MFMA32(va, pf, o[dt]);
          }
        }
      }
    }
    if (more) ATT_SSTORE(buf ^ 1);
    if (step + 2 < nt64) ATT_GLOAD((MODE == 0) ? kt - 2 : kt + 2);
    if (MODE == 0) {
      const int alive = __any(carry >= 5.42101086e-20f) ? 1 : 0;
      if (!__syncthreads_or(alive)) break;
    } else {
      __syncthreads();
    }
  }
  float inv = 1.f;
  if (MODE != 0) { const float lt = xsum32(lrun); inv = 1.f / lt; }
  const size_t tok = (size_t)(tokbase + tq);
  const u16* zrow = PROJ + tok * LDP + O_ZA + MODE * 512 + hdl * 64;
  u16* yrow = YBR + tok * LDY + MODE * 512 + hdl * 64;
#pragma unroll
  for (int dt = 0; dt < 2; ++dt)
#pragma unroll
    for (int g = 0; g < 4; ++g) {
      const int d4 = dt * 32 + 8 * g + 4 * h;
      uint2 zu = *(const uint2*)(zrow + d4);
      float z0 = bflo(zu.x), z1 = bfhi(zu.x), z2 = bflo(zu.y), z3 = bfhi(zu.y);
      float y0 = o[dt][4 * g] * inv, y1 = o[dt][4 * g + 1] * inv, y2 = o[dt][4 * g + 2] * inv, y3 = o[dt][4 * g + 3] * inv;
      y0 *= z0 * fsigmoid(z0); y1 *= z1 * fsigmoid(z1); y2 *= z2 * fsigmoid(z2); y3 *= z3 * fsigmoid(z3);
      *(uint2*)(yrow + d4) = make_uint2(pack2(y0, y1), pack2(y2, y3));
    }
}

DI void phase_branch(const Params& p, int layer, char* smem, int xcd, int loc, int nloc) {
  const char* wset = p.ws + WS_WT + (size_t)(layer & 1) * SZ_WSET;
  const u16* WBR = (const u16*)(wset + OFF_WT_BR);
  const u16* YBR = (const u16*)(p.ws + WS_YBR);
  const u16* PROJ = (const u16*)(p.ws + WS_PROJ);
  u16* MG = (u16*)(p.ws + WS_MERGED);
  const int tid = opaque_tid(), lane = tid & 63, wave = __builtin_amdgcn_readfirstlane(tid >> 6), r = lane & 31, h = lane >> 5;
  const int wn = wave & 1, wm = wave >> 1;
  for (int i = loc;; i += nloc) {
    int mt, nt;
    if (!tile_order<8>(i, xcd, mt, nt)) break;
    const int m0 = mt * 128, d0 = nt * 128;
    f32x16 sum[2][2];
    sum[0][0] = zero16(); sum[0][1] = zero16(); sum[1][0] = zero16(); sum[1][1] = zero16();
#pragma unroll 1
    for (int n = 0; n < 3; ++n) {
      f32x16 acc[2][2];
      acc[0][0] = zero16(); acc[0][1] = zero16(); acc[1][0] = zero16(); acc[1][1] = zero16();
      gemm128(WBR + ((size_t)n * 1024 + d0) * LDB, LDB, YBR + (size_t)m0 * LDY + n * 512, LDY, 512, acc, smem);
      const float* gb = p.gate_b + ((size_t)layer * 3 + n) * 1024;
#pragma unroll
      for (int mi = 0; mi < 2; ++mi) {
        const int m = m0 + wm * 64 + mi * 32 + r;
#pragma unroll
        for (int ni = 0; ni < 2; ++ni)
#pragma unroll
          for (int g = 0; g < 4; ++g) {
            const int d4 = d0 + wn * 64 + ni * 32 + 8 * g + 4 * h;
            uint2 gu = *(const uint2*)(PROJ + (size_t)m * LDP + O_G + n * 1024 + d4);
            float4 bb = *(const float4*)(gb + d4);
            float g0 = bflo(gu.x) + bb.x, g1 = bfhi(gu.x) + bb.y, g2 = bflo(gu.y) + bb.z, g3 = bfhi(gu.y) + bb.w;
            sum[ni][mi][4 * g] += acc[ni][mi][4 * g] * fsigmoid(g0);
            sum[ni][mi][4 * g + 1] += acc[ni][mi][4 * g + 1] * fsigmoid(g1);
            sum[ni][mi][4 * g + 2] += acc[ni][mi][4 * g + 2] * fsigmoid(g2);
            sum[ni][mi][4 * g + 3] += acc[ni][mi][4 * g + 3] * fsigmoid(g3);
          }
      }
    }
#pragma unroll
    for (int mi = 0; mi < 2; ++mi) {
      const int m = m0 + wm * 64 + mi * 32 + r;
#pragma unroll
      for (int ni = 0; ni < 2; ++ni)
#pragma unroll
        for (int g = 0; g < 4; ++g) {
          const int d4 = d0 + wn * 64 + ni * 32 + 8 * g + 4 * h;
          *(uint2*)(MG + (size_t)m * LDX + d4) = make_uint2(pack2(sum[ni][mi][4 * g], sum[ni][mi][4 * g + 1]), pack2(sum[ni][mi][4 * g + 2], sum[ni][mi][4 * g + 3]));
        }
    }
  }
}

DI void phase_out(const Params& p, int layer, char* smem, int xcd, int loc, int nloc) {
  const char* wset = p.ws + WS_WT + (size_t)(layer & 1) * SZ_WSET;
  const u16* WOUT = (const u16*)(wset + OFF_WT_OUT);
  const u16* MG = (const u16*)(p.ws + WS_MERGED);
  u16* XB = (u16*)(p.ws + WS_XB);
  float* XSS = (float*)(p.ws + WS_XSS);
  const float* xin = (layer == 0) ? p.x : p.out;
  const int tid = opaque_tid(), lane = tid & 63, wave = __builtin_amdgcn_readfirstlane(tid >> 6), r = lane & 31, h = lane >> 5;
  const int wn = wave & 1, wm = wave >> 1;
  for (int i = loc;; i += nloc) {
    int mt, nt;
    if (!tile_order<8>(i, xcd, mt, nt)) break;
    const int m0 = mt * 128, n0 = nt * 128;
    f32x16 acc[2][2];
    acc[0][0] = zero16(); acc[0][1] = zero16(); acc[1][0] = zero16(); acc[1][1] = zero16();
    gemm128(WOUT + (size_t)n0 * LDX, LDX, MG + (size_t)m0 * LDX, LDX, 1024, acc, smem);
#pragma unroll
    for (int mi = 0; mi < 2; ++mi) {
      const int m = m0 + wm * 64 + mi * 32 + r;
      float ss = 0.f;
#pragma unroll
      for (int ni = 0; ni < 2; ++ni)
#pragma unroll
        for (int g = 0; g < 4; ++g) {
          const int n4 = n0 + wn * 64 + ni * 32 + 8 * g + 4 * h;
          float4 xo = *(const float4*)(xin + (size_t)m * 1024 + n4);
          xo.x += acc[ni][mi][4 * g]; xo.y += acc[ni][mi][4 * g + 1]; xo.z += acc[ni][mi][4 * g + 2]; xo.w += acc[ni][mi][4 * g + 3];
          *(float4*)(p.out + (size_t)m * 1024 + n4) = xo;
          *(uint2*)(XB + (size_t)m * LDX + n4) = make_uint2(pack2(xo.x, xo.y), pack2(xo.z, xo.w));
          ss += xo.x * xo.x + xo.y * xo.y + xo.z * xo.z + xo.w * xo.w;
        }
      ss += xor32(ss);
      if (h == 0) XSS[(size_t)m * 16 + nt * 2 + wn] = ss;
    }
  }
}

DI void phase_init(const Params& p) {
  u16* XB = (u16*)(p.ws + WS_XB);
  float* XSS = (float*)(p.ws + WS_XSS);
  const int lane = threadIdx.x & 63;
  const int gw = blockIdx.x * 4 + (threadIdx.x >> 6), nw = gridDim.x * 4;
  for (int row = gw; row < NTOK; row += nw) {
    const float* xr = p.x + (size_t)row * 1024;
    float ss = 0.f;
#pragma unroll
    for (int i = 0; i < 4; ++i) {
      float4 v = *(const float4*)(xr + i * 256 + lane * 4);
      ss += v.x * v.x + v.y * v.y + v.z * v.z + v.w * v.w;
      *(uint2*)(XB + (size_t)row * LDX + i * 256 + lane * 4) = make_uint2(pack2(v.x, v.y), pack2(v.z, v.w));
    }
#pragma unroll
    for (int off = 32; off >= 1; off >>= 1) ss += __shfl_xor(ss, off);
    if (lane < 16) XSS[(size_t)row * 16 + lane] = (lane == 0) ? ss : 0.f;
  }
  if (blockIdx.x == 0 && threadIdx.x < 64) ((int*)(p.ws + WS_CTR))[threadIdx.x] = 0;
}


#ifndef DUP_MASK
#define DUP_MASK 0
#endif
constexpr int SMEM_BYTES = 73728;
constexpr int N_PHASES = 1 + 5 * DEPTH;

__global__ void __launch_bounds__(256, 2) hybrid_megakernel(Params p, int ph_lo, int ph_hi, int do_sync) {
  __shared__ __attribute__((aligned(16))) char smem[SMEM_BYTES];
  __shared__ int s_item;
  __shared__ uint4 xb_words;
  const int tid = threadIdx.x, bid = blockIdx.x, nb = gridDim.x;
  __shared__ int s_xinfo[4];
  if (tid == 0) { xb_words = make_uint4(0u, 0u, 0u, 0u); s_xinfo[3] = 0; }
  __syncthreads();
  XcdBarrier xb = xcd_barrier_post((unsigned*)(p.ws + WS_BAR), (volatile LAS unsigned*)&xb_words);
  if (tid == 0) s_xinfo[1] = (int)xb_add((unsigned*)(p.ws + WS_BAR) + 8 * xb.x, 1u);
  int t_cls = bid & 7, t_loc = bid >> 3, t_step = (nb - (bid & 7) + 7) >> 3;
  for (int ph = ph_lo; ph < ph_hi; ++ph) {
    if (ph == 0) {
      phase_init(p);
      for (int it = bid; it < CV_TOTAL; it += nb) convert_item(p, 0, it, (float*)smem);
    } else {
      const int layer = (ph - 1) / 5, sub = (ph - 1) % 5;
      if (sub == 0) {
        phase_proj(p, layer, smem, t_cls, t_loc, t_step);
        if (DUP_MASK & 1) { __syncthreads(); phase_proj(p, layer, smem, t_cls, t_loc, t_step); }
        if (DUP_MASK & 16) { __syncthreads(); phase_proj_probe(p, layer, smem, t_cls, t_loc, t_step); }
      } else if (sub == 1) {
        const int ncv = (layer + 1 < DEPTH) ? CV_TOTAL : 0;
        const int total = 4096 + 1024 + ncv;
        for (int rep = 0; rep < ((DUP_MASK & 4) ? 2 : 1); ++rep)
        for (int it = bid; it < total; it += nb) {
          if (it < 4096) select_item(p, it, smem);
          else if (it < 5120) prep_item(p, layer, it - 4096, smem);
          else convert_item(p, layer + 1, it - 5120, (float*)smem);
        }
      } else if (sub == 2) {
        const bool fast1 = softmax_bound_ok(p, layer, 1), fast2 = softmax_bound_ok(p, layer, 2);
        const bool xq = (s_xinfo[3] == 8);
        int* ctr = (int*)(p.ws + WS_CTR) + (xq ? (16 + layer * 8 + t_cls) : layer);
        const int limit = xq ? 384 : 3072;
        while (true) {
          if (tid == 0) s_item = atomicAdd(ctr, 1);
          __syncthreads();
          const int w = s_item;
          __syncthreads();
          if (w >= limit) break;
          int type, b, hd, d, jt;
          if (xq) {
            const int level = w / 12, within = w - level * 12;
            d = 31 - level;
            type = within >> 2;
            const int pr = 4 * t_cls + (within & 3);
            b = (type == 2) ? (t_cls >> 1) : (pr >> 3);
            hd = pr & 7;
            jt = d * 8 + 2 * (within & 3) + (t_cls & 1);
          } else {
            d = 31 - w / 96;
            const int within = w % 96, idx = within & 31;
            type = within >> 5; b = idx >> 3; hd = idx & 7; jt = d * 8 + (idx & 7);
          }
          if (type == 0) attn_item<0, false>(p, layer, b, hd, d, smem);
          else if (type == 1) { if (fast1) attn_item<1, true>(p, layer, b, hd, d, smem); else attn_item<1, false>(p, layer, b, hd, d, smem); }
          else { if (fast2) attn_item<2, true>(p, layer, b, 0, jt, smem); else attn_item<2, false>(p, layer, b, 0, jt, smem); }
        }
      } else if (sub == 3) {
        phase_branch(p, layer, smem, t_cls, t_loc, t_step);
        if (DUP_MASK & 8) { __syncthreads(); phase_branch(p, layer, smem, t_cls, t_loc, t_step); }
      } else {
        phase_out(p, layer, smem, t_cls, t_loc, t_step);
      }
    }
    if (do_sync == 2) cg::this_grid().sync();
    if (do_sync && ph + 1 < ph_hi) {
      xcd_barrier(xb);
      if (ph == ph_lo) {
        if (tid == 0) {
          unsigned* bar = (unsigned*)(p.ws + WS_BAR);
          int xi = 0;
          for (unsigned j = 0; j < xb.x; ++j) xi += (xb_ld(&bar[XB_XCNT(j)]) > 0u) ? 1 : 0;
          s_xinfo[0] = xi; s_xinfo[2] = (int)xb_words.x; s_xinfo[3] = (int)xb_words.y;
        }
        __syncthreads();
        if (s_xinfo[3] == 8) { t_cls = s_xinfo[0]; t_loc = s_xinfo[1]; t_step = s_xinfo[2]; }
      }
    }
  }
}

#ifndef MK_MULTI
#define MK_MULTI 0
#endif

extern "C" void kernel_launch(void* const* d_in, const int* in_sizes, int n_in, void* d_out, int out_size, void* d_ws,
                              size_t ws_size, hipStream_t stream) {
  (void)in_sizes; (void)n_in; (void)out_size;
  if (ws_size < WS_TOTAL) { fprintf(stderr, "workspace too small: %zu < %zu\n", ws_size, (size_t)WS_TOTAL); return; }
  Params p{};
  p.x = (const float*)d_in[0]; p.pos = (const int*)d_in[1]; p.norm_g = (const float*)d_in[2]; p.w_in = (const float*)d_in[3];
  p.qn_g = (const float*)d_in[4]; p.kvn_g = (const float*)d_in[5]; p.w_uq = (const float*)d_in[6]; p.w_ukv = (const float*)d_in[7];
  p.mla_q_g = (const float*)d_in[8]; p.mla_k_g = (const float*)d_in[9]; p.dsa_q_g = (const float*)d_in[10]; p.dsa_k_g = (const float*)d_in[11];
  p.rel_bias = (const float*)d_in[12]; p.gate_b = (const float*)d_in[13]; p.w_branch = (const float*)d_in[14]; p.w_out = (const float*)d_in[15];
  p.out = (float*)d_out; p.ws = (char*)d_ws;
  static int grid_blocks = 0;
  if (!grid_blocks) {
    int dev = 0, cus = 0, per_cu = 0;
    hipGetDevice(&dev);
    hipDeviceGetAttribute(&cus, hipDeviceAttributeMultiprocessorCount, dev);
    hipOccupancyMaxActiveBlocksPerMultiprocessor(&per_cu, hybrid_megakernel, 256, 0);
    if (per_cu > 2) per_cu = 2;
    grid_blocks = cus * per_cu;
    if (grid_blocks < 8) grid_blocks = 8;
  }
#if MK_MULTI
  for (int ph = 0; ph < N_PHASES; ++ph) {
    hipLaunchKernelGGL(hybrid_megakernel, dim3(grid_blocks), dim3(256), 0, stream, p, ph, ph + 1, 0);
  }
#else
  hipMemsetAsync((char*)d_ws + WS_BAR, 0, 32768, stream);
  int lo = 0, hi = N_PHASES, sy = 1;
  void* args[] = {&p, &lo, &hi, &sy};
  hipError_t e = hipLaunchCooperativeKernel((void*)hybrid_megakernel, dim3(grid_blocks), dim3(256), args, 0, stream);
  if (e != hipSuccess) fprintf(stderr, "cooperative launch failed: %s (grid %d)\n", hipGetErrorString(e), grid_blocks);
#endif
}
```

```cpp
#include <hip/hip_runtime.h>
#include <hip/hip_cooperative_groups.h>
#include <stdint.h>
#include <stdio.h>
namespace cg = cooperative_groups;

typedef unsigned short u16;
typedef __attribute__((ext_vector_type(8))) short bf16x8;
typedef __attribute__((ext_vector_type(16))) float f32x16;
typedef __attribute__((ext_vector_type(2))) float f2_t;
typedef __attribute__((ext_vector_type(2))) __bf16 bf2_t;

#define DI __device__ __forceinline__
#ifndef STAGE_LDS
#define STAGE_LDS 1
#endif
#ifndef BIS1
#define BIS1 0
#endif
#ifndef SEL_NOGUARD
#define SEL_NOGUARD 0
#endif
#define MFMA32(a, b, c) __builtin_amdgcn_mfma_f32_32x32x16_bf16((a), (b), (c), 0, 0, 0)

constexpr int SEQ = 4096, NTOK = 16384, DEPTH = 4;
constexpr int D_IN = 7496, NP = 7552;
constexpr int N_DSV = 2496, N_KPEIXK = 2816;
constexpr int LDP = 6016;
constexpr int LDX = 1088, LDB = 576, LDY = 1600;
constexpr int O_CQ = 0, O_CKV = 256, O_DSQ = 384, O_DSK = 896, O_IXQ = 1024, O_KPE = 1280, O_ZA = 1344, O_G = 2880, O_IXW = 5952;
constexpr float LOG2E = 1.4426950408889634f;
constexpr float C_SB = 0.125f * LOG2E;
constexpr float C_MLA = 0.10206207261596577f * LOG2E;
constexpr float EPS = 1e-6f;

constexpr size_t SZ_WT_IN = (size_t)NP * LDX * 2, SZ_WT_UQ = 768 * 256 * 2, SZ_WT_UKV = 1024 * 128 * 2,
                 SZ_WT_BR = 3 * 1024 * LDB * 2, SZ_WT_OUT = 1024 * LDX * 2;
constexpr size_t OFF_WT_UQ = SZ_WT_IN, OFF_WT_UKV = OFF_WT_UQ + SZ_WT_UQ, OFF_WT_BR = OFF_WT_UKV + SZ_WT_UKV,
                 OFF_WT_OUT = OFF_WT_BR + SZ_WT_BR, SZ_WSET = OFF_WT_OUT + SZ_WT_OUT;
constexpr size_t WS_WT = 0;
constexpr size_t WS_XB = WS_WT + 2 * SZ_WSET;
constexpr size_t WS_XSS = WS_XB + (size_t)NTOK * LDX * 2;
constexpr size_t WS_PROJ = WS_XSS + (size_t)NTOK * 16 * 4;
constexpr size_t WS_QB = WS_PROJ + (size_t)NTOK * LDP * 2;
constexpr size_t WS_KB = WS_QB + (size_t)NTOK * 768 * 2;
constexpr size_t WS_VTA = WS_KB + (size_t)NTOK * 768 * 2;
constexpr size_t WS_VTB = WS_VTA + (size_t)NTOK * 512 * 2;
constexpr size_t WS_VTC = WS_VTB + (size_t)NTOK * 512 * 2;
constexpr size_t WS_YBR = WS_VTC + (size_t)NTOK * 64 * 2;
constexpr size_t WS_BM = WS_YBR + (size_t)NTOK * LDY * 2;
constexpr size_t WS_QA = WS_BM + (size_t)NTOK * 128 * 4;
constexpr size_t WS_KA = WS_QA + (size_t)NTOK * 512 * 2;
constexpr size_t WS_DSQ = WS_KA + (size_t)NTOK * 512 * 2;
constexpr size_t WS_DSK = WS_DSQ + (size_t)NTOK * 512 * 2;
constexpr size_t WS_IXK = WS_DSK + (size_t)NTOK * 64 * 2;
constexpr size_t WS_CTR = WS_IXK + (size_t)NTOK * 32 * 2;
constexpr size_t WS_BAR = WS_CTR + 256;
constexpr size_t WS_PMAX = WS_BAR + 32768;
constexpr size_t WS_TOTAL = WS_PMAX + 4096;
constexpr size_t WS_MERGED = WS_QB;

struct Params {
  const float* x; const int* pos; const float* norm_g; const float* w_in; const float* qn_g; const float* kvn_g;
  const float* w_uq; const float* w_ukv; const float* mla_q_g; const float* mla_k_g; const float* dsa_q_g;
  const float* dsa_k_g; const float* rel_bias; const float* gate_b; const float* w_branch; const float* w_out;
  float* out; char* ws;
};

DI uint32_t pack2(float a, float b) { f2_t v = {a, b}; bf2_t r = __builtin_convertvector(v, bf2_t); return __builtin_bit_cast(uint32_t, r); }
DI float bflo(uint32_t u) { return __uint_as_float(u << 16); }
DI float bfhi(uint32_t u) { return __uint_as_float(u & 0xffff0000u); }
DI float bf1(u16 u) { return __uint_as_float(((uint32_t)u) << 16); }
DI u16 f2bf(float x) { return (u16)(pack2(x, 0.f) & 0xffffu); }
DI float xor32(float v) { return __shfl_xor(v, 32); }
DI float xsum32(float v) { unsigned u = __float_as_uint(v); auto r = __builtin_amdgcn_permlane32_swap(u, u, false, false); return __uint_as_float(r[0]) + __uint_as_float(r[1]); }
DI float xmax32(float v) { unsigned u = __float_as_uint(v); auto r = __builtin_amdgcn_permlane32_swap(u, u, false, false); return fmaxf(__uint_as_float(r[0]), __uint_as_float(r[1])); }
DI int crow(int reg, int h) { return (reg & 3) + 8 * (reg >> 2) + 4 * h; }
DI float fexp2(float x) { return __builtin_amdgcn_exp2f(x); }
DI float frcp(float x) { return __builtin_amdgcn_rcpf(x); }
DI int opaque_tid() { int t = threadIdx.x; asm volatile("" : "+v"(t)); return t; }
DI float fsigmoid(float x) { return frcp(1.f + fexp2(-LOG2E * x)); }
DI f32x16 zero16() { f32x16 z; _Pragma("unroll") for (int i = 0; i < 16; ++i) z[i] = 0.f; return z; }

#define XB_TMO      128
#define XB_XCNT(j)  (256  + 64 * (j))
#define XB_XSUB(j)  (1280 + 64 * (j))
#define XB_XGEN(j)  (2304 + 64 * (j))
#define XB_TOP      3328
#define XB_TOPGEN   3392
#define XCD_BAR_WORDS 3456
#define XB_SPIN_CAP (1u << 22)
#define LAS __attribute__((address_space(3)))
DI unsigned xb_ld(unsigned* p) { return __hip_atomic_load(p, __ATOMIC_RELAXED, __HIP_MEMORY_SCOPE_AGENT); }
DI unsigned xb_add(unsigned* p, unsigned v) { return __hip_atomic_fetch_add(p, v, __ATOMIC_RELAXED, __HIP_MEMORY_SCOPE_AGENT); }
DI unsigned xb_xcc_id() { return (unsigned)__builtin_amdgcn_s_getreg((3 << 11) | 20) & 0xFu; }
#define XB_SPIN(cond, bar) do { unsigned _sp = 0; while (cond) { __builtin_amdgcn_s_sleep(1); \
    if ((++_sp & 255u) == 0u) { if (xb_ld(&(bar)[XB_TMO])) break; if (_sp > XB_SPIN_CAP) { atomicAdd(&(bar)[XB_TMO], 1u); break; } } } } while (0)
struct XcdBarrier { unsigned* bar; unsigned x; volatile LAS unsigned* st; };
DI XcdBarrier xcd_barrier_post(unsigned* bar, volatile LAS unsigned* st) {
  XcdBarrier b; b.bar = bar; b.x = xb_xcc_id(); b.st = st;
  if (threadIdx.x == 0) (void)xb_add(&bar[XB_XCNT(b.x)], 1u);
  return b;
}
DI void xcd_barrier_complete(unsigned* bar, unsigned x, unsigned& nloc, unsigned& nx) {
  const unsigned G = gridDim.x * gridDim.y * gridDim.z;
  unsigned sum, cnt, mine, sp = 0u;
  for (;;) {
    sum = 0u; cnt = 0u; mine = 0u;
#pragma unroll
    for (unsigned j = 0; j < 16; ++j) { const unsigned c = xb_ld(&bar[XB_XCNT(j)]); sum += c; cnt += (c > 0u) ? 1u : 0u; mine = (j == x) ? c : mine; }
    if (sum == G) break;
    __builtin_amdgcn_s_sleep(1);
    if ((++sp & 255u) == 0u) { if (xb_ld(&bar[XB_TMO])) break; if (sp > XB_SPIN_CAP) { atomicAdd(&bar[XB_TMO], 1u); break; } }
  }
  nloc = mine > 0u ? mine : 1u; nx = cnt > 0u ? cnt : 1u;
}
DI void xcd_barrier(const XcdBarrier& b) {
  asm volatile("s_waitcnt vmcnt(0)" ::: "memory");
  __syncthreads();
  if (threadIdx.x == 0) {
    unsigned* bar = b.bar;
    __builtin_amdgcn_s_waitcnt(0);
    unsigned nloc = b.st[0], nx = b.st[1];
    if (nloc == 0u) { xcd_barrier_complete(bar, b.x, nloc, nx); b.st[0] = nloc; b.st[1] = nx; }
    const unsigned old = xb_add(&bar[XB_XSUB(b.x)], 1u);
    const unsigned gen = old / nloc;
    if (old + 1u == (gen + 1u) * nloc) {
      __builtin_amdgcn_fence(__ATOMIC_RELEASE, "agent");
      asm volatile("s_waitcnt vmcnt(0)" ::: "memory");
      const unsigned og = xb_add(&bar[XB_TOP], 1u);
      const unsigned tg = og / nx;
      if (og + 1u == (tg + 1u) * nx) xb_add(&bar[XB_TOPGEN], 1u);
      else XB_SPIN(xb_ld(&bar[XB_TOPGEN]) == tg, bar);
      __builtin_amdgcn_fence(__ATOMIC_ACQUIRE, "agent");
      xb_add(&bar[XB_XGEN(b.x)], 1u);
      asm volatile("s_waitcnt vmcnt(0)" ::: "memory");
    } else {
      XB_SPIN(xb_ld(&bar[XB_XGEN(b.x)]) == gen, bar);
      __builtin_amdgcn_fence(__ATOMIC_ACQUIRE, "agent");
      asm volatile("s_waitcnt vmcnt(0)" ::: "memory");
    }
  }
  __syncthreads();
}

#define XB_RND(j) (3456 + 64 * (j))
DI void class_round_sync(unsigned* bar, int cls, int members) {
  __syncthreads();
  if (threadIdx.x == 0) {
    const unsigned t = xb_add(&bar[XB_RND(cls)], 1u);
    const unsigned target = (t / (unsigned)members + 1u) * (unsigned)members;
    unsigned sp = 0;
    while (xb_ld(&bar[XB_RND(cls)]) < target) { __builtin_amdgcn_s_sleep(1); if (++sp > (1u << 16)) break; }
  }
  __syncthreads();
}

DI int src_col(int n) {
  if (n < 1920) return n;
  if (n < 2816) return n + 32;
  if (n < 2848) return n - 896;
  if (n < 2880) return n;
  if (n < 7488) return n + 8;
  if (n < 7496) return n - 4608;
  return -1;
}
template <bool MAP>
DI void transpose_tile(const float* __restrict__ src, int N, int K, int Nvalid, const float* __restrict__ g,
                       u16* __restrict__ dst, int ldd, int k0, int n0, float* sT) {
  const int tid = opaque_tid();
  const int cg = (tid & 15) * 4, kq = tid >> 4;
  const int sc = MAP ? src_col(n0 + cg) : ((n0 + cg < Nvalid) ? n0 + cg : -1);
#pragma unroll
  for (int i = 0; i < 4; ++i) {
    const int kk = i * 16 + kq;
    float4 v = make_float4(0.f, 0.f, 0.f, 0.f);
    if (sc >= 0) {
      v = *(const float4*)(src + (size_t)(k0 + kk) * N + sc);
      if (g) { const float gg = g[k0 + kk]; v.x *= gg; v.y *= gg; v.z *= gg; v.w *= gg; }
    }
    float* d = sT + kk * 65 + cg;
    d[0] = v.x; d[1] = v.y; d[2] = v.z; d[3] = v.w;
  }
  __syncthreads();
  const int n = tid >> 2, kc = (tid & 3) * 16;
  uint32_t o[8];
#pragma unroll
  for (int j = 0; j < 8; ++j) o[j] = pack2(sT[(kc + 2 * j) * 65 + n], sT[(kc + 2 * j + 1) * 65 + n]);
  uint4* d = (uint4*)(dst + (size_t)(n0 + n) * ldd + k0 + kc);
  d[0] = make_uint4(o[0], o[1], o[2], o[3]);
  d[1] = make_uint4(o[4], o[5], o[6], o[7]);
  __syncthreads();
}

constexpr int CV_IN = 16 * 118, CV_UQ = 4 * 12, CV_UKV = 2 * 16, CV_BR = 3 * 8 * 16, CV_OUT = 16 * 16;
constexpr int CV_TOTAL = CV_IN + CV_UQ + CV_UKV + CV_BR + CV_OUT;

DI void convert_item(const Params& p, int layer, int item, float* sT) {
  char* wset = p.ws + WS_WT + (size_t)(layer & 1) * SZ_WSET;
  if (item < CV_IN) {
    int kt = item & 15, nt = item >> 4;
    transpose_tile<true>(p.w_in + (size_t)layer * 1024 * D_IN, D_IN, 1024, D_IN, p.norm_g + layer * 1024, (u16*)wset, LDX, kt * 64, nt * 64, sT);
    return;
  }
  item -= CV_IN;
  if (item < CV_UQ) {
    int kt = item & 3, nt = item >> 2;
    transpose_tile<false>(p.w_uq + (size_t)layer * 256 * 768, 768, 256, 768, p.qn_g + layer * 256, (u16*)(wset + OFF_WT_UQ), 256, kt * 64, nt * 64, sT);
    return;
  }
  item -= CV_UQ;
  if (item < CV_UKV) {
    int kt = item & 1, nt = item >> 1;
    transpose_tile<false>(p.w_ukv + (size_t)layer * 128 * 1024, 1024, 128, 1024, p.kvn_g + layer * 128, (u16*)(wset + OFF_WT_UKV), 128, kt * 64, nt * 64, sT);
    return;
  }
  item -= CV_UKV;
  if (item < CV_BR) {
    int br = item >> 7, rem = item & 127, kt = rem & 7, nt = rem >> 3;
    transpose_tile<false>(p.w_branch + ((size_t)layer * 3 + br) * 512 * 1024, 1024, 512, 1024, nullptr,
                   (u16*)(wset + OFF_WT_BR) + (size_t)br * 1024 * LDB, LDB, kt * 64, nt * 64, sT);
    return;
  }
  item -= CV_BR;
  {
    int kt = item & 15, nt = item >> 4;
    transpose_tile<false>(p.w_out + (size_t)layer * 1024 * 1024, 1024, 1024, 1024, nullptr, (u16*)(wset + OFF_WT_OUT), LDX, kt * 64, nt * 64, sT);
  }
}

DI void gemm128(const u16* __restrict__ W, int ldw, const u16* __restrict__ X, int ldx, int K, f32x16 (&acc)[2][2], char* smem) {
  typedef u16 (*tile_t)[128][72];
  tile_t sw = (tile_t)smem;
  tile_t sx = (tile_t)(smem + 2 * 128 * 72 * 2);
  const int tid = opaque_tid(), lane = tid & 63, wave = __builtin_amdgcn_readfirstlane(tid >> 6), r = lane & 31, h = lane >> 5;
  const int wn = wave & 1, wm = wave >> 1;
  const int lc = tid & 7, lr = tid >> 3;
  const u16* gw = W + (size_t)lr * ldw + lc * 8;
  const u16* gx = X + (size_t)lr * ldx + lc * 8;
  const u16* gw1 = gw + (size_t)32 * ldw; const u16* gw2 = gw + (size_t)64 * ldw; const u16* gw3 = gw + (size_t)96 * ldw;
  const u16* gx1 = gx + (size_t)32 * ldx; const u16* gx2 = gx + (size_t)64 * ldx; const u16* gx3 = gx + (size_t)96 * ldx;
  uint4 rw0, rw1, rw2, rw3, rx0, rx1, rx2, rx3;
#define G_LOAD(KOFF) do { rw0 = *(const uint4*)(gw + (KOFF)); rw1 = *(const uint4*)(gw1 + (KOFF)); rw2 = *(const uint4*)(gw2 + (KOFF)); rw3 = *(const uint4*)(gw3 + (KOFF)); \
                          rx0 = *(const uint4*)(gx + (KOFF)); rx1 = *(const uint4*)(gx1 + (KOFF)); rx2 = *(const uint4*)(gx2 + (KOFF)); rx3 = *(const uint4*)(gx3 + (KOFF)); } while (0)
#define G_STORE(BUF) do { *(uint4*)&sw[(BUF)][lr][lc * 8] = rw0; *(uint4*)&sw[(BUF)][lr + 32][lc * 8] = rw1; *(uint4*)&sw[(BUF)][lr + 64][lc * 8] = rw2; *(uint4*)&sw[(BUF)][lr + 96][lc * 8] = rw3; \
                          *(uint4*)&sx[(BUF)][lr][lc * 8] = rx0; *(uint4*)&sx[(BUF)][lr + 32][lc * 8] = rx1; *(uint4*)&sx[(BUF)][lr + 64][lc * 8] = rx2; *(uint4*)&sx[(BUF)][lr + 96][lc * 8] = rx3; } while (0)
  G_LOAD(0);
  G_STORE(0);
  const int nk = K >> 6;
  G_LOAD(64);
  __syncthreads();
  for (int kt = 0; kt < nk; ++kt) {
    const int buf = kt & 1;
#pragma unroll
    for (int ks = 0; ks < 4; ++ks) {
      bf16x8 a0 = *(const bf16x8*)&sw[buf][wn * 64 + r][ks * 16 + h * 8];
      bf16x8 a1 = *(const bf16x8*)&sw[buf][wn * 64 + 32 + r][ks * 16 + h * 8];
      bf16x8 b0 = *(const bf16x8*)&sx[buf][wm * 64 + r][ks * 16 + h * 8];
      bf16x8 b1 = *(const bf16x8*)&sx[buf][wm * 64 + 32 + r][ks * 16 + h * 8];
      acc[0][0] = MFMA32(a0, b0, acc[0][0]);
      acc[0][1] = MFMA32(a0, b1, acc[0][1]);
      acc[1][0] = MFMA32(a1, b0, acc[1][0]);
      acc[1][1] = MFMA32(a1, b1, acc[1][1]);
    }
    if (kt + 1 < nk) G_STORE(buf ^ 1);
    if (kt + 2 < nk) G_LOAD((kt + 2) * 64);
    __syncthreads();
  }
#undef G_LOAD
#undef G_STORE
}

template <int NT>
DI bool tile_order(int i, int xcd, int& mt, int& nt) {
  constexpr int PER = 8 * NT;
  if (i >= 2 * PER) return false;
  int mh = i / PER, j = i - mh * PER;
  int ng = j >> 6, w = j & 63;
  mt = xcd * 16 + mh * 8 + (w & 7);
  nt = ng * 8 + (w >> 3);
  return true;
}

DI void phase_proj(const Params& p, int layer, char* smem, int xcd, int loc, int nloc) {
  const u16* WT = (const u16*)(p.ws + WS_WT + (size_t)(layer & 1) * SZ_WSET);
  const u16* XB = (const u16*)(p.ws + WS_XB);
  const float* XSS = (const float*)(p.ws + WS_XSS);
  u16* PROJ = (u16*)(p.ws + WS_PROJ);
  u16* VTA = (u16*)(p.ws + WS_VTA);
  u16* VTC = (u16*)(p.ws + WS_VTC);
  const int tid = opaque_tid(), lane = tid & 63, wave = __builtin_amdgcn_readfirstlane(tid >> 6), r = lane & 31, h = lane >> 5;
  const int wn = wave & 1, wm = wave >> 1;
  for (int i = loc;; i += nloc) {
    int mt, nt;
    if (!tile_order<59>(i, xcd, mt, nt)) break;
    const int m0 = mt * 128, n0 = nt * 128;
    f32x16 acc[2][2];
    acc[0][0] = zero16(); acc[0][1] = zero16(); acc[1][0] = zero16(); acc[1][1] = zero16();
    float rinv2[2];
#pragma unroll
    for (int mi = 0; mi < 2; ++mi) {
      const float4* sp = (const float4*)(XSS + (size_t)(m0 + wm * 64 + mi * 32 + r) * 16);
      float4 q0 = sp[0], q1 = sp[1], q2 = sp[2], q3 = sp[3];
      float ss = ((q0.x + q0.y) + (q0.z + q0.w)) + ((q1.x + q1.y) + (q1.z + q1.w)) + ((q2.x + q2.y) + (q2.z + q2.w)) + ((q3.x + q3.y) + (q3.z + q3.w));
      rinv2[mi] = rsqrtf(ss * (1.f / 1024.f) + EPS);
    }
    gemm128(WT + (size_t)n0 * LDX, LDX, XB + (size_t)m0 * LDX, LDX, 1024, acc, smem);
    {
      const int nb = n0 + wn * 64;
      const int mb = m0 + wm * 64;
      const int b = mb >> 12, s0 = mb & 4095;
      u16 (*st)[72] = (u16 (*)[72])(smem + ((wave & 2) ? 55296 : 18432) + (wave & 1) * 9216);
      const bool transposed = (nb >= 1024 && nb < 1536) || (nb == N_DSV);
      const float cs = (nb < 512) ? C_SB : 1.f;
      u16* dst; size_t rstride;
      if (nb < 512) { dst = (u16*)(p.ws + WS_QA) + ((size_t)(b * 8 + (nb >> 6)) * 4096 + s0) * 64; rstride = 64; }
      else if (nb < 1024) { dst = (u16*)(p.ws + WS_KA) + ((size_t)(b * 8 + ((nb - 512) >> 6)) * 4096 + s0) * 64; rstride = 64; }
      else if (nb < 1536) { dst = VTA + ((size_t)(b * 8 + ((nb - 1024) >> 6)) * 64) * 4096 + s0; rstride = 4096; }
      else if (nb == N_DSV) { dst = VTC + ((size_t)b * 64) * 4096 + s0; rstride = 4096; }
      else { dst = PROJ + (size_t)mb * LDP + (nb - 1536); rstride = LDP; }
#pragma unroll
      for (int mi = 0; mi < 2; ++mi) {
        const int m = mb + mi * 32 + r;
        const float rinv = rinv2[mi] * cs;
#pragma unroll
        for (int ni = 0; ni < 2; ++ni) {
          if (transposed) {
#pragma unroll
            for (int i = 0; i < 16; ++i) {
              if (STAGE_LDS) st[ni * 32 + crow(i, h)][mi * 32 + r] = f2bf(acc[ni][mi][i] * rinv);
              else dst[(size_t)(ni * 32 + crow(i, h)) * rstride + mi * 32 + r] = f2bf(acc[ni][mi][i] * rinv);
            }
          } else {
#pragma unroll
            for (int g = 0; g < 4; ++g) {
              const uint2 v = make_uint2(pack2(acc[ni][mi][4 * g] * rinv, acc[ni][mi][4 * g + 1] * rinv), pack2(acc[ni][mi][4 * g + 2] * rinv, acc[ni][mi][4 * g + 3] * rinv));
              if (STAGE_LDS) *(uint2*)&st[mi * 32 + r][ni * 32 + 8 * g + 4 * h] = v;
              else {
                *(uint2*)(dst + (size_t)(mi * 32 + r) * rstride + ni * 32 + 8 * g + 4 * h) = v;
                if (nb == N_KPEIXK && ni == 1) *(uint2*)((u16*)(p.ws + WS_IXK) + (size_t)m * 32 + 8 * g + 4 * h) = v;
              }
            }
          }
        }
      }
      if (STAGE_LDS) {
        __builtin_amdgcn_wave_barrier();
        asm volatile("s_waitcnt lgkmcnt(0)" ::: "memory");
        const int rr = lane >> 3, cc = lane & 7;
#pragma unroll
        for (int it = 0; it < 8; ++it) {
          const int row = it * 8 + rr;
          uint4 v = *(const uint4*)&st[row][cc * 8];
          *(uint4*)(dst + (size_t)row * rstride + cc * 8) = v;
          if (nb == N_KPEIXK && cc >= 4) *(uint4*)((u16*)(p.ws + WS_IXK) + (size_t)(mb + row) * 32 + (cc - 4) * 8) = v;
        }
      }
    }
  }
}

DI void phase_proj_probe(const Params& p, int layer, char* smem, int xcd, int loc, int nloc) {
  const u16* WT = (const u16*)(p.ws + WS_WT + (size_t)(layer & 1) * SZ_WSET);
  const u16* XB = (const u16*)(p.ws + WS_XB);
  float tot = 0.f;
  for (int i = loc;; i += nloc) {
    int mt, nt;
    if (!tile_order<59>(i, xcd, mt, nt)) break;
    f32x16 acc[2][2];
    acc[0][0] = zero16(); acc[0][1] = zero16(); acc[1][0] = zero16(); acc[1][1] = zero16();
    gemm128(WT, LDX, XB, LDX, 1024, acc, smem);
    tot += acc[0][0][0] + acc[0][1][3] + acc[1][0][5] + acc[1][1][7];
  }
  if (tot == 12345.678f) ((float*)(p.ws + WS_CTR))[32] = tot;
}

DI void prep_item(const Params& p, int layer, int item, char* smem) {
  const char* wset = p.ws + WS_WT + (size_t)(layer & 1) * SZ_WSET;
  const u16* WUQ = (const u16*)(wset + OFF_WT_UQ);
  const u16* WUKV = (const u16*)(wset + OFF_WT_UKV);
  u16* PROJ = (u16*)(p.ws + WS_PROJ);
  u16* QB = (u16*)(p.ws + WS_QB);
  u16* KB = (u16*)(p.ws + WS_KB);
  u16* VTB = (u16*)(p.ws + WS_VTB);
  const int tid = opaque_tid(), lane = tid & 63, wave = __builtin_amdgcn_readfirstlane(tid >> 6), r = lane & 31, h = lane >> 5;
  const int tg = (item >> 3) * 4 + wave, hd = item & 7;
  const int token = tg * 32 + r, b = token >> 12, s = token & 4095;
  u16 (*sWq)[264] = (u16 (*)[264])smem;
  u16 (*sWk)[136] = (u16 (*)[136])smem;
  {
    const u16* src = WUQ + (size_t)(hd * 96) * 256;
#pragma unroll
    for (int i = 0; i < 12; ++i) {
      const int idx = tid + 256 * i, row = idx >> 5, c = idx & 31;
      *(uint4*)&sWq[row][c * 8] = *(const uint4*)(src + (size_t)row * 256 + c * 8);
    }
  }
  __syncthreads();
  u16* prow = PROJ + (size_t)token * LDP;

  const float posf = (float)p.pos[token];
  float cs[8], sn[8];
  {
    const float IF0[8] = {1.0f, 0.5623413251903491f, 0.31622776601683794f, 0.1778279410038923f, 0.01f, 0.005623413251903491f, 0.0031622776601683794f, 0.0017782794100389228f};
    const float IF1[8] = {0.1f, 0.05623413251903491f, 0.03162277660168379f, 0.01778279410038923f, 0.001f, 0.0005623413251903491f, 0.00031622776601683794f, 0.00017782794100389227f};
#pragma unroll
    for (int reg = 0; reg < 8; ++reg) {
      const float inv = h ? IF1[reg] : IF0[reg];
      const float ang = posf * inv;
      double rv = (double)ang * 0.15915494309189535;
      rv -= rint(rv);
      const float fr = (float)rv;
      sn[reg] = __builtin_amdgcn_sinf(fr);
      cs[reg] = __builtin_amdgcn_cosf(fr);
    }
  }

  {
    bf16x8 bq[16];
    float ss = 0.f;
#pragma unroll
    for (int ks = 0; ks < 16; ++ks) {
      uint4 u = *(const uint4*)(prow + O_CQ + ks * 16 + 8 * h);
      bq[ks] = __builtin_bit_cast(bf16x8, u);
      float f;
      f = bflo(u.x); ss += f * f; f = bfhi(u.x); ss += f * f; f = bflo(u.y); ss += f * f; f = bfhi(u.y); ss += f * f;
      f = bflo(u.z); ss += f * f; f = bfhi(u.z); ss += f * f; f = bflo(u.w); ss += f * f; f = bfhi(u.w); ss += f * f;
    }
    ss += xor32(ss);
    const float rq = rsqrtf(ss * (1.f / 256.f) + EPS);
    f32x16 acc[3];
    acc[0] = zero16(); acc[1] = zero16(); acc[2] = zero16();

#pragma unroll
    for (int ks = 0; ks < 16; ++ks) {
#pragma unroll
      for (int nt = 0; nt < 3; ++nt) {
        bf16x8 a = *(const bf16x8*)&sWq[nt * 32 + r][ks * 16 + 8 * h];
        acc[nt] = MFMA32(a, bq[ks], acc[nt]);
      }
    }
    float ss2 = 0.f;
#pragma unroll
    for (int nt = 0; nt < 3; ++nt)
#pragma unroll
      for (int i = 0; i < 16; ++i) { acc[nt][i] *= rq; ss2 += acc[nt][i] * acc[nt][i]; }
    ss2 += xor32(ss2);
    const float r2 = rsqrtf(ss2 * (1.f / 96.f) + EPS);
    const float* gq = p.mla_q_g + layer * 96;
#pragma unroll
    for (int nt = 0; nt < 3; ++nt)
#pragma unroll
      for (int g = 0; g < 4; ++g) {
        float4 gg = *(const float4*)(gq + nt * 32 + 8 * g + 4 * h);
        acc[nt][4 * g] *= r2 * gg.x; acc[nt][4 * g + 1] *= r2 * gg.y; acc[nt][4 * g + 2] *= r2 * gg.z; acc[nt][4 * g + 3] *= r2 * gg.w;
      }
#pragma unroll
    for (int reg = 0; reg < 8; ++reg) {
      float x1 = acc[2][reg], x2 = acc[2][reg + 8];
      acc[2][reg] = x1 * cs[reg] - x2 * sn[reg];
      acc[2][reg + 8] = x2 * cs[reg] + x1 * sn[reg];
    }
    u16* qo = QB + ((size_t)(b * 8 + hd) * 4096 + s) * 96;
#pragma unroll
    for (int nt = 0; nt < 3; ++nt)
#pragma unroll
      for (int g = 0; g < 4; ++g)
        *(uint2*)(qo + nt * 32 + 8 * g + 4 * h) = make_uint2(pack2(acc[nt][4 * g] * C_MLA, acc[nt][4 * g + 1] * C_MLA), pack2(acc[nt][4 * g + 2] * C_MLA, acc[nt][4 * g + 3] * C_MLA));
  }
  __syncthreads();
  {
    const u16* src = WUKV + (size_t)(hd * 128) * 128;
#pragma unroll
    for (int i = 0; i < 8; ++i) {
      const int idx = tid + 256 * i, row = idx >> 4, c = idx & 15;
      *(uint4*)&sWk[row][c * 8] = *(const uint4*)(src + (size_t)row * 128 + c * 8);
    }
  }
  __syncthreads();
  {
    bf16x8 bk[8];
    float ss = 0.f;
#pragma unroll
    for (int ks = 0; ks < 8; ++ks) {
      uint4 u = *(const uint4*)(prow + O_CKV + ks * 16 + 8 * h);
      bk[ks] = __builtin_bit_cast(bf16x8, u);
      float f;
      f = bflo(u.x); ss += f * f; f = bfhi(u.x); ss += f * f; f = bflo(u.y); ss += f * f; f = bfhi(u.y); ss += f * f;
      f = bflo(u.z); ss += f * f; f = bfhi(u.z); ss += f * f; f = bflo(u.w); ss += f * f; f = bfhi(u.w); ss += f * f;
    }
    ss += xor32(ss);
    const float rkv = rsqrtf(ss * (1.f / 128.f) + EPS);
    f32x16 acc[4];
    acc[0] = zero16(); acc[1] = zero16(); acc[2] = zero16(); acc[3] = zero16();

#pragma unroll
    for (int ks = 0; ks < 8; ++ks) {
#pragma unroll
      for (int nt = 0; nt < 4; ++nt) {
        bf16x8 a = *(const bf16x8*)&sWk[nt * 32 + r][ks * 16 + 8 * h];
        acc[nt] = MFMA32(a, bk[ks], acc[nt]);
      }
    }
    float kpe[16];
#pragma unroll
    for (int g = 0; g < 4; ++g) {
      uint2 u = *(const uint2*)(prow + O_KPE + 8 * g + 4 * h);
      kpe[4 * g] = bflo(u.x); kpe[4 * g + 1] = bfhi(u.x); kpe[4 * g + 2] = bflo(u.y); kpe[4 * g + 3] = bfhi(u.y);
    }
    float ss2 = 0.f;
#pragma unroll
    for (int nt = 0; nt < 4; ++nt)
#pragma unroll
      for (int i = 0; i < 16; ++i) acc[nt][i] *= rkv;
#pragma unroll
    for (int i = 0; i < 16; ++i) ss2 += acc[0][i] * acc[0][i] + acc[1][i] * acc[1][i] + kpe[i] * kpe[i];
    ss2 += xor32(ss2);
    const float r2 = rsqrtf(ss2 * (1.f / 96.f) + EPS);
    const float* gk = p.mla_k_g + layer * 96;
#pragma unroll
    for (int g = 0; g < 4; ++g) {
      float4 g0 = *(const float4*)(gk + 8 * g + 4 * h);
      float4 g1 = *(const float4*)(gk + 32 + 8 * g + 4 * h);
      float4 g2 = *(const float4*)(gk + 64 + 8 * g + 4 * h);
      acc[0][4 * g] *= r2 * g0.x; acc[0][4 * g + 1] *= r2 * g0.y; acc[0][4 * g + 2] *= r2 * g0.z; acc[0][4 * g + 3] *= r2 * g0.w;
      acc[1][4 * g] *= r2 * g1.x; acc[1][4 * g + 1] *= r2 * g1.y; acc[1][4 * g + 2] *= r2 * g1.z; acc[1][4 * g + 3] *= r2 * g1.w;
      kpe[4 * g] *= r2 * g2.x; kpe[4 * g + 1] *= r2 * g2.y; kpe[4 * g + 2] *= r2 * g2.z; kpe[4 * g + 3] *= r2 * g2.w;
    }
#pragma unroll
    for (int reg = 0; reg < 8; ++reg) {
      float x1 = kpe[reg], x2 = kpe[reg + 8];
      kpe[reg] = x1 * cs[reg] - x2 * sn[reg];
      kpe[reg + 8] = x2 * cs[reg] + x1 * sn[reg];
    }
    u16* ko = KB + ((size_t)(b * 8 + hd) * 4096 + s) * 96;
#pragma unroll
    for (int g = 0; g < 4; ++g) {
      *(uint2*)(ko + 8 * g + 4 * h) = make_uint2(pack2(acc[0][4 * g], acc[0][4 * g + 1]), pack2(acc[0][4 * g + 2], acc[0][4 * g + 3]));
      *(uint2*)(ko + 32 + 8 * g + 4 * h) = make_uint2(pack2(acc[1][4 * g], acc[1][4 * g + 1]), pack2(acc[1][4 * g + 2], acc[1][4 * g + 3]));
      *(uint2*)(ko + 64 + 8 * g + 4 * h) = make_uint2(pack2(kpe[4 * g], kpe[4 * g + 1]), pack2(kpe[4 * g + 2], kpe[4 * g + 3]));
    }
#pragma unroll
    for (int nt = 2; nt < 4; ++nt)
#pragma unroll
      for (int i = 0; i < 16; ++i) {
        const int d = (nt - 2) * 32 + crow(i, h);
        VTB[((size_t)((b * 8 + hd) * 64 + d)) * 4096 + s] = f2bf(acc[nt][i]);
      }
  }
  __syncthreads();
  {
    const u16* qp = prow + O_DSQ + hd * 64 + 32 * h;
    u16* qo = (u16*)(p.ws + WS_DSQ) + ((size_t)token * 8 + hd) * 64 + 32 * h;
    uint4 u[4];
    float f[32];
    float ss = 0.f;
#pragma unroll
    for (int i = 0; i < 4; ++i) {
      u[i] = *(const uint4*)(qp + 8 * i);
      f[8 * i] = bflo(u[i].x); f[8 * i + 1] = bfhi(u[i].x); f[8 * i + 2] = bflo(u[i].y); f[8 * i + 3] = bfhi(u[i].y);
      f[8 * i + 4] = bflo(u[i].z); f[8 * i + 5] = bfhi(u[i].z); f[8 * i + 6] = bflo(u[i].w); f[8 * i + 7] = bfhi(u[i].w);
    }
#pragma unroll
    for (int i = 0; i < 32; ++i) ss += f[i] * f[i];
    ss += xor32(ss);
    const float rr = rsqrtf(ss * (1.f / 64.f) + EPS) * C_SB;
    const float* gq = p.dsa_q_g + layer * 64 + 32 * h;
#pragma unroll
    for (int i = 0; i < 4; ++i) {
      float4 ga = *(const float4*)(gq + 8 * i), gb = *(const float4*)(gq + 8 * i + 4);
      *(uint4*)(qo + 8 * i) = make_uint4(pack2(f[8 * i] * rr * ga.x, f[8 * i + 1] * rr * ga.y), pack2(f[8 * i + 2] * rr * ga.z, f[8 * i + 3] * rr * ga.w),
                                         pack2(f[8 * i + 4] * rr * gb.x, f[8 * i + 5] * rr * gb.y), pack2(f[8 * i + 6] * rr * gb.z, f[8 * i + 7] * rr * gb.w));
    }
  }
  if (hd == 1) {
    int pm = p.pos[token];
#pragma unroll
    for (int off = 1; off < 32; off <<= 1) { const int o = __shfl_xor(pm, off); pm = pm > o ? pm : o; }
    if (lane == 0) ((int*)(p.ws + WS_PMAX))[tg] = pm;
  }
  if (hd == 0) {
    const u16* kp = prow + O_DSK + 32 * h;
    u16* ko2 = (u16*)(p.ws + WS_DSK) + (size_t)token * 64 + 32 * h;
    float f[32];
    float ss = 0.f;
#pragma unroll
    for (int i = 0; i < 4; ++i) {
      uint4 u = *(const uint4*)(kp + 8 * i);
      f[8 * i] = bflo(u.x); f[8 * i + 1] = bfhi(u.x); f[8 * i + 2] = bflo(u.y); f[8 * i + 3] = bfhi(u.y);
      f[8 * i + 4] = bflo(u.z); f[8 * i + 5] = bfhi(u.z); f[8 * i + 6] = bflo(u.w); f[8 * i + 7] = bfhi(u.w);
    }
#pragma unroll
    for (int i = 0; i < 32; ++i) ss += f[i] * f[i];
    ss += xor32(ss);
    const float rr = rsqrtf(ss * (1.f / 64.f) + EPS);
    const float* gk = p.dsa_k_g + layer * 64 + 32 * h;
#pragma unroll
    for (int i = 0; i < 4; ++i) {
      float4 ga = *(const float4*)(gk + 8 * i), gb = *(const float4*)(gk + 8 * i + 4);
      *(uint4*)(ko2 + 8 * i) = make_uint4(pack2(f[8 * i] * rr * ga.x, f[8 * i + 1] * rr * ga.y), pack2(f[8 * i + 2] * rr * ga.z, f[8 * i + 3] * rr * ga.w),
                                         pack2(f[8 * i + 4] * rr * gb.x, f[8 * i + 5] * rr * gb.y), pack2(f[8 * i + 6] * rr * gb.z, f[8 * i + 7] * rr * gb.w));
    }
  }
}

struct SelSmem { uint32_t hist[2][4096]; uint32_t pfx[4]; uint32_t need[4]; uint32_t dcut[4]; uint32_t flag; };

template <int PASS>
DI void sel_pass(SelSmem* S, const uint32_t (&sk)[32][2], int ntiles, uint32_t (&pf)[2]) {
  const int tid = opaque_tid(), lane = tid & 63, wave = __builtin_amdgcn_readfirstlane(tid >> 6), r = lane & 31, h = lane >> 5;
  {
    uint4* hz = (uint4*)&S->hist[0][0];
#pragma unroll
    for (int i = 0; i < 8; ++i) hz[tid + 256 * i] = make_uint4(0, 0, 0, 0);
  }
  __syncthreads();
#pragma unroll
  for (int i = 0; i < 32; ++i) {
    const int tile = i * 4 + wave;
    if (tile < ntiles) {
#pragma unroll
      for (int j = 0; j < 2; ++j) {
        const uint32_t k = sk[i][j];
        bool match; uint32_t digit;
        if (PASS == 0) { match = (k != 0u); digit = k >> 20; }
        else if (PASS == 1) { match = ((k >> 20) == pf[j]); digit = (k >> 10) & 1023u; }
        else if (PASS == 2) { match = ((k >> 10) == pf[j]); digit = k & 1023u; }
        else { match = (k == pf[j]); digit = 4095u - (uint32_t)(tile * 32 + r); }
        if (match) atomicAdd(&S->hist[h][digit], j ? 0x10000u : 1u);
      }
    }
  }
  __syncthreads();
  {
    constexpr int PER = (PASS == 0 || PASS == 3) ? 64 : 16;
    const int pair = wave >> 1, sh = (wave & 1) * 16;
    const uint32_t need = S->need[wave];
    const uint32_t prevp = S->pfx[wave];
    const uint32_t* hp = &S->hist[pair][lane * PER];
    uint32_t tot = 0;
    for (int c = 0; c < PER; ++c) tot += (hp[(c + lane) & (PER - 1)] >> sh) & 0xffffu;
    uint32_t incl = tot;
#pragma unroll
    for (int off = 1; off < 64; off <<= 1) {
      uint32_t v = __shfl_down(incl, off);
      if (lane + off < 64) incl += v;
    }
    const uint32_t sfx = incl - tot;
    const bool cross = (sfx < need) && (need <= sfx + tot);
    const unsigned long long cm = __ballot(cross);
    if (cm != 0ull) {
      const int L = __builtin_ctzll(cm);
      const uint32_t cumbase = (uint32_t)__shfl((int)sfx, L);
      const uint32_t cnt = (lane < PER) ? ((S->hist[pair][L * PER + lane] >> sh) & 0xffffu) : 0u;
      uint32_t inc2 = cnt;
#pragma unroll
      for (int off = 1; off < PER; off <<= 1) {
        uint32_t v = __shfl_down(inc2, off);
        if (lane + off < 64) inc2 += v;
      }
      const uint32_t cum = cumbase + (inc2 - cnt);
      if (lane < PER && cum < need && need <= cum + cnt) {
        const uint32_t bin = (uint32_t)(L * PER + lane);
        const uint32_t nn = need - cum;
        if (PASS == 0) S->pfx[wave] = bin;
        else if (PASS == 1 || PASS == 2) S->pfx[wave] = (prevp << 10) | bin;
        else S->dcut[wave] = bin;
        if (PASS == 2 && cnt != nn) atomicOr(&S->flag, 1u);
        if (PASS == 1 && cnt != nn) atomicOr(&S->flag, 2u);
        S->need[wave] = nn;
      }
    }
  }
  __syncthreads();
  if (PASS < 3) { pf[0] = S->pfx[2 * h]; pf[1] = S->pfx[2 * h + 1]; }
}

DI void select_item(const Params& p, int item, char* smem) {
  SelSmem* S = (SelSmem*)smem;
  const u16* PROJ = (const u16*)(p.ws + WS_PROJ);
  uint32_t* BM = (uint32_t*)(p.ws + WS_BM);
  const int b = item & 3, t0 = (1023 - (item >> 2)) * 4;
  const int tokbase = b * 4096;
  const int tid = opaque_tid(), lane = tid & 63, wave = __builtin_amdgcn_readfirstlane(tid >> 6), r = lane & 31, h = lane >> 5;
  if (t0 + 3 < 256) {
    if (tid < 32) {
      const int q = tid >> 3, tile = tid & 7, t = t0 + q;
      uint32_t wd = (tile < (t >> 5)) ? 0xffffffffu : (tile == (t >> 5) ? (0xffffffffu >> (31 - (t & 31))) : 0u);
      BM[(size_t)(tokbase + t) * 128 + tile] = wd;
    }
    return;
  }
  const int ntiles = 2 * (t0 >> 6) + 2;
  if (tid < 4) { S->need[tid] = 256u; S->pfx[tid] = 0u; S->dcut[tid] = 0u; }
  if (tid == 4) S->flag = 0u;
  bf16x8 a0, a1;
  {
    const int hb = (r >> 2) & 1, idx16 = (r & 3) + 4 * (r >> 3);
    const int q = 2 * hb + (idx16 >> 3), head = idx16 & 7;
    const u16* aq = PROJ + (size_t)(tokbase + t0 + q) * LDP + O_IXQ + head * 32 + 8 * h;
    a0 = *(const bf16x8*)aq;
    a1 = *(const bf16x8*)(aq + 16);
  }
  float wv[16];
#pragma unroll
  for (int j = 0; j < 2; ++j) {
    uint4 u = *(const uint4*)(PROJ + (size_t)(tokbase + t0 + 2 * h + j) * LDP + O_IXW);
    const float c = 0.35355339059327373f * 0.17677669529663687f;
    wv[8 * j] = bflo(u.x) * c; wv[8 * j + 1] = bfhi(u.x) * c; wv[8 * j + 2] = bflo(u.y) * c; wv[8 * j + 3] = bfhi(u.y) * c;
    wv[8 * j + 4] = bflo(u.z) * c; wv[8 * j + 5] = bfhi(u.z) * c; wv[8 * j + 6] = bflo(u.w) * c; wv[8 * j + 7] = bfhi(u.w) * c;
  }
  const u16* IXK = (const u16*)(p.ws + WS_IXK) + (size_t)tokbase * 32;
  uint32_t sk[32][2];
  bf16x8 ka0[4], ka1[4], kb0[4], kb1[4];
#define SEL_LOAD(S0, S1, CC)                                                          \
  _Pragma("unroll") for (int ii = 0; ii < 4; ++ii) {                                   \
    const int key_ = ((((CC) * 4 + ii) * 4 + wave) * 32) + r;                          \
    const u16* kp_ = BIS1 ? (PROJ + (size_t)(tokbase + key_) * LDP + O_KPE + 32 + 8 * h) : (IXK + (size_t)key_ * 32 + 8 * h); \
    S0[ii] = *(const bf16x8*)kp_; S1[ii] = *(const bf16x8*)(kp_ + 16);                 \
  }
#define SEL_COMP(S0, S1, CC)                                                          \
  _Pragma("unroll") for (int ii = 0; ii < 4; ++ii) {                                   \
    const int i_ = (CC) * 4 + ii;                                                      \
    const int key_ = (i_ * 4 + wave) * 32 + r;                                         \
    f32x16 acc_ = zero16();                                                            \
    acc_ = MFMA32(a0, S0[ii], acc_);                                                   \
    acc_ = MFMA32(a1, S1[ii], acc_);                                                   \
    _Pragma("unroll") for (int j = 0; j < 2; ++j) {                                    \
      float sc_ = 0.f;                                                                 \
      _Pragma("unroll") for (int hd = 0; hd < 8; ++hd) sc_ = fmaf(wv[8 * j + hd], fmaxf(acc_[8 * j + hd], 0.f), sc_); \
      sc_ += 0.0f;                                                                     \
      const uint32_t bits_ = __float_as_uint(sc_);                                     \
      const uint32_t k32_ = bits_ ^ (((uint32_t)((int32_t)bits_ >> 31)) | 0x80000000u); \
      sk[i_][j] = (key_ <= t0 + 2 * h + j) ? k32_ : 0u;                                \
    }                                                                                  \
  }
#define SEL_ZERO(CC) _Pragma("unroll") for (int ii = 0; ii < 4; ++ii) { sk[(CC) * 4 + ii][0] = 0u; sk[(CC) * 4 + ii][1] = 0u; }
  if (wave < ntiles) { SEL_LOAD(ka0, ka1, 0) }
#pragma unroll
  for (int cc = 0; cc < 8; cc += 2) {
    if (16 * (cc + 1) + wave < ntiles) { SEL_LOAD(kb0, kb1, cc + 1) }
    if (16 * cc + wave < ntiles) { SEL_COMP(ka0, ka1, cc) } else { SEL_ZERO(cc) }
    if (cc + 2 < 8) { if (16 * (cc + 2) + wave < ntiles) { SEL_LOAD(ka0, ka1, cc + 2) } }
    if (16 * (cc + 1) + wave < ntiles) { SEL_COMP(kb0, kb1, cc + 1) } else { SEL_ZERO(cc + 1) }
  }
#undef SEL_LOAD
#undef SEL_COMP
#undef SEL_ZERO
  uint32_t pf[2] = {0u, 0u};
  sel_pass<0>(S, sk, ntiles, pf);
  sel_pass<1>(S, sk, ntiles, pf);
  if (S->flag & 2u) sel_pass<2>(S, sk, ntiles, pf);
  else { pf[0] <<= 10; pf[1] <<= 10; }
  uint32_t dc[2] = {0u, 0u};
  if (S->flag & 1u) {
    sel_pass<3>(S, sk, ntiles, pf);
    dc[0] = S->dcut[2 * h]; dc[1] = S->dcut[2 * h + 1];
  }
  uint32_t* bml = &S->hist[0][0];
  const bool ties = (S->flag & 1u) != 0u;
#pragma unroll
  for (int i = 0; i < 32; ++i) {
    const int tile = i * 4 + wave;
    if (tile < ntiles) {
      const uint32_t di = 4095u - (uint32_t)(tile * 32 + r);
#pragma unroll
      for (int j = 0; j < 2; ++j) {
        const uint32_t k = sk[i][j];
        const bool sel = ties ? ((k > pf[j]) || (k == pf[j] && di >= dc[j])) : (k >= pf[j]);
        const unsigned long long m = __ballot(sel);
        if (lane == 0) { bml[j * 128 + tile] = (uint32_t)m; bml[(2 + j) * 128 + tile] = (uint32_t)(m >> 32); }
      }
    }
  }
  __syncthreads();
#pragma unroll
  for (int k2 = 0; k2 < 2; ++k2) {
    const int idx = tid + 256 * k2, q = idx >> 7, tile = idx & 127;
    if (tile < ntiles) BM[(size_t)(tokbase + t0 + q) * 128 + tile] = bml[q * 128 + tile];
  }
  __syncthreads();
}

DI bool softmax_bound_ok(const Params& p, int layer, int mode) {
  const int lane = threadIdx.x & 63;
  const float* gq = (mode == 1) ? (p.mla_q_g + layer * 96) : (p.dsa_q_g + layer * 64);
  const float* gk = (mode == 1) ? (p.mla_k_g + layer * 96) : (p.dsa_k_g + layer * 64);
  const int ng = (mode == 1) ? 96 : 64;
  float aq = 0.f, ak = 0.f, ab = 0.f;
  for (int i = lane; i < ng; i += 64) { aq = fmaxf(aq, fabsf(gq[i])); ak = fmaxf(ak, fabsf(gk[i])); }
  if (mode == 2) { for (int i = lane; i < 256; i += 64) ab = fmaxf(ab, fabsf(p.rel_bias[i])); }
#pragma unroll
  for (int off = 1; off < 64; off <<= 1) { aq = fmaxf(aq, __shfl_xor(aq, off)); ak = fmaxf(ak, __shfl_xor(ak, off)); ab = fmaxf(ab, __shfl_xor(ab, off)); }
  const float bound = ((mode == 1) ? 9.7979590f * aq * ak : 8.f * aq * ak + 2.f * ab) * LOG2E * 1.02f;
  return __builtin_amdgcn_readfirstlane((bound < 100.f) ? 1 : 0) != 0;
}

template <int MODE, bool FAST>
DI void attn_item(const Params& p, int layer, int b, int hd, int qt, char* smem) {
  constexpr int DK = (MODE == 1) ? 96 : 64;
  constexpr int KS = DK / 16;
  constexpr int KROW = DK + 8;
  constexpr int KCH = DK / 8;
  constexpr int NKL = (64 * KCH) / 256;
  typedef u16 (*kt_t)[64][KROW];
  typedef u16 (*vt_t)[64][72];
  kt_t sK = (kt_t)smem;
  vt_t sV = (vt_t)(smem + 2 * 64 * KROW * 2);
  int* sPos = (int*)(smem + 2 * 64 * KROW * 2 + 2 * 64 * 72 * 2);
  float* sBias = (float*)(smem + 2 * 64 * KROW * 2 + 2 * 64 * 72 * 2 + 512);
  int* sWd = (int*)(smem + 2 * 64 * KROW * 2 + 2 * 64 * 72 * 2 + 512 + 4096);

  const u16* PROJ = (const u16*)(p.ws + WS_PROJ);
  u16* YBR = (u16*)(p.ws + WS_YBR);
  const uint32_t* BM = (const uint32_t*)(p.ws + WS_BM);
  const int tid = opaque_tid(), lane = tid & 63, wave = __builtin_amdgcn_readfirstlane(tid >> 6), r = lane & 31, h = lane >> 5;
  const int tokbase = b * 4096;

  int tq, hdl, wmin, wmax, nt64;
  const u16* qrow;
  const u16* kbase; size_t kstride;
  const u16* vbase;
  if (MODE == 0) {
    tq = qt * 128 + wave * 32 + r; hdl = hd; wmin = qt * 128 + wave * 32; wmax = wmin + 31; nt64 = 2 * qt + 2;
    qrow = (const u16*)(p.ws + WS_QA) + ((size_t)(b * 8 + hd) * 4096 + tq) * 64;
    kbase = (const u16*)(p.ws + WS_KA) + ((size_t)(b * 8 + hd) * 4096) * 64; kstride = 64;
    vbase = (const u16*)(p.ws + WS_VTA) + (size_t)((b * 8 + hd) * 64) * 4096;
  } else if (MODE == 1) {
    tq = qt * 128 + wave * 32 + r; hdl = hd; wmin = qt * 128 + wave * 32; wmax = wmin + 31; nt64 = 2 * qt + 2;
    qrow = (const u16*)(p.ws + WS_QB) + ((size_t)(b * 8 + hd) * 4096 + tq) * 96;
    kbase = (const u16*)(p.ws + WS_KB) + ((size_t)(b * 8 + hd) * 4096) * 96; kstride = 96;
    vbase = (const u16*)(p.ws + WS_VTB) + (size_t)((b * 8 + hd) * 64) * 4096;
  } else {
    tq = qt * 16 + wave * 4 + (r >> 3); hdl = r & 7; wmin = qt * 16 + wave * 4; wmax = wmin + 3; nt64 = (qt >> 2) + 1;
    qrow = (const u16*)(p.ws + WS_DSQ) + ((size_t)(tokbase + tq) * 8 + hdl) * 64;
    kbase = (const u16*)(p.ws + WS_DSK) + (size_t)tokbase * 64; kstride = 64;
    vbase = (const u16*)(p.ws + WS_VTC) + (size_t)(b * 64) * 4096;
  }
  int posq = 0, wposmin = 0;
  if (MODE == 2) {
    posq = p.pos[tokbase + tq];
    wposmin = posq;
#pragma unroll
    for (int off = 1; off < 64; off <<= 1) { const int o = __shfl_xor(wposmin, off); wposmin = wposmin < o ? wposmin : o; }
    wposmin = __builtin_amdgcn_readfirstlane(wposmin);
    for (int e = tid; e < 1024; e += 256) {
      const int n = e >> 3, hh = e & 7;
      int bk = n;
      if (n >= 16) {
        bk = 16 + (n >= 19) + (n >= 21) + (n >= 24) + (n >= 27) + (n >= 31) + (n >= 35) + (n >= 40) + (n >= 46) + (n >= 52) + (n >= 59) + (n >= 67) + (n >= 77) + (n >= 87) + (n >= 99) + (n >= 113);
      }
      sBias[e] = (p.rel_bias[bk * 8 + hh] - p.rel_bias[31 * 8 + hh]) * LOG2E;
    }
  }
  constexpr bool fastsm = FAST;
  bf16x8 qf[KS];
#pragma unroll
  for (int ks = 0; ks < KS; ++ks) qf[ks] = *(const bf16x8*)(qrow + ks * 16 + 8 * h);

  f32x16 o[2];
  o[0] = zero16(); o[1] = zero16();
  float carry = 1.f;
  float mrun = -INFINITY, lrun = 0.f;

  uint4 rk0, rk1, rk2 = make_uint4(0, 0, 0, 0), rv0, rv1;
  int rp = 0;
  const int krow0 = tid / KCH, kc0 = tid - krow0 * KCH;
  const int krow1 = (tid + 256) / KCH, kc1 = (tid + 256) - krow1 * KCH;
  const int krow2 = (tid + 512) / KCH, kc2 = (tid + 512) - krow2 * KCH;
  const int vd0 = tid >> 3, vc0 = tid & 7, vd1 = vd0 + 32;
#define ATT_GLOAD(KT)                                                                         \
  do {                                                                                        \
    const int key0_ = (KT) * 64;                                                              \
    rk0 = *(const uint4*)(kbase + (size_t)(key0_ + krow0) * kstride + kc0 * 8);               \
    rk1 = *(const uint4*)(kbase + (size_t)(key0_ + krow1) * kstride + kc1 * 8);               \
    if (NKL > 2) rk2 = *(const uint4*)(kbase + (size_t)(key0_ + krow2) * kstride + kc2 * 8);  \
    rv0 = *(const uint4*)(vbase + (size_t)vd0 * 4096 + key0_ + vc0 * 8);                      \
    rv1 = *(const uint4*)(vbase + (size_t)vd1 * 4096 + key0_ + vc0 * 8);                      \
    if (MODE == 2) {                                                                          \
      if (tid < 64) rp = p.pos[tokbase + key0_ + tid];                                        \
      else if (tid < 96) rp = (int)BM[(size_t)(tokbase + qt * 16 + ((tid - 64) >> 1)) * 128 + 2 * (KT) + (tid & 1)]; \
      else if (tid < 98) rp = ((const int*)(p.ws + WS_PMAX))[b * 128 + 2 * (KT) + (tid & 1)]; \
    }                                                                                         \
  } while (0)
#define ATT_SSTORE(BUF)                                                  \
  do {                                                                   \
    *(uint4*)&sK[(BUF)][krow0][kc0 * 8] = rk0;                           \
    *(uint4*)&sK[(BUF)][krow1][kc1 * 8] = rk1;                           \
    if (NKL > 2) *(uint4*)&sK[(BUF)][krow2][kc2 * 8] = rk2;              \
    *(uint4*)&sV[(BUF)][vd0][vc0 * 8] = rv0;                             \
    *(uint4*)&sV[(BUF)][vd1][vc0 * 8] = rv1;                             \
    if (MODE == 2) {                                                     \
      if (tid < 64) sPos[(BUF) * 64 + tid] = rp;                         \
      else if (tid < 98) sWd[(BUF) * 34 + (tid - 64)] = rp;              \
    }                                                                    \
  } while (0)

  ATT_GLOAD(MODE == 0 ? nt64 - 1 : 0);
  ATT_SSTORE(0);
  if (nt64 > 1) ATT_GLOAD(MODE == 0 ? nt64 - 2 : 1);
  __syncthreads();
  for (int step = 0; step < nt64; ++step) {
    const int kt = (MODE == 0) ? (nt64 - 1 - step) : step;
    const int buf = step & 1;
    const bool more = (step + 1 < nt64);
#pragma unroll
    for (int subi = 0; subi < 2; ++subi) {
      const int sub = (MODE == 0) ? (1 - subi) : subi;
      const int ks0 = kt * 64 + sub * 32;
      const bool skip = (MODE == 0) ? (ks0 >= wmax) : (ks0 > wmax);
      if (!skip) {
        uint32_t wd = 0;
        int pmaxk = 0;
        if (MODE == 2) { wd = (uint32_t)sWd[buf * 34 + (wave * 4 + (r >> 3)) * 2 + sub]; pmaxk = sWd[buf * 34 + 32 + sub]; }
        f32x16 s = zero16();
#pragma unroll
        for (int ks = 0; ks < KS; ++ks) {
          bf16x8 a = *(const bf16x8*)&sK[buf][sub * 32 + r][ks * 16 + 8 * h];
          s = MFMA32(a, qf[ks], s);
        }
        float pv[16];
        if (MODE == 0) {
          const bool needmask = (ks0 + 31 >= wmin);
          float e[16];
#pragma unroll
          for (int i = 0; i < 16; ++i) e[i] = frcp(1.f + fexp2(s[i]));
          if (needmask) {
#pragma unroll
            for (int i = 0; i < 16; ++i) e[i] = ((ks0 + crow(i, h)) < tq) ? e[i] : 1.f;
          }
          float tot[4], pr[4], sel[4];
#pragma unroll
          for (int g = 0; g < 4; ++g) tot[g] = (e[4 * g + 3] * e[4 * g + 2]) * (e[4 * g + 1] * e[4 * g]);
#pragma unroll
          for (int g = 0; g < 4; ++g) {
            unsigned uu = __float_as_uint(tot[g]);
            auto rr = __builtin_amdgcn_permlane32_swap(uu, uu, false, false);
            const float r0 = __uint_as_float(rr[0]), r1 = __uint_as_float(rr[1]);
            pr[g] = r0 * r1;
            sel[g] = h ? 1.f : r1;
          }
          float R[4];
          R[3] = carry; R[2] = R[3] * pr[3]; R[1] = R[2] * pr[2]; R[0] = R[1] * pr[1];
          carry = R[0] * pr[0];
#pragma unroll
          for (int g = 0; g < 4; ++g) {
            const float p4 = R[g] * sel[g];
            const float p3 = p4 * e[4 * g + 3];
            const float p2 = p3 * e[4 * g + 2];
            const float p1 = p2 * e[4 * g + 1];
            const float p0 = p1 * e[4 * g];
            pv[4 * g + 3] = p4 - p3; pv[4 * g + 2] = p3 - p2; pv[4 * g + 1] = p2 - p1; pv[4 * g] = p1 - p0;
          }
        } else {
          float u[16];
          if (MODE == 1) {
            const bool needmask = (ks0 + 31 > wmin);
#pragma unroll
            for (int i = 0; i < 16; ++i) u[i] = s[i];
            if (needmask) {
              asm volatile("" ::: "memory");
#pragma unroll
              for (int i = 0; i < 16; ++i) { if ((ks0 + crow(i, h)) > tq) u[i] = -INFINITY; }
            }
          } else if (wposmin - pmaxk >= 113) {
#pragma unroll
            for (int i = 0; i < 16; ++i) u[i] = ((wd >> crow(i, h)) & 1u) ? s[i] : -INFINITY;
          } else {
#pragma unroll
            for (int i = 0; i < 16; ++i) {
              const int kk = crow(i, h);
              const int pk = sPos[buf * 64 + sub * 32 + kk];
              int dist = posq - pk;
              dist = dist < 0 ? 0 : (dist > 127 ? 127 : dist);
              const float bias = sBias[dist * 8 + hdl];
              const float negm = ((wd >> kk) & 1u) ? 0.f : -INFINITY;
              u[i] = (s[i] + bias) + negm;
            }
          }
          if (fastsm) {
            float ls = 0.f;
#pragma unroll
            for (int i = 0; i < 16; ++i) { pv[i] = fexp2(u[i]); ls += pv[i]; }
            lrun += ls;
          } else {
          float mx = u[0];
#pragma unroll
          for (int i = 1; i < 16; ++i) mx = fmaxf(mx, u[i]);
          mx = xmax32(mx);
          const float mnew = fmaxf(mrun, mx);
          const float muse = (mnew == -INFINITY) ? 0.f : mnew;
          const float alpha = fexp2(mrun - muse);
          float ls = 0.f;
#pragma unroll
          for (int i = 0; i < 16; ++i) { pv[i] = fexp2(u[i] - muse); ls += pv[i]; }
          lrun = lrun * alpha + ls;
          mrun = mnew;
          if (__any(alpha != 1.f)) {
#pragma unroll
            for (int i = 0; i < 16; ++i) { o[0][i] *= alpha; o[1][i] *= alpha; }
          }
          }
        }
#pragma unroll
        for (int sidx = 0; sidx < 2; ++sidx) {
          uint4 pk4 = make_uint4(pack2(pv[8 * sidx], pv[8 * sidx + 1]), pack2(pv[8 * sidx + 2], pv[8 * sidx + 3]),
                                 pack2(pv[8 * sidx + 4], pv[8 * sidx + 5]), pack2(pv[8 * sidx + 6], pv[8 * sidx + 7]));
          bf16x8 pf = __builtin_bit_cast(bf16x8, pk4);
#pragma unroll
          for (int dt = 0; dt < 2; ++dt) {
            const u16* vp = &sV[buf][dt * 32 + r][sub * 32 + 16 * sidx + 4 * h];
            uint2 lo = *(const uint2*)vp;
            uint2 hi = *(const uint2*)(vp + 8);
            bf16x8 va = __builtin_bit_cast(bf16x8, make_uint4(lo.x, lo.y, hi.x, hi.y));
            o[dt] = MFMA32(va, pf, o[dt]);
          }
        }
      }
    }
    if (more) ATT_SSTORE(buf ^ 1);
    if (step + 2 < nt64) ATT_GLOAD((MODE == 0) ? kt - 2 : kt + 2);
    if (MODE == 0) {
      const int alive = __any(carry >= 5.42101086e-20f) ? 1 : 0;
      if (!__syncthreads_or(alive)) break;
    } else {
      __syncthreads();
    }
  }
  float inv = 1.f;
  if (MODE != 0) { const float lt = xsum32(lrun); inv = 1.f / lt; }
  const size_t tok = (size_t)(tokbase + tq);
  const u16* zrow = PROJ + tok * LDP + O_ZA + MODE * 512 + hdl * 64;
  u16* yrow = YBR + tok * LDY + MODE * 512 + hdl * 64;
#pragma unroll
  for (int dt = 0; dt < 2; ++dt)
#pragma unroll
    for (int g = 0; g < 4; ++g) {
      const int d4 = dt * 32 + 8 * g + 4 * h;
      uint2 zu = *(const uint2*)(zrow + d4);
      float z0 = bflo(zu.x), z1 = bfhi(zu.x), z2 = bflo(zu.y), z3 = bfhi(zu.y);
      float y0 = o[dt][4 * g] * inv, y1 = o[dt][4 * g + 1] * inv, y2 = o[dt][4 * g + 2] * inv, y3 = o[dt][4 * g + 3] * inv;
      y0 *= z0 * fsigmoid(z0); y1 *= z1 * fsigmoid(z1); y2 *= z2 * fsigmoid(z2); y3 *= z3 * fsigmoid(z3);
      *(uint2*)(yrow + d4) = make_uint2(pack2(y0, y1), pack2(y2, y3));
    }
}

DI void phase_branch(const Params& p, int layer, char* smem, int xcd, int loc, int nloc) {
  const char* wset = p.ws + WS_WT + (size_t)(layer & 1) * SZ_WSET;
  const u16* WBR = (const u16*)(wset + OFF_WT_BR);
  const u16* YBR = (const u16*)(p.ws + WS_YBR);
  const u16* PROJ = (const u16*)(p.ws + WS_PROJ);
  u16* MG = (u16*)(p.ws + WS_MERGED);
  const int tid = opaque_tid(), lane = tid & 63, wave = __builtin_amdgcn_readfirstlane(tid >> 6), r = lane & 31, h = lane >> 5;
  const int wn = wave & 1, wm = wave >> 1;
  for (int i = loc;; i += nloc) {
    int mt, nt;
    if (!tile_order<8>(i, xcd, mt, nt)) break;
    const int m0 = mt * 128, d0 = nt * 128;
    f32x16 sum[2][2];
    sum[0][0] = zero16(); sum[0][1] = zero16(); sum[1][0] = zero16(); sum[1][1] = zero16();
#pragma unroll 1
    for (int n = 0; n < 3; ++n) {
      f32x16 acc[2][2];
      acc[0][0] = zero16(); acc[0][1] = zero16(); acc[1][0] = zero16(); acc[1][1] = zero16();
      gemm128(WBR + ((size_t)n * 1024 + d0) * LDB, LDB, YBR + (size_t)m0 * LDY + n * 512, LDY, 512, acc, smem);
      const float* gb = p.gate_b + ((size_t)layer * 3 + n) * 1024;
#pragma unroll
      for (int mi = 0; mi < 2; ++mi) {
        const int m = m0 + wm * 64 + mi * 32 + r;
#pragma unroll
        for (int ni = 0; ni < 2; ++ni)
#pragma unroll
          for (int g = 0; g < 4; ++g) {
            const int d4 = d0 + wn * 64 + ni * 32 + 8 * g + 4 * h;
            uint2 gu = *(const uint2*)(PROJ + (size_t)m * LDP + O_G + n * 1024 + d4);
            float4 bb = *(const float4*)(gb + d4);
            float g0 = bflo(gu.x) + bb.x, g1 = bfhi(gu.x) + bb.y, g2 = bflo(gu.y) + bb.z, g3 = bfhi(gu.y) + bb.w;
            sum[ni][mi][4 * g] += acc[ni][mi][4 * g] * fsigmoid(g0);
            sum[ni][mi][4 * g + 1] += acc[ni][mi][4 * g + 1] * fsigmoid(g1);
            sum[ni][mi][4 * g + 2] += acc[ni][mi][4 * g + 2] * fsigmoid(g2);
            sum[ni][mi][4 * g + 3] += acc[ni][mi][4 * g + 3] * fsigmoid(g3);
          }
      }
    }
#pragma unroll
    for (int mi = 0; mi < 2; ++mi) {
      const int m = m0 + wm * 64 + mi * 32 + r;
#pragma unroll
      for (int ni = 0; ni < 2; ++ni)
#pragma unroll
        for (int g = 0; g < 4; ++g) {
          const int d4 = d0 + wn * 64 + ni * 32 + 8 * g + 4 * h;
          *(uint2*)(MG + (size_t)m * LDX + d4) = make_uint2(pack2(sum[ni][mi][4 * g], sum[ni][mi][4 * g + 1]), pack2(sum[ni][mi][4 * g + 2], sum[ni][mi][4 * g + 3]));
        }
    }
  }
}

DI void phase_out(const Params& p, int layer, char* smem, int xcd, int loc, int nloc) {
  const char* wset = p.ws + WS_WT + (size_t)(layer & 1) * SZ_WSET;
  const u16* WOUT = (const u16*)(wset + OFF_WT_OUT);
  const u16* MG = (const u16*)(p.ws + WS_MERGED);
  u16* XB = (u16*)(p.ws + WS_XB);
  float* XSS = (float*)(p.ws + WS_XSS);
  const float* xin = (layer == 0) ? p.x : p.out;
  const int tid = opaque_tid(), lane = tid & 63, wave = __builtin_amdgcn_readfirstlane(tid >> 6), r = lane & 31, h = lane >> 5;
  const int wn = wave & 1, wm = wave >> 1;
  for (int i = loc;; i += nloc) {
    int mt, nt;
    if (!tile_order<8>(i, xcd, mt, nt)) break;
    const int m0 = mt * 128, n0 = nt * 128;
    f32x16 acc[2][2];
    acc[0][0] = zero16(); acc[0][1] = zero16(); acc[1][0] = zero16(); acc[1][1] = zero16();
    gemm128(WOUT + (size_t)n0 * LDX, LDX, MG + (size_t)m0 * LDX, LDX, 1024, acc, smem);
#pragma unroll
    for (int mi = 0; mi < 2; ++mi) {
      const int m = m0 + wm * 64 + mi * 32 + r;
      float ss = 0.f;
#pragma unroll
      for (int ni = 0; ni < 2; ++ni)
#pragma unroll
        for (int g = 0; g < 4; ++g) {
          const int n4 = n0 + wn * 64 + ni * 32 + 8 * g + 4 * h;
          float4 xo = *(const float4*)(xin + (size_t)m * 1024 + n4);
          xo.x += acc[ni][mi][4 * g]; xo.y += acc[ni][mi][4 * g + 1]; xo.z += acc[ni][mi][4 * g + 2]; xo.w += acc[ni][mi][4 * g + 3];
          *(float4*)(p.out + (size_t)m * 1024 + n4) = xo;
          *(uint2*)(XB + (size_t)m * LDX + n4) = make_uint2(pack2(xo.x, xo.y), pack2(xo.z, xo.w));
          ss += xo.x * xo.x + xo.y * xo.y + xo.z * xo.z + xo.w * xo.w;
        }
      ss += xor32(ss);
      if (h == 0) XSS[(size_t)m * 16 + nt * 2 + wn] = ss;
    }
  }
}

DI void phase_init(const Params& p) {
  u16* XB = (u16*)(p.ws + WS_XB);
  float* XSS = (float*)(p.ws + WS_XSS);
  const int lane = threadIdx.x & 63;
  const int gw = blockIdx.x * 4 + (threadIdx.x >> 6), nw = gridDim.x * 4;
  for (int row = gw; row < NTOK; row += nw) {
    const float* xr = p.x + (size_t)row * 1024;
    float ss = 0.f;
#pragma unroll
    for (int i = 0; i < 4; ++i) {
      float4 v = *(const float4*)(xr + i * 256 + lane * 4);
      ss += v.x * v.x + v.y * v.y + v.z * v.z + v.w * v.w;
      *(uint2*)(XB + (size_t)row * LDX + i * 256 + lane * 4) = make_uint2(pack2(v.x, v.y), pack2(v.z, v.w));
    }
#pragma unroll
    for (int off = 32; off >= 1; off >>= 1) ss += __shfl_xor(ss, off);
    if (lane < 16) XSS[(size_t)row * 16 + lane] = (lane == 0) ? ss : 0.f;
  }
  if (blockIdx.x == 0 && threadIdx.x < 64) ((int*)(p.ws + WS_CTR))[threadIdx.x] = 0;
}


#ifndef DUP_MASK
#define DUP_MASK 0
#endif
constexpr int SMEM_BYTES = 73728;
constexpr int N_PHASES = 1 + 5 * DEPTH;

__global__ void __launch_bounds__(256, 2) hybrid_megakernel(Params p, int ph_lo, int ph_hi, int do_sync) {
  __shared__ __attribute__((aligned(16))) char smem[SMEM_BYTES];
  __shared__ int s_item;
  __shared__ uint4 xb_words;
  const int tid = threadIdx.x, bid = blockIdx.x, nb = gridDim.x;
  __shared__ int s_xinfo[4];
  if (tid == 0) { xb_words = make_uint4(0u, 0u, 0u, 0u); s_xinfo[3] = 0; }
  __syncthreads();
  XcdBarrier xb = xcd_barrier_post((unsigned*)(p.ws + WS_BAR), (volatile LAS unsigned*)&xb_words);
  if (tid == 0) s_xinfo[1] = (int)xb_add((unsigned*)(p.ws + WS_BAR) + 8 * xb.x, 1u);
  int t_cls = bid & 7, t_loc = bid >> 3, t_step = (nb - (bid & 7) + 7) >> 3;
  for (int ph = ph_lo; ph < ph_hi; ++ph) {
    if (ph == 0) {
      phase_init(p);
      for (int it = bid; it < CV_TOTAL; it += nb) convert_item(p, 0, it, (float*)smem);
    } else {
      const int layer = (ph - 1) / 5, sub = (ph - 1) % 5;
      if (sub == 0) {
        phase_proj(p, layer, smem, t_cls, t_loc, t_step);
        if (DUP_MASK & 1) { __syncthreads(); phase_proj(p, layer, smem, t_cls, t_loc, t_step); }
        if (DUP_MASK & 16) { __syncthreads(); phase_proj_probe(p, layer, smem, t_cls, t_loc, t_step); }
      } else if (sub == 1) {
        const int ncv = (layer + 1 < DEPTH) ? CV_TOTAL : 0;
        const int total = 4096 + 1024 + ncv;
        for (int rep = 0; rep < ((DUP_MASK & 4) ? 2 : 1); ++rep)
        for (int it = bid; it < total; it += nb) {
          if (it < 4096) select_item(p, it, smem);
          else if (it < 5120) prep_item(p, layer, it - 4096, smem);
          else convert_item(p, layer + 1, it - 5120, (float*)smem);
        }
      } else if (sub == 2) {
        const bool fast1 = softmax_bound_ok(p, layer, 1), fast2 = softmax_bound_ok(p, layer, 2);
        const bool xq = (s_xinfo[3] == 8);
        int* ctr = (int*)(p.ws + WS_CTR) + (xq ? (16 + layer * 8 + t_cls) : layer);
        const int limit = xq ? 384 : 3072;
        while (true) {
          if (tid == 0) s_item = atomicAdd(ctr, 1);
          __syncthreads();
          const int w = s_item;
          __syncthreads();
          if (w >= limit) break;
          int type, b, hd, d, jt;
          if (xq) {
            const int level = w / 12, within = w - level * 12;
            d = 31 - level;
            type = within >> 2;
            const int pr = 4 * t_cls + (within & 3);
            b = (type == 2) ? (t_cls >> 1) : (pr >> 3);
            hd = pr & 7;
            jt = d * 8 + 2 * (within & 3) + (t_cls & 1);
          } else {
            d = 31 - w / 96;
            const int within = w % 96, idx = within & 31;
            type = within >> 5; b = idx >> 3; hd = idx & 7; jt = d * 8 + (idx & 7);
          }
          if (type == 0) attn_item<0, false>(p, layer, b, hd, d, smem);
          else if (type == 1) { if (fast1) attn_item<1, true>(p, layer, b, hd, d, smem); else attn_item<1, false>(p, layer, b, hd, d, smem); }
          else { if (fast2) attn_item<2, true>(p, layer, b, 0, jt, smem); else attn_item<2, false>(p, layer, b, 0, jt, smem); }
        }
      } else if (sub == 3) {
        phase_branch(p, layer, smem, t_cls, t_loc, t_step);
        if (DUP_MASK & 8) { __syncthreads(); phase_branch(p, layer, smem, t_cls, t_loc, t_step); }
      } else {
        phase_out(p, layer, smem, t_cls, t_loc, t_step);
      }
    }
    if (do_sync == 2) cg::this_grid().sync();
    if (do_sync && ph + 1 < ph_hi) {
      xcd_barrier(xb);
      if (ph == ph_lo) {
        if (tid == 0) {
          unsigned* bar = (unsigned*)(p.ws + WS_BAR);
          int xi = 0;
          for (unsigned j = 0; j < xb.x; ++j) xi += (xb_ld(&bar[XB_XCNT(j)]) > 0u) ? 1 : 0;
          s_xinfo[0] = xi; s_xinfo[2] = (int)xb_words.x; s_xinfo[3] = (int)xb_words.y;
        }
        __syncthreads();
        if (s_xinfo[3] == 8) { t_cls = s_xinfo[0]; t_loc = s_xinfo[1]; t_step = s_xinfo[2]; }
      }
    }
  }
}

#ifndef MK_MULTI
#define MK_MULTI 0
#endif

extern "C" void kernel_launch(void* const* d_in, const int* in_sizes, int n_in, void* d_out, int out_size, void* d_ws,
                              size_t ws_size, hipStream_t stream) {
  (void)in_sizes; (void)n_in; (void)out_size;
  if (ws_size < WS_TOTAL) { fprintf(stderr, "workspace too small: %zu < %zu\n", ws_size, (size_t)WS_TOTAL); return; }
  Params p{};
  p.x = (const float*)d_in[0]; p.pos = (const int*)d_in[1]; p.norm_g = (const float*)d_in[2]; p.w_in = (const float*)d_in[3];
  p.qn_g = (const float*)d_in[4]; p.kvn_g = (const float*)d_in[5]; p.w_uq = (const float*)d_in[6]; p.w_ukv = (const float*)d_in[7];
  p.mla_q_g = (const float*)d_in[8]; p.mla_k_g = (const float*)d_in[9]; p.dsa_q_g = (const float*)d_in[10]; p.dsa_k_g = (const float*)d_in[11];
  p.rel_bias = (const float*)d_in[12]; p.gate_b = (const float*)d_in[13]; p.w_branch = (const float*)d_in[14]; p.w_out = (const float*)d_in[15];
  p.out = (float*)d_out; p.ws = (char*)d_ws;
  static int grid_blocks = 0;
  if (!grid_blocks) {
    int dev = 0, cus = 0, per_cu = 0;
    hipGetDevice(&dev);
    hipDeviceGetAttribute(&cus, hipDeviceAttributeMultiprocessorCount, dev);
    hipOccupancyMaxActiveBlocksPerMultiprocessor(&per_cu, hybrid_megakernel, 256, 0);
    if (per_cu > 2) per_cu = 2;
    grid_blocks = cus * per_cu;
    if (grid_blocks < 8) grid_blocks = 8;
  }
#if MK_MULTI
  for (int ph = 0; ph < N_PHASES; ++ph) {
    hipLaunchKernelGGL(hybrid_megakernel, dim3(grid_blocks), dim3(256), 0, stream, p, ph, ph + 1, 0);
  }
#else
  hipMemsetAsync((char*)d_ws + WS_BAR, 0, 32768, stream);
  int lo = 0, hi = N_PHASES, sy = 1;
  void* args[] = {&p, &lo, &hi, &sy};
  hipError_t e = hipLaunchCooperativeKernel((void*)hybrid_megakernel, dim3(grid_blocks), dim3(256), args, 0, stream);
  if (e != hipSuccess) fprintf(stderr, "cooperative launch failed: %s (grid %d)\n", hipGetErrorString(e), grid_blocks);
#endif
}
```
